# Optimizing an MI355X kernel written in HIP

```python
import math
import jax, jax.numpy as jnp
from jax import lax
import numpy as np

D_MODEL = 2048
BATCH = 4
SEQ = 2048
DEPTH = 2

N_BRANCH = 4
BRANCH_WIDTH = D_MODEL // 4
GM_GROUPS = 4
GM_CHUNK = 128
GM_GROUP_DIM = BRANCH_WIDTH // GM_GROUPS
DA_HEADS = 4
DA_QK_DIM = BRANCH_WIDTH // (2 * DA_HEADS)
DA_V_DIM = 2 * DA_QK_DIM
DA_ROT_DIM = DA_QK_DIM // 4
FA_HEADS = 4
FA_HEAD_DIM = BRANCH_WIDTH // FA_HEADS
POOL_WINDOWS = (2, 4, 8, 16)
POOL_GROUPS = 4
POOL_GROUP_DIM = BRANCH_WIDTH // POOL_GROUPS
FFN_DIM = 4 * D_MODEL
ROPE_THETA = 500000.0
Q_BLOCK = 128
NORM_EPS = 1e-6

A_U = 0
A_V = A_U + BRANCH_WIDTH
B_Q = A_V + BRANCH_WIDTH
B_K = B_Q + 2 * DA_HEADS * DA_QK_DIM
B_V = B_K + 2 * DA_HEADS * DA_QK_DIM
C_Q = B_V + DA_HEADS * DA_V_DIM
C_K = C_Q + FA_HEADS * FA_HEAD_DIM
C_V = C_K + FA_HEADS * FA_HEAD_DIM
C_F = C_V + FA_HEADS * FA_HEAD_DIM
D_H = C_F + FA_HEADS
GATE = D_H + BRANCH_WIDTH
IN_COLS = GATE + N_BRANCH * D_MODEL

kernel_name = "hybrid_gated_parallel_mixers"


def rms_norm(x, g):
    xf = x.astype(jnp.float32)
    y = xf * lax.rsqrt(jnp.mean(xf * xf, axis=-1, keepdims=True) + NORM_EPS)
    return (y * g.astype(jnp.float32)).astype(x.dtype)


def rotary_tables(positions, rot_dim):
    inv = 1.0 / (ROPE_THETA ** (jnp.arange(0, rot_dim, 2, dtype=jnp.float32) / rot_dim))
    ang = positions.astype(jnp.float32)[..., None] * inv
    return jnp.cos(ang), jnp.sin(ang)


def apply_partial_rotary(x, cos, sin):
    half = cos.shape[-1]
    xf = x.astype(jnp.float32)
    x1, x2, xp = xf[..., :half], xf[..., half:2 * half], xf[..., 2 * half:]
    c, s = cos[:, :, None, :], sin[:, :, None, :]
    out = jnp.concatenate([x1 * c - x2 * s, x1 * s + x2 * c, xp], axis=-1)
    return out.astype(x.dtype)


def chunked_spatial_gating(u, v, ln_g, ln_b, w_s, b_s):
    B, S, _ = v.shape
    vf = v.astype(jnp.float32)
    mu = jnp.mean(vf, axis=-1, keepdims=True)
    var = jnp.mean(jnp.square(vf - mu), axis=-1, keepdims=True)
    vn = ((vf - mu) * lax.rsqrt(var + NORM_EPS) * ln_g.astype(jnp.float32)
          + ln_b.astype(jnp.float32)).astype(v.dtype)
    vn = vn.reshape(B, S // GM_CHUNK, GM_CHUNK, GM_GROUPS, GM_GROUP_DIM)
    causal = jnp.tril(jnp.ones((GM_CHUNK, GM_CHUNK), dtype=w_s.dtype))
    mixed = jnp.einsum('gts,bnsgc->bntgc', w_s * causal, vn) + b_s.T[:, :, None]
    return u * mixed.reshape(B, S, GM_GROUPS * GM_GROUP_DIM)


def differential_attention(q, k, v, lam, subln_g, lambda_init):
    B, S, H, _, dk = q.shape
    dv = v.shape[-1]
    nb = S // Q_BLOCK
    kh = k.transpose(0, 2, 3, 1, 4)
    vh = v.transpose(0, 2, 1, 3)
    q_blocks = q.transpose(0, 2, 3, 1, 4).reshape(B, H, 2, nb, Q_BLOCK, dk).transpose(3, 0, 1, 2, 4, 5)
    kpos = jnp.arange(S)
    scale = dk ** -0.5

    def one_block(args):
        qb, i = args
        qpos = i * Q_BLOCK + jnp.arange(Q_BLOCK)
        logits = jnp.einsum('bhmqd,bhmkd->bhmqk', qb, kh).astype(jnp.float32) * scale
        logits = jnp.where(qpos[:, None] >= kpos[None, :], logits, -jnp.inf)
        p = jax.nn.softmax(logits, axis=-1)
        w = p[:, :, 0] - lam * p[:, :, 1]
        return jnp.einsum('bhqk,bhkd->bhqd', w.astype(vh.dtype), vh)

    out = lax.map(one_block, (q_blocks, jnp.arange(nb)))
    out = out.transpose(1, 0, 3, 2, 4).reshape(B, S, H, dv)
    out = rms_norm(out, subln_g) * (1.0 - lambda_init)
    return out.reshape(B, S, H * dv)


def forgetting_attention(q, k, v, f_logit):
    B, S, H, d = q.shape
    nb = S // Q_BLOCK
    logf = jax.nn.log_sigmoid(f_logit.astype(jnp.float32))
    cum = jnp.cumsum(logf, axis=1).transpose(0, 2, 1)
    kh = k.transpose(0, 2, 1, 3)
    vh = v.transpose(0, 2, 1, 3)
    q_blocks = q.transpose(0, 2, 1, 3).reshape(B, H, nb, Q_BLOCK, d).transpose(2, 0, 1, 3, 4)
    c_blocks = cum.reshape(B, H, nb, Q_BLOCK).transpose(2, 0, 1, 3)
    kpos = jnp.arange(S)
    scale = d ** -0.5

    def one_block(args):
        qb, cq, i = args
        qpos = i * Q_BLOCK + jnp.arange(Q_BLOCK)
        logits = jnp.einsum('bhqd,bhkd->bhqk', qb, kh).astype(jnp.float32) * scale
        logits = logits + cq[..., None] - cum[:, :, None, :]
        logits = jnp.where(qpos[:, None] >= kpos[None, :], logits, -jnp.inf)
        p = jax.nn.softmax(logits, axis=-1)
        return jnp.einsum('bhqk,bhkd->bhqd', p.astype(vh.dtype), vh)

    out = lax.map(one_block, (q_blocks, c_blocks, jnp.arange(nb)))
    return out.transpose(1, 0, 3, 2, 4).reshape(B, S, H * d)


def multiscale_pool(h, w_pool, scale):
    B, S, _ = h.shape
    hg = h.reshape(B, S, POOL_GROUPS, POOL_GROUP_DIM)
    csum = jnp.cumsum(hg.astype(jnp.float32), axis=1)
    csum = jnp.concatenate([jnp.zeros_like(csum[:, :1]), csum], axis=1)
    win = jnp.array(POOL_WINDOWS, dtype=jnp.int32)
    t = jnp.arange(S, dtype=jnp.int32)[:, None]
    start = jnp.maximum(t + 1 - win[None, :], 0)
    gidx = jnp.arange(POOL_GROUPS)[None, :]
    total = csum[:, 1:] - csum[:, start, gidx]
    count = jnp.minimum(t + 1, win[None, :]).astype(jnp.float32)[None, :, :, None]
    pooled = (total / count - hg.astype(jnp.float32)).astype(h.dtype)
    y = jnp.einsum('bsgc,gcd->bsgd', pooled, w_pool)
    return y.reshape(B, S, POOL_GROUPS * POOL_GROUP_DIM) * scale


def setup_inputs(seed: int = 0) -> dict:
    key = jax.random.key(seed)
    ks = jax.random.split(key, 24)
    L = DEPTH
    f32 = jnp.float32

    def nrm(k, shape, s):
        return jax.random.normal(k, shape, f32) * s

    x = jax.random.normal(ks[0], (BATCH, SEQ, D_MODEL), f32)
    offs = jax.random.randint(ks[1], (BATCH, 1), 0, 4096, dtype=jnp.int32)
    positions = offs + jnp.arange(SEQ, dtype=jnp.int32)[None, :]
    return {
        "x": x,
        "positions": positions,
        "norm_mix_pre": 1.0 + nrm(ks[2], (L, D_MODEL), 0.05),
        "norm_mix_post": 1.0 + nrm(ks[3], (L, D_MODEL), 0.05),
        "norm_ffn_pre": 1.0 + nrm(ks[4], (L, D_MODEL), 0.05),
        "norm_ffn_post": 1.0 + nrm(ks[5], (L, D_MODEL), 0.05),
        "w_in": nrm(ks[6], (L, D_MODEL, IN_COLS), D_MODEL ** -0.5),
        "gm_ln_g": 1.0 + nrm(ks[7], (L, BRANCH_WIDTH), 0.05),
        "gm_ln_b": nrm(ks[8], (L, BRANCH_WIDTH), 0.02),
        "gm_w_s": nrm(ks[9], (L, GM_GROUPS, GM_CHUNK, GM_CHUNK), GM_CHUNK ** -0.5),
        "gm_b_s": 1.0 + nrm(ks[10], (L, GM_GROUPS, GM_CHUNK), 0.1),
        "da_lambda": nrm(ks[11], (L, 4, DA_QK_DIM), 0.1),
        "da_subln_g": 1.0 + nrm(ks[12], (L, DA_V_DIM), 0.05),
        "fa_b_f": 2.0 + nrm(ks[13], (L, FA_HEADS), 0.1),
        "pool_w": nrm(ks[14], (L, POOL_GROUPS, POOL_GROUP_DIM, POOL_GROUP_DIM), POOL_GROUP_DIM ** -0.5),
        "pool_scale": 1.0 + nrm(ks[15], (L, BRANCH_WIDTH), 0.1),
        "w_branch": nrm(ks[16], (L, N_BRANCH, BRANCH_WIDTH, D_MODEL), BRANCH_WIDTH ** -0.5),
        "w_out": nrm(ks[17], (L, D_MODEL, D_MODEL), D_MODEL ** -0.5),
        "w_ffn_up": nrm(ks[18], (L, D_MODEL, FFN_DIM), D_MODEL ** -0.5),
        "w_ffn_down": nrm(ks[19], (L, FFN_DIM, D_MODEL), FFN_DIM ** -0.5),
    }


def reference(x, positions, norm_mix_pre, norm_mix_post, norm_ffn_pre, norm_ffn_post,
              w_in, gm_ln_g, gm_ln_b, gm_w_s, gm_b_s, da_lambda, da_subln_g, fa_b_f,
              pool_w, pool_scale, w_branch, w_out, w_ffn_up, w_ffn_down):
    B, S, _ = x.shape
    cos, sin = rotary_tables(positions, DA_ROT_DIM)
    h = x
    for l in range(DEPTH):
        lambda_init = 0.8 - 0.6 * math.exp(-0.3 * l)
        xn = rms_norm(h, norm_mix_pre[l])
        proj = xn @ w_in[l]

        o_a = chunked_spatial_gating(proj[..., A_U:A_V], proj[..., A_V:B_Q],
                                     gm_ln_g[l], gm_ln_b[l], gm_w_s[l], gm_b_s[l])

        q_b = apply_partial_rotary(proj[..., B_Q:B_K].reshape(B, S, 2 * DA_HEADS, DA_QK_DIM), cos, sin)
        k_b = apply_partial_rotary(proj[..., B_K:B_V].reshape(B, S, 2 * DA_HEADS, DA_QK_DIM), cos, sin)
        v_b = proj[..., B_V:C_Q].reshape(B, S, DA_HEADS, DA_V_DIM)
        lp = da_lambda[l].astype(jnp.float32)
        lam = jnp.exp(jnp.sum(lp[0] * lp[1])) - jnp.exp(jnp.sum(lp[2] * lp[3])) + lambda_init
        o_b = differential_attention(q_b.reshape(B, S, DA_HEADS, 2, DA_QK_DIM),
                                     k_b.reshape(B, S, DA_HEADS, 2, DA_QK_DIM),
                                     v_b, lam, da_subln_g[l], lambda_init)

        q_c = proj[..., C_Q:C_K].reshape(B, S, FA_HEADS, FA_HEAD_DIM)
        k_c = proj[..., C_K:C_V].reshape(B, S, FA_HEADS, FA_HEAD_DIM)
        v_c = proj[..., C_V:C_F].reshape(B, S, FA_HEADS, FA_HEAD_DIM)
        f_logit = proj[..., C_F:D_H] + fa_b_f[l]
        o_c = forgetting_attention(q_c, k_c, v_c, f_logit)

        o_d = multiscale_pool(proj[..., D_H:GATE], pool_w[l], pool_scale[l])

        branches = jnp.stack([o_a, o_b, o_c, o_d], axis=2)
        gates = jax.nn.sigmoid(proj[..., GATE:].reshape(B, S, N_BRANCH, D_MODEL))
        branch_d = jnp.einsum('bsnc,ncd->bsnd', branches, w_branch[l])
        merged = jnp.einsum('bsnd,bsnd->bsd', gates, branch_d)
        h = h + rms_norm(merged @ w_out[l], norm_mix_post[l])

        hn = rms_norm(h, norm_ffn_pre[l])
        ff = jnp.square(jax.nn.relu(hn @ w_ffn_up[l])) @ w_ffn_down[l]
        h = h + rms_norm(ff, norm_ffn_post[l])
    return h
```

```cpp
#include <hip/hip_runtime.h>
#include <hip/hip_cooperative_groups.h>
#include <cstdio>
#include <cstdint>
namespace cg = cooperative_groups;
#ifndef REP_P0
#define REP_P0 1
#endif
#ifndef REP_IN
#define REP_IN 1
#endif
#ifndef REP_MIX
#define REP_MIX 1
#endif
#ifndef REP_MERGE
#define REP_MERGE 1
#endif
#ifndef REP_OUT
#define REP_OUT 1
#endif
#ifndef REP_UP
#define REP_UP 1
#endif
#ifndef REP_DN
#define REP_DN 1
#endif
#ifndef REP_ROW
#define REP_ROW 1
#endif
#ifndef REP_SYNC
#define REP_SYNC 1
#endif
#ifndef USE_CG_SYNC
#define USE_CG_SYNC 0
#endif
#define GSYNC() do { for (int _r = 0; _r < REP_SYNC; ++_r) { if (USE_CG_SYNC) grid.sync(); else { XcdBarrier _b; _b.bar = xbar_words; _b.x = xbar_x; _b.st = (volatile LAS unsigned*)(lds + LDS_MISC + 32); xcd_barrier(_b); } } } while (0)

#define LAS __attribute__((address_space(3)))
typedef unsigned short bf16_t;
typedef short bf16x8 __attribute__((ext_vector_type(8)));
typedef float f32x4 __attribute__((ext_vector_type(4)));
typedef unsigned u32x4 __attribute__((ext_vector_type(4)));
typedef unsigned u32x2 __attribute__((ext_vector_type(2)));

constexpr int DM = 2048, NBATCH = 4, SEQ = 2048, MROWS = NBATCH * SEQ, DEPTH = 2;
constexpr int INC = 12804;
constexpr int NP = 12800;
constexpr int NIN = 13056;
constexpr int FFN = 8192;
constexpr int P_AU = 0, P_AV = 512, P_BQ = 1024, P_BK = 1536, P_BV = 2048, P_CQ = 2560, P_CK = 3072, P_CV = 3584, P_DH = 4096, P_GATE = 4608;
constexpr float NORM_EPS = 1e-6f;
constexpr float LOG2E = 1.4426950408889634f;

constexpr size_t MiB = 1u << 20;
constexpr size_t WS_CTL = 0, CTL_BYTES = 65536;
constexpr int CW_BAR = 4096;
constexpr size_t WS_W = 1 * MiB, WL_STRIDE = 132 * MiB;
constexpr size_t WO_IN = 0, WO_BR = 51 * MiB, WO_OUT = 59 * MiB, WO_UP = 67 * MiB, WO_DN = 99 * MiB, WO_POOL = 131 * MiB;
constexpr size_t WS_PROJ = 266 * MiB;
constexpr size_t WS_XN = 466 * MiB;
constexpr size_t WS_BR = 498 * MiB;
constexpr size_t WS_MB = 530 * MiB;
constexpr size_t WS_Y = 562 * MiB;
constexpr size_t WS_FLOG = 626 * MiB;
constexpr size_t WS_ROT = 627 * MiB;
constexpr size_t WS_HB = 628 * MiB;
constexpr size_t WS_END = 660 * MiB;

constexpr int LDS_BYTES = 139264;
constexpr int LDS_MISC = 135168;

__device__ __forceinline__ unsigned f2bf(float f) { unsigned u = __builtin_bit_cast(unsigned, f); return (u + 0x7fffu + ((u >> 16) & 1u)) >> 16; }
__device__ __forceinline__ unsigned pk2(float lo, float hi) { return f2bf(lo) | (f2bf(hi) << 16); }
__device__ __forceinline__ float bflo(unsigned w) { return __builtin_bit_cast(float, w << 16); }
__device__ __forceinline__ float bfhi(unsigned w) { return __builtin_bit_cast(float, w & 0xffff0000u); }
__device__ __forceinline__ float wave_sum(float v) {
#pragma unroll
    for (int o = 1; o < 64; o <<= 1) v += __shfl_xor(v, o);
    return v;
}
#define LDS_WAIT() asm volatile("s_waitcnt lgkmcnt(0)" ::: "memory")

namespace pg8 {
constexpr int BM = 256, BK = 64, HALF = 128, HTB = HALF * BK * 2, STAGE_BYTES = 8 * HTB, NXCD = 8, WGM = 8;
__host__ __device__ __forceinline__ int lds_byte(int r, int c) { const int st = (r >> 4) * 2 + (c >> 5), rr = r & 15, cc = c & 31, ob = rr * 64 + cc * 2; return st * 1024 + (ob ^ (((ob >> 9) & 1) << 5)); }
__host__ __device__ __forceinline__ void stage_rc(int b, int& R, int& C) { const int st = b / 1024, sb = b % 1024, swz = sb ^ (((sb >> 9) & 1) << 5); R = (st >> 1) * 16 + swz / 64; C = (st & 1) * 32 + (swz % 64) / 2; }
__host__ __device__ __forceinline__ int perm32(int rho) { const int n = rho >> 4, i = rho & 15; return 8 * (i >> 2) + 4 * n + (i & 3); }

struct Unit { int pm, pn; };
struct Gemm { const bf16_t* A; const bf16_t* Bt; int M, N, K; };

struct StaticOrder {
    int nM, nN, nwg, G, c, nrep;
    __device__ void init(int M, int N, int G_, int c_, int nrep_ = 1) { nM = M / BM; nN = N / BM; nwg = nM * nN; G = G_; c = c_; nrep = nrep_; asm volatile("" : "+s"(c), "+s"(G)); }
    __device__ bool next(int i, Unit& u) const {
        long L = (long)i * G + c; if (L >= (long)nwg * nrep) return false;
        if (nrep > 1) L %= nwg;
        int wgid = (int)L; { const int q = nwg / NXCD, r = nwg % NXCD, xcd = wgid % NXCD, off = wgid / NXCD; wgid = (xcd < r ? xcd * (q + 1) : r * (q + 1) + (xcd - r) * q) + off; }
        const int nig = WGM * nN, gid = wgid / nig, fm = gid * WGM, gsz = (nM - fm) < WGM ? (nM - fm) : WGM;
        u.pm = fm + ((wgid % nig) % gsz); u.pn = (wgid % nig) / gsz; return true;
    }
};

struct InOrder : StaticOrder {
    int i0, i1;
    __device__ void init(int M, int N, int G_, int c_, int i0_, int i1_) { StaticOrder::init(M, N, G_, c_, 1); i0 = i0_; i1 = i1_; }
    __device__ bool next(int i, Unit& u) const {
        if (i + i0 >= i1) return false;
        const bool ok = StaticOrder::next(i + i0, u);
        if (ok) u.pn = (u.pn == 0) ? 50 : u.pn - 1;
        return ok;
    }
};
__device__ __forceinline__ unsigned cvt_pk_bf16(float lo, float hi) { unsigned r; asm volatile("v_cvt_pk_bf16_f32 %0, %1, %2" : "=v"(r) : "v"(lo), "v"(hi)); return r; }


struct EpiIn {
    static constexpr bool PERM = true, FOLD = false;
    bf16_t* O; float* flog; const float* rot; const float* bfv;
    __device__ __forceinline__ void operator()(const f32x4 (&acc)[2][2][4][2], const Unit& u, int wr, int wc, int fr, int fq) const {
        const int row0 = u.pm * BM + wr * 64 + fr;
        if (u.pn == 50) {
            if (wc == 0 && fq == 0) {
                const f32x4 b = *(const f32x4*)bfv;
#pragma unroll
                for (int ai = 0; ai < 2; ++ai)
#pragma unroll
                    for (int m = 0; m < 4; ++m) *(f32x4*)(flog + (size_t)(row0 + ai * HALF + m * 16) * 4) = acc[ai][0][m][0] + b;
            }
            return;
        }
        const int col0 = u.pn * BM + wc * 32 + 8 * fq;
        const bool sig = u.pn >= 18;
        const bool rotary = (u.pn >= 4) && (u.pn < 8) && ((wc & 1) == 0);
        const float sg = (fq == 0) ? -1.f : 1.f;
#pragma unroll
        for (int ai = 0; ai < 2; ++ai) {
            f32x4 rt[4][4];
            if (rotary) {
#pragma unroll
                for (int m = 0; m < 4; ++m)
#pragma unroll
                    for (int q = 0; q < 4; ++q) rt[m][q] = *((const f32x4*)(rot + (size_t)(row0 + ai * HALF + m * 16) * 16) + q);
            }
#pragma unroll
            for (int m = 0; m < 4; ++m) {
                const int row = row0 + ai * HALF + m * 16;
                bf16_t* rowp = O + (size_t)row * NP + col0;
                f32x4 v[2][2];
#pragma unroll
                for (int bj = 0; bj < 2; ++bj) { v[bj][0] = acc[ai][bj][m][0]; v[bj][1] = acc[ai][bj][m][1]; }
                if (rotary) {
#pragma unroll
                    for (int n = 0; n < 2; ++n) {
                        const f32x4 ca = rt[m][2 * n], cb = rt[m][2 * n + 1];
                        const float cc[4] = {ca[0], ca[2], cb[0], cb[2]};
                        const float ss[4] = {ca[1] * sg, ca[3] * sg, cb[1] * sg, cb[3] * sg};
#pragma unroll
                        for (int bj = 0; bj < 2; ++bj)
#pragma unroll
                            for (int j = 0; j < 4; ++j) {
                                const float own = v[bj][n][j];
                                const float par = __shfl_xor(own, 16);
                                const float nv = own * cc[j] + par * ss[j];
                                v[bj][n][j] = (fq < 2) ? nv : own;
                            }
                    }
                }
#pragma unroll
                for (int bj = 0; bj < 2; ++bj) {
                    f32x4 v0 = v[bj][0], v1 = v[bj][1];
                    if (sig) {
#pragma unroll
                        for (int j = 0; j < 4; ++j) {
                            v0[j] = __builtin_amdgcn_rcpf(1.0f + __builtin_amdgcn_exp2f(v0[j]));
                            v1[j] = __builtin_amdgcn_rcpf(1.0f + __builtin_amdgcn_exp2f(v1[j]));
                        }
                    }
                    u32x4 w; w.x = cvt_pk_bf16(v0[0], v0[1]); w.y = cvt_pk_bf16(v0[2], v0[3]); w.z = cvt_pk_bf16(v1[0], v1[1]); w.w = cvt_pk_bf16(v1[2], v1[3]);
                    *(u32x4*)(rowp + bj * HALF) = w;
                }
            }
            if (rotary) asm volatile("" ::: "memory");
        }
    }
};
template <int ACT> struct EpiBf {
    static constexpr bool PERM = true, FOLD = false;
    bf16_t* O; int ldc;
    __device__ __forceinline__ void operator()(const f32x4 (&acc)[2][2][4][2], const Unit& u, int wr, int wc, int fr, int fq) const {
        const int row0 = u.pm * BM + wr * 64 + fr, col0 = u.pn * BM + wc * 32 + 8 * fq;
#pragma unroll
        for (int ai = 0; ai < 2; ++ai)
#pragma unroll
            for (int m = 0; m < 4; ++m) {
                bf16_t* rowp = O + (size_t)(row0 + ai * HALF + m * 16) * ldc + col0;
#pragma unroll
                for (int bj = 0; bj < 2; ++bj) {
                    f32x4 v0 = acc[ai][bj][m][0], v1 = acc[ai][bj][m][1];
#pragma unroll
                    for (int j = 0; j < 4; ++j) { if (ACT == 1) { const float a = fmaxf(v0[j], 0.f), b = fmaxf(v1[j], 0.f); v0[j] = a * a; v1[j] = b * b; } }
                    u32x4 w; w.x = cvt_pk_bf16(v0[0], v0[1]); w.y = cvt_pk_bf16(v0[2], v0[3]); w.z = cvt_pk_bf16(v1[0], v1[1]); w.w = cvt_pk_bf16(v1[2], v1[3]);
                    *(u32x4*)(rowp + bj * HALF) = w;
                }
            }
    }
};
struct EpiF32 {
    static constexpr bool PERM = false, FOLD = false;
    float* C; int ldc;
    __device__ __forceinline__ void operator()(const f32x4 (&acc)[2][2][4][2], const Unit& u, int wr, int wc, int fr, int fq) const {
        const int row0 = u.pm * BM + wr * 64 + fr, col0 = u.pn * BM + wc * 32 + 4 * fq;
#pragma unroll
        for (int ai = 0; ai < 2; ++ai)
#pragma unroll
            for (int m = 0; m < 4; ++m) {
                float* rowp = C + (size_t)(row0 + ai * HALF + m * 16) * ldc + col0;
#pragma unroll
                for (int bj = 0; bj < 2; ++bj)
#pragma unroll
                    for (int n = 0; n < 2; ++n) *(f32x4*)(rowp + bj * HALF + n * 16) = acc[ai][bj][m][n];
            }
    }
};
struct EpiMergeFold {
    static constexpr bool PERM = true, FOLD = true;
    const bf16_t* gate;
    bf16_t* MBo;
    static __device__ __forceinline__ void unpack8(const u32x4 w, float (&f)[8]) {
        f[0] = bflo(w.x); f[1] = bfhi(w.x); f[2] = bflo(w.y); f[3] = bfhi(w.y); f[4] = bflo(w.z); f[5] = bfhi(w.z); f[6] = bflo(w.w); f[7] = bfhi(w.w);
#pragma unroll
        for (int j = 0; j < 8; ++j) f[j] = fmaxf(f[j], 1e-30f);
    }
    static __device__ __forceinline__ float ratio(float n, float d) { return fmaxf(n, 1e-30f) * __builtin_amdgcn_rcpf(fmaxf(d, 1e-30f)); }
    __device__ __forceinline__ void fold(f32x4 (&acc)[2][2][4][2], const Unit& u, int nb, int wr, int wc, int fr, int fq) const {
        const bf16_t* gbase = gate + (size_t)(u.pm * BM + wr * 64 + fr) * NP + (size_t)nb * DM + (u.pn * BM + wc * 32 + 8 * fq);
#pragma unroll
        for (int ai = 0; ai < 2; ++ai) {
            u32x4 wn[4][2], wd[4][2];
#pragma unroll
            for (int m = 0; m < 4; ++m)
#pragma unroll
                for (int bj = 0; bj < 2; ++bj) {
                    const bf16_t* gp = gbase + (size_t)(ai * HALF + m * 16) * NP + bj * HALF;
                    wn[m][bj] = *(const u32x4*)(gp - DM);
                    wd[m][bj] = *(const u32x4*)gp;
                }
#pragma unroll
            for (int m = 0; m < 4; ++m)
#pragma unroll
                for (int bj = 0; bj < 2; ++bj) {
                    const u32x4 a = wn[m][bj], d = wd[m][bj];
                    f32x4 r0, r1;
                    r0[0] = ratio(bflo(a.x), bflo(d.x)); r0[1] = ratio(bfhi(a.x), bfhi(d.x)); r0[2] = ratio(bflo(a.y), bflo(d.y)); r0[3] = ratio(bfhi(a.y), bfhi(d.y));
                    r1[0] = ratio(bflo(a.z), bflo(d.z)); r1[1] = ratio(bfhi(a.z), bfhi(d.z)); r1[2] = ratio(bflo(a.w), bflo(d.w)); r1[3] = ratio(bfhi(a.w), bfhi(d.w));
                    acc[ai][bj][m][0] *= r0; acc[ai][bj][m][1] *= r1;
                }
            asm volatile("" ::: "memory");
        }
    }
    __device__ __forceinline__ void operator()(const f32x4 (&acc)[2][2][4][2], const Unit& u, int wr, int wc, int fr, int fq) const {
        const int row0 = u.pm * BM + wr * 64 + fr, col0 = u.pn * BM + wc * 32 + 8 * fq;
        u32x4 gw[2][4][2];
#pragma unroll
        for (int ai = 0; ai < 2; ++ai)
#pragma unroll
            for (int m = 0; m < 4; ++m)
#pragma unroll
                for (int bj = 0; bj < 2; ++bj) gw[ai][m][bj] = *(const u32x4*)(gate + (size_t)(row0 + ai * HALF + m * 16) * NP + (size_t)3 * DM + col0 + bj * HALF);
#pragma unroll
        for (int ai = 0; ai < 2; ++ai)
#pragma unroll
            for (int m = 0; m < 4; ++m) {
                bf16_t* rowp = MBo + (size_t)(row0 + ai * HALF + m * 16) * DM + col0;
#pragma unroll
                for (int bj = 0; bj < 2; ++bj) {
                    float g[8]; unpack8(gw[ai][m][bj], g);
                    const f32x4 v0 = acc[ai][bj][m][0], v1 = acc[ai][bj][m][1];
                    u32x4 w; w.x = cvt_pk_bf16(v0[0] * g[0], v0[1] * g[1]); w.y = cvt_pk_bf16(v0[2] * g[2], v0[3] * g[3]); w.z = cvt_pk_bf16(v1[0] * g[4], v1[1] * g[5]); w.w = cvt_pk_bf16(v1[2] * g[6], v1[3] * g[7]);
                    *(u32x4*)(rowp + bj * HALF) = w;
                }
            }
    }
};

template <class Epi, class Sched, bool ALIGN_EPI = true, bool SP2 = true>
__device__ __forceinline__ void gemm_phase(LAS unsigned char* lds, const Gemm g, const Sched& S, const Epi& E) {
    int tid = threadIdx.x; asm volatile("" : "+v"(tid));
    const int wid = __builtin_amdgcn_readfirstlane(tid >> 6), lane = tid & 63, wr = wid >> 2, wc = wid & 3, fr = lane & 15, fq = lane >> 4;
    const int K = g.K, nt = K / BK;
    unsigned voffA[2], voffB[2];
#pragma unroll
    for (int i = 0; i < 2; ++i) { int R, C; stage_rc(tid * 16 + i * 8192, R, C); const int Rb = Epi::PERM ? ((R & ~31) + perm32(R & 31)) : R;
        voffA[i] = (unsigned)(R * K + C) * 2u; voffB[i] = (unsigned)(Rb * K + C) * 2u; }
    const size_t kstep = (size_t)(BK * 2);
    const size_t hstep = (size_t)HALF * K * 2;
    const size_t tstep = 2 * hstep;
    const unsigned ldsw = (unsigned)wid * 1024u;
    const int aoff = lds_byte(wr * 64 + fr, fq * 8), boff = lds_byte(wc * 32 + fr, fq * 8);
#define PG8_SA(b, h) (((b) * 2 + (h)) * HTB)
#define PG8_SB(b, h) ((4 + (b) * 2 + (h)) * HTB)
#define PG8_STAGE(bufoff, gbase, voff) do { _Pragma("unroll") for (int _i = 0; _i < 2; ++_i) \
        __builtin_amdgcn_global_load_lds((const unsigned*)((const char*)(gbase) + (voff)[_i]), (LAS unsigned*)(lds + (bufoff) + ldsw + _i * 8192), 16, 0, 0); } while (0)
#define PG8_LDA(dst, b, h) do { _Pragma("unroll") for (int m = 0; m < 4; ++m) _Pragma("unroll") for (int k = 0; k < 2; ++k) dst[m][k] = *(const LAS bf16x8*)(lds + PG8_SA(b, h) + aoff + m * 2048 + k * 1024); } while (0)
#define PG8_LDB(dst, b, h) do { _Pragma("unroll") for (int n = 0; n < 2; ++n) _Pragma("unroll") for (int k = 0; k < 2; ++k) dst[n][k] = *(const LAS bf16x8*)(lds + PG8_SB(b, h) + boff + n * 2048 + k * 1024); } while (0)
#define PG8_MMA(ai, bj, At, Bt) do { __builtin_amdgcn_s_setprio(1); _Pragma("unroll") for (int m = 0; m < 4; ++m) _Pragma("unroll") for (int n = 0; n < 2; ++n) _Pragma("unroll") for (int k = 0; k < 2; ++k) \
        acc[ai][bj][m][n] = __builtin_amdgcn_mfma_f32_16x16x32_bf16(Bt[n][k], At[m][k], acc[ai][bj][m][n], 0, 0, 0); __builtin_amdgcn_s_setprio(0); } while (0)
#define PG8_WAIT_V(n) asm volatile("s_waitcnt vmcnt(" #n ")" ::: "memory")
#define PG8_WAIT_L(n) asm volatile("s_waitcnt lgkmcnt(" #n ")" ::: "memory")
#define PG8_BAR __builtin_amdgcn_s_barrier()
#define PG8_SCHED __builtin_amdgcn_sched_barrier(0)
    Unit cur, nxt; int ui = 0;
    if (!S.next(0, cur)) return;
    f32x4 acc[2][2][4][2];
#pragma unroll
    for (int a = 0; a < 2; ++a)
#pragma unroll
        for (int b = 0; b < 2; ++b)
#pragma unroll
            for (int m = 0; m < 4; ++m)
#pragma unroll
                for (int n = 0; n < 2; ++n) acc[a][b][m][n] = (f32x4){0.f, 0.f, 0.f, 0.f};
    bf16x8 At[4][2], B0[2][2], B1[2][2];
    const char* cA = (const char*)g.A + (size_t)cur.pm * tstep; const char* cB = (const char*)g.Bt + (size_t)cur.pn * tstep;
    if constexpr (SP2) {
        PG8_STAGE(PG8_SB(0, 0), cB, voffB); PG8_STAGE(PG8_SB(0, 1), cB + hstep, voffB); PG8_STAGE(PG8_SA(0, 0), cA, voffA); PG8_STAGE(PG8_SA(0, 1), cA + hstep, voffA);
        if (wr == 1) PG8_BAR;
        PG8_WAIT_V(2); PG8_BAR;
        PG8_STAGE(PG8_SB(1, 0), cB + kstep, voffB); PG8_STAGE(PG8_SA(1, 0), cA + kstep, voffA); PG8_STAGE(PG8_SB(1, 1), cB + hstep + kstep, voffB);
        PG8_WAIT_V(6); PG8_BAR;
    } else {
        PG8_STAGE(PG8_SB(0, 0), cB, voffB); PG8_STAGE(PG8_SA(0, 0), cA, voffA); PG8_STAGE(PG8_SB(0, 1), cB + hstep, voffB); PG8_STAGE(PG8_SA(0, 1), cA + hstep, voffA);
        if (wr == 1) PG8_BAR;
        PG8_WAIT_V(4); PG8_BAR;
        PG8_STAGE(PG8_SB(1, 0), cB + kstep, voffB); PG8_STAGE(PG8_SA(1, 0), cA + kstep, voffA); PG8_STAGE(PG8_SB(1, 1), cB + hstep + kstep, voffB);
        PG8_WAIT_V(6); PG8_BAR;
    }
    for (;;) {
        const bool has_next = S.next(ui + 1, nxt);
        const char* nA = has_next ? (const char*)g.A + (size_t)nxt.pm * tstep : cA; const char* nB = has_next ? (const char*)g.Bt + (size_t)nxt.pn * tstep : cB;
        for (int t = 0; t < nt; t += 2) {
            const bool last = (t == nt - 2);
            const char* a1 = cA + (size_t)(t + 1) * kstep;
            const char* a2 = last ? nA : cA + (size_t)(t + 2) * kstep; const char* b2 = last ? nB : cB + (size_t)(t + 2) * kstep;
            const char* a3 = a2 + kstep; const char* b3 = b2 + kstep;
            if constexpr (Epi::FOLD) { if (t > 0 && (t & 7) == 0) E.fold(acc, cur, t >> 3, wr, wc, fr, fq); }
            if constexpr (SP2) {
            PG8_LDB(B0, 0, 0); PG8_LDB(B1, 0, 1); PG8_SCHED; PG8_LDA(At, 0, 0); PG8_STAGE(PG8_SA(1, 1), a1 + hstep, voffA);
            PG8_WAIT_V(8); PG8_WAIT_L(0); PG8_BAR; PG8_MMA(0, 0, At, B0); PG8_MMA(0, 1, At, B1); PG8_BAR; PG8_SCHED;
            PG8_LDA(At, 0, 1); PG8_STAGE(PG8_SB(0, 0), b2, voffB); PG8_STAGE(PG8_SB(0, 1), b2 + hstep, voffB); PG8_STAGE(PG8_SA(0, 0), a2, voffA);
            PG8_WAIT_V(8); PG8_WAIT_L(0); PG8_BAR; PG8_MMA(1, 0, At, B0); PG8_MMA(1, 1, At, B1); PG8_BAR; PG8_SCHED;
            PG8_LDB(B0, 1, 0); PG8_LDB(B1, 1, 1); PG8_SCHED; PG8_LDA(At, 1, 0); PG8_STAGE(PG8_SA(0, 1), a2 + hstep, voffA);
            PG8_WAIT_V(8); PG8_WAIT_L(0); PG8_BAR; PG8_MMA(0, 0, At, B0); PG8_MMA(0, 1, At, B1); PG8_BAR; PG8_SCHED;
            PG8_LDA(At, 1, 1); PG8_STAGE(PG8_SB(1, 0), b3, voffB); PG8_STAGE(PG8_SB(1, 1), b3 + hstep, voffB); PG8_STAGE(PG8_SA(1, 0), a3, voffA);
            PG8_WAIT_V(8); PG8_WAIT_L(0); PG8_BAR; PG8_MMA(1, 0, At, B0); PG8_MMA(1, 1, At, B1); PG8_BAR; PG8_SCHED;
            } else {
            PG8_LDB(B0, 0, 0); PG8_SCHED; PG8_LDA(At, 0, 0); PG8_STAGE(PG8_SA(1, 1), a1 + hstep, voffA);
            PG8_WAIT_L(8); PG8_BAR; PG8_WAIT_L(0); PG8_MMA(0, 0, At, B0); PG8_BAR; PG8_SCHED;
            PG8_LDB(B1, 0, 1); PG8_STAGE(PG8_SB(0, 0), b2, voffB);
            PG8_BAR; PG8_WAIT_L(0); PG8_MMA(0, 1, At, B1); PG8_BAR;
            PG8_LDA(At, 0, 1); PG8_STAGE(PG8_SA(0, 0), a2, voffA);
            PG8_BAR; PG8_WAIT_L(0); PG8_MMA(1, 0, At, B0); PG8_BAR; PG8_SCHED;
            PG8_STAGE(PG8_SB(0, 1), b2 + hstep, voffB);
            PG8_WAIT_V(6); PG8_BAR; PG8_MMA(1, 1, At, B1); PG8_BAR;
            PG8_LDB(B0, 1, 0); PG8_SCHED; PG8_LDA(At, 1, 0); PG8_STAGE(PG8_SA(0, 1), a2 + hstep, voffA);
            PG8_WAIT_L(8); PG8_BAR; PG8_WAIT_L(0); PG8_MMA(0, 0, At, B0); PG8_BAR; PG8_SCHED;
            PG8_LDB(B1, 1, 1); PG8_STAGE(PG8_SB(1, 0), b3, voffB);
            PG8_BAR; PG8_WAIT_L(0); PG8_MMA(0, 1, At, B1); PG8_BAR;
            PG8_LDA(At, 1, 1); PG8_STAGE(PG8_SA(1, 0), a3, voffA);
            PG8_BAR; PG8_WAIT_L(0); PG8_MMA(1, 0, At, B0); PG8_BAR; PG8_SCHED;
            PG8_STAGE(PG8_SB(1, 1), b3 + hstep, voffB);
            PG8_WAIT_V(6); PG8_BAR; PG8_MMA(1, 1, At, B1); PG8_BAR;
            }
        }
        if constexpr (ALIGN_EPI) { if (wr == 0) PG8_BAR; }
        E(acc, cur, wr, wc, fr, fq);
        if (!has_next) break;
#pragma unroll
        for (int a = 0; a < 2; ++a)
#pragma unroll
            for (int b = 0; b < 2; ++b)
#pragma unroll
                for (int m = 0; m < 4; ++m)
#pragma unroll
                    for (int n = 0; n < 2; ++n) acc[a][b][m][n] = (f32x4){0.f, 0.f, 0.f, 0.f};
        cur = nxt; cA = nA; cB = nB; ++ui;
        if constexpr (ALIGN_EPI) { if (wr == 1) PG8_BAR; }
    }
    PG8_WAIT_V(0);
    if constexpr (!ALIGN_EPI) { if (wr == 0) PG8_BAR; }
    PG8_BAR;
#undef PG8_SA
#undef PG8_SB
#undef PG8_STAGE
#undef PG8_LDA
#undef PG8_LDB
#undef PG8_MMA
#undef PG8_WAIT_V
#undef PG8_WAIT_L
#undef PG8_BAR
#undef PG8_SCHED
}
}

struct Args {
    const float* x; const int* pos;
    const float *n_mix_pre, *n_mix_post, *n_ffn_pre, *n_ffn_post, *w_in, *gm_ln_g, *gm_ln_b, *gm_w_s, *gm_b_s, *da_lambda, *da_subln_g, *fa_b_f,
                *pool_w, *pool_scale, *w_branch, *w_out, *w_ffn_up, *w_ffn_down;
    float* out; unsigned char* ws;
};

struct TrDesc { const float* sp; size_t ld; bf16_t* dp; int K; float scale; bool ok; };
__device__ __forceinline__ void tr_load(const TrDesc& d, f32x4 (&v)[16]) {
#pragma unroll
    for (int i = 0; i < 16; ++i) v[i] = d.ok ? __builtin_nontemporal_load((const f32x4*)(d.sp + (size_t)(4 * i) * d.ld)) : (f32x4){0.f, 0.f, 0.f, 0.f};
}
__device__ __forceinline__ void tr_finish(const TrDesc& d, const f32x4 (&v)[16], LAS float* scr, int lane) {
    const int c4 = (lane & 15) * 4, kr = lane >> 4;
#pragma unroll
    for (int i = 0; i < 16; ++i) {
        LAS float* p = scr + (4 * i + kr) * 65 + c4;
        p[0] = v[i][0] * d.scale; p[1] = v[i][1] * d.scale; p[2] = v[i][2] * d.scale; p[3] = v[i][3] * d.scale;
    }
    LDS_WAIT();
    const int c = lane & 7;
#pragma unroll
    for (int j = 0; j < 8; ++j) {
        const int n = (lane >> 3) + 8 * j;
        const LAS float* s = scr + (8 * c) * 65 + n;
        u32x4 o; o.x = pg8::cvt_pk_bf16(s[0], s[65]); o.y = pg8::cvt_pk_bf16(s[2 * 65], s[3 * 65]); o.z = pg8::cvt_pk_bf16(s[4 * 65], s[5 * 65]); o.w = pg8::cvt_pk_bf16(s[6 * 65], s[7 * 65]);
        *(u32x4*)(d.dp + (size_t)n * d.K + 8 * c) = o;
    }
    LDS_WAIT();
}

__device__ __forceinline__ void rms_row_bf16(const float* xrow, const f32x4 (&gv)[8], bf16_t* orow, int lane) {
    f32x4 v[8]; float s = 0.f;
#pragma unroll
    for (int j = 0; j < 8; ++j) { v[j] = *((const f32x4*)xrow + lane + 64 * j); s += (v[j][0] * v[j][0] + v[j][1] * v[j][1]) + (v[j][2] * v[j][2] + v[j][3] * v[j][3]); }
    const float rstd = 1.0f / sqrtf(wave_sum(s) * (1.0f / DM) + NORM_EPS);
#pragma unroll
    for (int j = 0; j < 8; ++j) {
        u32x2 w; w.x = pk2(v[j][0] * rstd * gv[j][0], v[j][1] * rstd * gv[j][1]); w.y = pk2(v[j][2] * rstd * gv[j][2], v[j][3] * rstd * gv[j][3]);
        *((u32x2*)orow + lane + 64 * j) = w;
    }
}

__device__ __forceinline__ void phase0(const Args& a, LAS unsigned char* lds, int gw, int NGW, int wave, int lane) {
    LAS float* scr = (LAS float*)(lds + wave * 16640);
    constexpr int I_IN = 32 * 204, I_BR = 4 * 8 * 32, I_OUT = 32 * 32, I_UP = 32 * 128, I_DN = 128 * 32, I_POOL = 16;
    constexpr int I_LAYER = I_IN + I_BR + I_OUT + I_UP + I_DN + I_POOL, I_ALL = DEPTH * I_LAYER;
    const int c4 = (lane & 15) * 4, kr = lane >> 4;
    auto decode = [&](int it) -> TrDesc {
        const int l = it / I_LAYER; int r = it - l * I_LAYER;
        unsigned char* wl = a.ws + WS_W + (size_t)l * WL_STRIDE;
        const float* src; size_t ld; int sc, nv = 64, k0, n0, K; bf16_t* dst; float scale = 1.0f;
        if (r < I_IN) {
            const int kb = r / 204, nb = r % 204; n0 = nb * 64; k0 = kb * 64;
            if (nb < 64) { sc = n0; } else if (nb < 200) { sc = n0 + 4; } else if (nb == 200) { sc = 4096; nv = 4; } else { sc = 0; nv = 0; }
            src = a.w_in + (size_t)l * DM * INC; ld = INC; dst = (bf16_t*)(wl + WO_IN); K = DM;
            scale = (nb >= 72 && nb < 200) ? -LOG2E : 1.0f;
        } else if ((r -= I_IN) < I_BR) {
            const int n = r / 256, rr = r % 256, kb = rr / 32, nb = rr % 32; n0 = nb * 64; k0 = kb * 64; sc = n0;
            src = a.w_branch + ((size_t)l * 4 + n) * 512 * DM; ld = DM; dst = (bf16_t*)(wl + WO_BR) + n * 512; K = DM;
        } else if ((r -= I_BR) < I_OUT) {
            const int kb = r / 32, nb = r % 32; n0 = nb * 64; k0 = kb * 64; sc = n0;
            src = a.w_out + (size_t)l * DM * DM; ld = DM; dst = (bf16_t*)(wl + WO_OUT); K = DM;
        } else if ((r -= I_OUT) < I_UP) {
            const int kb = r / 128, nb = r % 128; n0 = nb * 64; k0 = kb * 64; sc = n0;
            src = a.w_ffn_up + (size_t)l * DM * FFN; ld = FFN; dst = (bf16_t*)(wl + WO_UP); K = DM;
        } else if ((r -= I_UP) < I_DN) {
            const int kb = r / 32, nb = r % 32; n0 = nb * 64; k0 = kb * 64; sc = n0;
            src = a.w_ffn_down + (size_t)l * FFN * DM; ld = DM; dst = (bf16_t*)(wl + WO_DN); K = FFN;
        } else {
            r -= I_DN;
            const int g = r / 4, rr = r % 4, kb = rr / 2, nb = rr % 2; n0 = nb * 64; k0 = kb * 64; sc = n0;
            src = a.pool_w + ((size_t)l * 4 + g) * 128 * 128; ld = 128; dst = (bf16_t*)(wl + WO_POOL) + (size_t)g * 128 * 128; K = 128;
        }
        TrDesc d; d.sp = src + (size_t)(k0 + kr) * ld + sc + c4; d.ld = ld; d.dp = dst + (size_t)n0 * K + k0; d.K = K; d.scale = scale; d.ok = c4 < nv;
        return d;
    };
    {
        int it = gw; TrDesc dA, dB; f32x4 vA[16], vB[16];
        if (it < I_ALL) { dA = decode(it); tr_load(dA, vA); }
        while (it < I_ALL) {
            const int itB = it + NGW;
            if (itB < I_ALL) { dB = decode(itB); tr_load(dB, vB); }
            tr_finish(dA, vA, scr, lane);
            const int itA = itB + NGW;
            if (itA < I_ALL) { dA = decode(itA); tr_load(dA, vA); }
            if (itB < I_ALL) tr_finish(dB, vB, scr, lane);
            it = itA;
        }
    }
    {
        float* rot = (float*)(a.ws + WS_ROT);
        const float inv[8] = {1.0f, 0.193922758102417f, 0.03760603070259094f, 0.00729266507551074f, 0.001414213445968926f, 0.00027424818836152554f, 5.318296462064609e-05f, 1.0313385246263351e-05f};
        for (int e = gw * 64 + lane; e < MROWS * 8; e += NGW * 64) {
            const int row = e >> 3, i = e & 7;
            float iv = inv[0];
#pragma unroll
            for (int q = 1; q < 8; ++q) iv = (i == q) ? inv[q] : iv;
            const float ang = (float)a.pos[row] * iv;
            const double ad = (double)ang;
            const double kk = __builtin_rint(ad * 0.15915494309189535);
            const float rr = (float)(ad - kk * 6.283185307179586);
            rot[2 * e] = cosf(rr); rot[2 * e + 1] = sinf(rr);
        }
    }
    {
        f32x4 g0[8];
#pragma unroll
        for (int j = 0; j < 8; ++j) g0[j] = *((const f32x4*)a.n_mix_pre + lane + 64 * j);
        for (int m = gw; m < MROWS; m += NGW) rms_row_bf16(a.x + (size_t)m * DM, g0, (bf16_t*)(a.ws + WS_XN) + (size_t)m * DM, lane);
    }
}

template <bool HIN_BF, bool HOUT_BF>
__device__ __forceinline__ void row_phase(const bf16_t* Y, const void* hin, void* hout, const float* gpost, const float* gpre, bf16_t* XN, int gw, int NGW, int lane) {
    f32x4 gpo[8], gpr[8];
#pragma unroll
    for (int j = 0; j < 8; ++j) { gpo[j] = *((const f32x4*)gpost + lane + 64 * j); gpr[j] = gpre ? *((const f32x4*)gpre + lane + 64 * j) : (f32x4){0.f, 0.f, 0.f, 0.f}; }
    for (int m = gw; m < MROWS; m += NGW) {
        const u32x2* yr = (const u32x2*)(Y + (size_t)m * DM);
        u32x2 yw[8]; u32x2 hw[8]; f32x4 hf[8];
#pragma unroll
        for (int j = 0; j < 8; ++j) yw[j] = yr[lane + 64 * j];
#pragma unroll
        for (int j = 0; j < 8; ++j) {
            if (HIN_BF) hw[j] = *((const u32x2*)((const bf16_t*)hin + (size_t)m * DM) + lane + 64 * j);
            else hf[j] = *((const f32x4*)((const float*)hin + (size_t)m * DM) + lane + 64 * j);
        }
        f32x4 v[8]; float s = 0.f;
#pragma unroll
        for (int j = 0; j < 8; ++j) { v[j] = (f32x4){bflo(yw[j].x), bfhi(yw[j].x), bflo(yw[j].y), bfhi(yw[j].y)}; s += (v[j][0] * v[j][0] + v[j][1] * v[j][1]) + (v[j][2] * v[j][2] + v[j][3] * v[j][3]); }
        const float rstd = 1.0f / sqrtf(wave_sum(s) * (1.0f / DM) + NORM_EPS);
        float s2 = 0.f;
#pragma unroll
        for (int j = 0; j < 8; ++j) {
            f32x4 h;
            if (HIN_BF) h = (f32x4){bflo(hw[j].x), bfhi(hw[j].x), bflo(hw[j].y), bfhi(hw[j].y)}; else h = hf[j];
            v[j] = h + v[j] * rstd * gpo[j];
            if (HOUT_BF) { u32x2 w; w.x = pk2(v[j][0], v[j][1]); w.y = pk2(v[j][2], v[j][3]); *((u32x2*)((bf16_t*)hout + (size_t)m * DM) + lane + 64 * j) = w; }
            else *((f32x4*)((float*)hout + (size_t)m * DM) + lane + 64 * j) = v[j];
            s2 += (v[j][0] * v[j][0] + v[j][1] * v[j][1]) + (v[j][2] * v[j][2] + v[j][3] * v[j][3]);
        }
        if (gpre) {
            const float rstd2 = 1.0f / sqrtf(wave_sum(s2) * (1.0f / DM) + NORM_EPS);
#pragma unroll
            for (int j = 0; j < 8; ++j) {
                const f32x4 gv = gpr[j];
                u32x2 w; w.x = pk2(v[j][0] * rstd2 * gv[0], v[j][1] * rstd2 * gv[1]); w.y = pk2(v[j][2] * rstd2 * gv[2], v[j][3] * rstd2 * gv[3]);
                *((u32x2*)(XN + (size_t)m * DM) + lane + 64 * j) = w;
            }
        }
    }
}

constexpr int KSTR = 272;
constexpr int VSTR = 144;
constexpr int KBUF = 64 * KSTR;
constexpr int VBUF = 128 * VSTR;
constexpr int L_K0 = 0, L_V0 = 2 * KBUF, L_CUM = L_V0 + 2 * VBUF  , L_STAT = L_CUM + 8192  , L_WT = L_STAT + 1024  ;

struct KRegs { u32x4 a, b; };
struct VRegs { u32x4 a, b; };

__device__ __forceinline__ KRegs k_load(const bf16_t* base  , int tid) {
    const bf16_t* p = base + (size_t)(tid >> 3) * NP + (tid & 7) * 16;
    KRegs r; r.a = *(const u32x4*)p; r.b = *(const u32x4*)(p + 8); return r;
}
__device__ __forceinline__ void k_store(LAS unsigned char* buf, const KRegs& r, int tid) {
    LAS unsigned char* d = buf + (tid >> 3) * KSTR + (tid & 7) * 32;
    *(LAS u32x4*)d = r.a; *(LAS u32x4*)(d + 16) = r.b;
}
__device__ __forceinline__ void v_map(int tid, int& chunk, int& pair) { const int w = tid >> 6, l = tid & 63; chunk = 4 * (w & 3) + (l & 3); pair = 16 * (w >> 2) + (l >> 2); }
__device__ __forceinline__ VRegs v_load(const bf16_t* base, int tid) {
    int chunk, pair; v_map(tid, chunk, pair);
    const bf16_t* p = base + (size_t)(2 * pair) * NP + chunk * 8;
    VRegs r; r.a = *(const u32x4*)p; r.b = *(const u32x4*)(p + NP); return r;
}
__device__ __forceinline__ void v_store_words(LAS unsigned char* buf, const unsigned (&wa)[4], const unsigned (&wb)[4], int tid) {
    int chunk, pair; v_map(tid, chunk, pair);
    LAS unsigned char* d = buf + (8 * chunk) * VSTR + pair * 4;
#pragma unroll
    for (int i = 0; i < 4; ++i) {
        *(LAS unsigned*)(d + (2 * i) * VSTR) = (wa[i] & 0xffffu) | (wb[i] << 16);
        *(LAS unsigned*)(d + (2 * i + 1) * VSTR) = (wa[i] >> 16) | (wb[i] & 0xffff0000u);
    }
}
__device__ __forceinline__ void v_store(LAS unsigned char* buf, const VRegs& r, int tid) {
    const unsigned wa[4] = {r.a.x, r.a.y, r.a.z, r.a.w}, wb[4] = {r.b.x, r.b.y, r.b.z, r.b.w};
    v_store_words(buf, wa, wb, tid);
}

__device__ __forceinline__ void pv_mma(f32x4 (&o)[8], const LAS unsigned char* vbuf, const bf16x8 (&pf)[2], int lane) {
    const LAS unsigned char* vp = vbuf + (lane & 15) * VSTR + (lane >> 4) * 16;
#pragma unroll
    for (int mb = 0; mb < 8; ++mb)
#pragma unroll
        for (int pr = 0; pr < 2; ++pr) {
            const bf16x8 vf = *(const LAS bf16x8*)(vp + mb * 16 * VSTR + pr * 64);
            o[mb] = __builtin_amdgcn_mfma_f32_16x16x32_bf16(vf, pf[pr], o[mb], 0, 0, 0);
        }
}

__device__ __forceinline__ void softmax_tile(f32x4 (&s)[4], const f32x4 (&add)[4], float cs, float& lsum, bf16x8 (&pf)[2]) {
    float ps = 0.f;
#pragma unroll
    for (int rb = 0; rb < 4; ++rb)
#pragma unroll
        for (int j = 0; j < 4; ++j) { s[rb][j] = __builtin_amdgcn_exp2f(fminf(fmaf(s[rb][j], cs, add[rb][j]), 126.f)); ps += s[rb][j]; }
    lsum += ps;
#pragma unroll
    for (int pr = 0; pr < 2; ++pr) {
        u32x4 w; w.x = pg8::cvt_pk_bf16(s[2 * pr][0], s[2 * pr][1]); w.y = pg8::cvt_pk_bf16(s[2 * pr][2], s[2 * pr][3]); w.z = pg8::cvt_pk_bf16(s[2 * pr + 1][0], s[2 * pr + 1][1]); w.w = pg8::cvt_pk_bf16(s[2 * pr + 1][2], s[2 * pr + 1][3]);
        pf[pr] = __builtin_bit_cast(bf16x8, w);
    }
}

template <bool DIFF>
__device__ __forceinline__ void attn_unit(const Args& a, int layer, int bh, int qb, LAS unsigned char* lds, int tid) {
    const int wave = tid >> 6, lane = tid & 63, l15 = lane & 15, quad = lane >> 4;
    const int b = bh >> 2, h = bh & 3;
    const bf16_t* proj = (const bf16_t*)(a.ws + WS_PROJ) + (size_t)b * SEQ * NP;
    const bf16_t* Qg = proj + (DIFF ? P_BQ : P_CQ) + h * 128;
    const bf16_t* Kg = proj + (DIFF ? P_BK : P_CK) + h * 128;
    const bf16_t* Vg = proj + (DIFF ? P_BV : P_CV) + h * 128;
    const int q0 = qb * 128, ntiles = 2 * qb + 2;
    __syncthreads();
    { KRegs r0 = k_load(Qg + (size_t)q0 * NP, tid), r1 = k_load(Qg + (size_t)(q0 + 64) * NP, tid);
      k_store(lds + L_K0, r0, tid); k_store(lds + L_K0 + KBUF, r1, tid); }
    if (!DIFF) {
        const float* fl = (const float*)(a.ws + WS_FLOG) + (size_t)b * SEQ * 4 + h;
        const int nk = q0 + 128;
        float v[4];
#pragma unroll
        for (int i = 0; i < 4; ++i) {
            const int k = 4 * tid + i;
            float z = (k < nk) ? fl[(size_t)k * 4] : 0.f;
            float ls = fminf(z, 0.f) - log1pf(expf(-fabsf(z)));
            v[i] = (k < nk) ? ls : 0.f;
        }
        const float s0 = v[0], s1 = s0 + v[1], s2 = s1 + v[2], s3 = s2 + v[3];
        float x = s3;
#pragma unroll
        for (int d = 1; d < 64; d <<= 1) { const float y = __shfl_up(x, d); if (lane >= d) x += y; }
        LAS float* wt = (LAS float*)(lds + L_WT);
        if (lane == 63) wt[wave] = x;
        __syncthreads();
        float off = 0.f;
#pragma unroll
        for (int w = 0; w < 8; ++w) off += (w < wave) ? wt[w] : 0.f;
        const float ex = off + x - s3;
        LAS f32x4* cum = (LAS f32x4*)(lds + L_CUM);
        cum[tid] = (f32x4){(ex + s0) * LOG2E, (ex + s1) * LOG2E, (ex + s2) * LOG2E, (ex + s3) * LOG2E};
    }
    __syncthreads();
    bf16x8 qf[4];
    {
        const LAS unsigned char* qp = lds + L_K0 + (wave * 16 + l15) * KSTR + quad * 16;
#pragma unroll
        for (int ks = 0; ks < 4; ++ks) qf[ks] = *(const LAS bf16x8*)(qp + ks * 64);
    }
    KRegs kr = k_load(Kg, tid); VRegs vr = v_load(Vg, tid);
    __syncthreads();

    constexpr int NMAP = DIFF ? 2 : 1;
    const float cs = (DIFF ? 0.125f : 0.08838834764831845f) * LOG2E;
    f32x4 o[NMAP][8]; float lsum[NMAP];
#pragma unroll
    for (int mp = 0; mp < NMAP; ++mp) { lsum[mp] = 0.f;
#pragma unroll
        for (int mb = 0; mb < 8; ++mb) o[mp][mb] = (f32x4){0.f, 0.f, 0.f, 0.f}; }
    const int qi = q0 + wave * 16 + l15;
    float cumq = 0.f; if (!DIFF) cumq = *(const LAS float*)(lds + L_CUM + qi * 4);

    for (int jt = 0; jt < ntiles; ++jt) {
        LAS unsigned char* kb = lds + L_K0 + (jt & 1) * KBUF;
        LAS unsigned char* vb = lds + L_V0 + (jt & 1) * VBUF;
        k_store(kb, kr, tid); v_store(vb, vr, tid);
        __syncthreads();
        if (jt + 1 < ntiles) { kr = k_load(Kg + (size_t)(jt + 1) * 64 * NP, tid); vr = v_load(Vg + (size_t)(jt + 1) * 64 * NP, tid); }
        f32x4 s[NMAP][4];
        {
            bf16x8 kf[4][4];
#pragma unroll
            for (int rb = 0; rb < 4; ++rb) {
                const int trow = 32 * (rb >> 1) + 8 * (l15 >> 2) + 4 * (rb & 1) + (l15 & 3);
                const LAS unsigned char* kp = kb + trow * KSTR + quad * 16;
#pragma unroll
                for (int ks = 0; ks < 4; ++ks) kf[rb][ks] = *(const LAS bf16x8*)(kp + ks * 64);
            }
            __builtin_amdgcn_sched_barrier(0);
#pragma unroll
            for (int rb = 0; rb < 4; ++rb) {
                if (DIFF) {
                    f32x4 c0 = (f32x4){0.f, 0.f, 0.f, 0.f}, c1 = c0;
                    c0 = __builtin_amdgcn_mfma_f32_16x16x32_bf16(kf[rb][0], qf[0], c0, 0, 0, 0);
                    c0 = __builtin_amdgcn_mfma_f32_16x16x32_bf16(kf[rb][1], qf[1], c0, 0, 0, 0);
                    c1 = __builtin_amdgcn_mfma_f32_16x16x32_bf16(kf[rb][2], qf[2], c1, 0, 0, 0);
                    c1 = __builtin_amdgcn_mfma_f32_16x16x32_bf16(kf[rb][3], qf[3], c1, 0, 0, 0);
                    s[0][rb] = c0; s[NMAP - 1][rb] = c1;
                } else {
                    f32x4 c0 = (f32x4){0.f, 0.f, 0.f, 0.f};
#pragma unroll
                    for (int ks = 0; ks < 4; ++ks) c0 = __builtin_amdgcn_mfma_f32_16x16x32_bf16(kf[rb][ks], qf[ks], c0, 0, 0, 0);
                    s[0][rb] = c0;
                }
            }
        }
        bf16x8 vf[8][2];
        {
            const LAS unsigned char* vp = vb + l15 * VSTR + quad * 16;
#pragma unroll
            for (int mb = 0; mb < 8; ++mb)
#pragma unroll
                for (int pr = 0; pr < 2; ++pr) vf[mb][pr] = *(const LAS bf16x8*)(vp + mb * 16 * VSTR + pr * 64);
        }
        __builtin_amdgcn_sched_barrier(0);
        f32x4 addv[4];
#pragma unroll
        for (int rb = 0; rb < 4; ++rb) {
            const int key0 = jt * 64 + 32 * (rb >> 1) + 8 * quad + 4 * (rb & 1);
            if (!DIFF) addv[rb] = cumq - *(const LAS f32x4*)(lds + L_CUM + key0 * 4);
            else addv[rb] = (f32x4){0.f, 0.f, 0.f, 0.f};
        }
        if (jt >= 2 * qb) {
#pragma unroll
            for (int rb = 0; rb < 4; ++rb) {
                const int key0 = jt * 64 + 32 * (rb >> 1) + 8 * quad + 4 * (rb & 1);
#pragma unroll
                for (int mp = 0; mp < NMAP; ++mp)
#pragma unroll
                    for (int j = 0; j < 4; ++j) s[mp][rb][j] = (key0 + j > qi) ? -INFINITY : s[mp][rb][j];
            }
        }
        bf16x8 pf[NMAP][2];
#pragma unroll
        for (int mp = 0; mp < NMAP; ++mp) softmax_tile(s[mp], addv, cs, lsum[mp], pf[mp]);
#pragma unroll
        for (int mb = 0; mb < 8; ++mb)
#pragma unroll
            for (int pr = 0; pr < 2; ++pr)
#pragma unroll
                for (int mp = 0; mp < NMAP; ++mp) o[mp][mb] = __builtin_amdgcn_mfma_f32_16x16x32_bf16(vf[mb][pr], pf[mp][pr], o[mp][mb], 0, 0, 0);
    }
    float inv[NMAP];
#pragma unroll
    for (int mp = 0; mp < NMAP; ++mp) { float l = lsum[mp]; l += __shfl_xor(l, 16); l += __shfl_xor(l, 32); inv[mp] = 1.0f / l; }
    const size_t orow = (size_t)b * SEQ + qi;
    if (DIFF) {
        const float li = 0.8f - 0.6f * expf(-0.3f * (float)layer);
        const float* lp = a.da_lambda + (size_t)layer * 256;
        float d1 = lp[lane] * lp[64 + lane], d2 = lp[128 + lane] * lp[192 + lane];
        d1 = wave_sum(d1); d2 = wave_sum(d2);
        const float lam = expf(d1) - expf(d2) + li;
        const float c1 = inv[0], c2 = lam * inv[NMAP - 1];
        float ss = 0.f;
#pragma unroll
        for (int mb = 0; mb < 8; ++mb) { o[0][mb] = o[0][mb] * c1 - o[NMAP - 1][mb] * c2; ss += (o[0][mb][0] * o[0][mb][0] + o[0][mb][1] * o[0][mb][1]) + (o[0][mb][2] * o[0][mb][2] + o[0][mb][3] * o[0][mb][3]); }
        ss += __shfl_xor(ss, 16); ss += __shfl_xor(ss, 32);
        const float rstd = (1.0f / sqrtf(ss * (1.0f / 128.0f) + NORM_EPS)) * (1.0f - li);
        const float* sg = a.da_subln_g + (size_t)layer * 128;
        bf16_t* op = (bf16_t*)(a.ws + WS_BR) + orow * DM + 1 * 512 + h * 128 + quad * 4;
        f32x4 sgv[8];
#pragma unroll
        for (int mb = 0; mb < 8; ++mb) sgv[mb] = *(const f32x4*)(sg + mb * 16 + quad * 4);
#pragma unroll
        for (int mb = 0; mb < 8; ++mb) {
            const f32x4 gv = sgv[mb];
            u32x2 w; w.x = pk2(o[0][mb][0] * rstd * gv[0], o[0][mb][1] * rstd * gv[1]); w.y = pk2(o[0][mb][2] * rstd * gv[2], o[0][mb][3] * rstd * gv[3]);
            *(u32x2*)(op + mb * 16) = w;
        }
    } else {
        bf16_t* op = (bf16_t*)(a.ws + WS_BR) + orow * DM + 2 * 512 + h * 128 + quad * 4;
#pragma unroll
        for (int mb = 0; mb < 8; ++mb) {
            const f32x4 v = o[0][mb] * inv[0];
            u32x2 w; w.x = pk2(v[0], v[1]); w.y = pk2(v[2], v[3]);
            *(u32x2*)(op + mb * 16) = w;
        }
    }
}

__device__ __forceinline__ void gmlp_unit(const Args& a, int layer, int unit, LAS unsigned char* lds, int tid) {
    const int wave = tid >> 6, lane = tid & 63, l15 = lane & 15, quad = lane >> 4;
    const int g = unit & 3, bn = unit >> 2;
    const size_t r0 = (size_t)bn * 128;
    const bf16_t* proj = (const bf16_t*)(a.ws + WS_PROJ) + r0 * NP;
    __syncthreads();
    LAS float* stat = (LAS float*)(lds + L_STAT);
    {
        const int t = wave * 16 + (lane >> 2), part = lane & 3;
        const bf16_t* vp = proj + (size_t)t * NP + P_AV + part * 128;
        u32x4 w[16];
#pragma unroll
        for (int j = 0; j < 16; ++j) w[j] = *(const u32x4*)(vp + j * 8);
        float s1 = 0.f, s2 = 0.f;
#pragma unroll
        for (int j = 0; j < 16; ++j) {
            const float f[8] = {bflo(w[j].x), bfhi(w[j].x), bflo(w[j].y), bfhi(w[j].y), bflo(w[j].z), bfhi(w[j].z), bflo(w[j].w), bfhi(w[j].w)};
#pragma unroll
            for (int e = 0; e < 8; ++e) { s1 += f[e]; s2 += f[e] * f[e]; }
        }
        s1 += __shfl_xor(s1, 1); s1 += __shfl_xor(s1, 2); s2 += __shfl_xor(s2, 1); s2 += __shfl_xor(s2, 2);
        const float mu = s1 * (1.0f / 512.0f), var = fmaxf(s2 * (1.0f / 512.0f) - mu * mu, 0.f);
        if (part == 0) { stat[2 * t] = mu; stat[2 * t + 1] = 1.0f / sqrtf(var + NORM_EPS); }
    }
    __syncthreads();
    {
        int chunk, pair; v_map(tid, chunk, pair);
        const float* lg = a.gm_ln_g + (size_t)layer * 512 + g * 128 + chunk * 8;
        const float* lb = a.gm_ln_b + (size_t)layer * 512 + g * 128 + chunk * 8;
        const f32x4 g0 = *(const f32x4*)lg, g1 = *(const f32x4*)(lg + 4), b0 = *(const f32x4*)lb, b1 = *(const f32x4*)(lb + 4);
        const float gg[8] = {g0[0], g0[1], g0[2], g0[3], g1[0], g1[1], g1[2], g1[3]};
        const float bb[8] = {b0[0], b0[1], b0[2], b0[3], b1[0], b1[1], b1[2], b1[3]};
#pragma unroll
        for (int half = 0; half < 2; ++half) {
            const VRegs r = v_load(proj + (size_t)(half * 64) * NP + P_AV + g * 128, tid);
            const int sA = half * 64 + 2 * pair, sB = sA + 1;
            const float muA = stat[2 * sA], rsA = stat[2 * sA + 1], muB = stat[2 * sB], rsB = stat[2 * sB + 1];
            const unsigned ra[4] = {r.a.x, r.a.y, r.a.z, r.a.w}, rb[4] = {r.b.x, r.b.y, r.b.z, r.b.w};
            unsigned wa[4], wb[4];
#pragma unroll
            for (int i = 0; i < 4; ++i) {
                wa[i] = pk2((bflo(ra[i]) - muA) * rsA * gg[2 * i] + bb[2 * i], (bfhi(ra[i]) - muA) * rsA * gg[2 * i + 1] + bb[2 * i + 1]);
                wb[i] = pk2((bflo(rb[i]) - muB) * rsB * gg[2 * i] + bb[2 * i], (bfhi(rb[i]) - muB) * rsB * gg[2 * i + 1] + bb[2 * i + 1]);
            }
            v_store_words(lds + L_V0 + half * VBUF, wa, wb, tid);
        }
    }
    __syncthreads();
    const int t = wave * 16 + l15;
    const float* W = a.gm_w_s + ((size_t)layer * 4 + g) * 128 * 128 + (size_t)t * 128;
    f32x4 o[8];
#pragma unroll
    for (int mb = 0; mb < 8; ++mb) o[mb] = (f32x4){0.f, 0.f, 0.f, 0.f};
#pragma unroll
    for (int st = 0; st < 2; ++st) {
        if (st * 64 <= wave * 16 + 15) {
            bf16x8 pf[2];
#pragma unroll
            for (int pr = 0; pr < 2; ++pr) {
                const int sbase = st * 64 + pr * 32 + quad * 8;
                const f32x4 w0 = *(const f32x4*)(W + sbase), w1 = *(const f32x4*)(W + sbase + 4);
                float f[8] = {w0[0], w0[1], w0[2], w0[3], w1[0], w1[1], w1[2], w1[3]};
#pragma unroll
                for (int j = 0; j < 8; ++j) f[j] = (sbase + j <= t) ? f[j] : 0.f;
                u32x4 w; w.x = pk2(f[0], f[1]); w.y = pk2(f[2], f[3]); w.z = pk2(f[4], f[5]); w.w = pk2(f[6], f[7]);
                pf[pr] = __builtin_bit_cast(bf16x8, w);
            }
            pv_mma(o, lds + L_V0 + st * VBUF, pf, lane);
        }
    }
    const float bs = a.gm_b_s[((size_t)layer * 4 + g) * 128 + t];
    const bf16_t* up = proj + (size_t)t * NP + P_AU + g * 128 + quad * 4;
    bf16_t* op = (bf16_t*)(a.ws + WS_BR) + (r0 + t) * DM + g * 128 + quad * 4;
    u32x2 uwv[8];
#pragma unroll
    for (int mb = 0; mb < 8; ++mb) uwv[mb] = *(const u32x2*)(up + mb * 16);
#pragma unroll
    for (int mb = 0; mb < 8; ++mb) {
        const u32x2 uw = uwv[mb];
        u32x2 w; w.x = pk2(bflo(uw.x) * (o[mb][0] + bs), bfhi(uw.x) * (o[mb][1] + bs)); w.y = pk2(bflo(uw.y) * (o[mb][2] + bs), bfhi(uw.y) * (o[mb][3] + bs));
        *(u32x2*)(op + mb * 16) = w;
    }
}

template <int G_>
__device__ __forceinline__ void pool_unit_t(const Args& a, int layer, int unit, int tid) {
    const int wave = tid >> 6, lane = tid & 63, l15 = lane & 15, quad = lane >> 4;
    constexpr int g = G_; const int tile = unit >> 2;
    const int t = wave * 16 + l15;
    const size_t row = (size_t)tile * 128 + t;
    const int tseq = (int)(row & (SEQ - 1));
    constexpr int win = 2 << g;
    const int cnt = (tseq + 1 < win) ? (tseq + 1) : win;
    const float rc = 1.0f / (float)cnt;
    const bf16_t* hp = (const bf16_t*)(a.ws + WS_PROJ) + row * NP + P_DH + g * 128 + quad * 8;
    const bf16_t* wp = (const bf16_t*)(a.ws + WS_W + (size_t)layer * WL_STRIDE + WO_POOL) + (size_t)g * 128 * 128 + (size_t)l15 * 128 + quad * 8;
    f32x4 o[8];
#pragma unroll
    for (int mb = 0; mb < 8; ++mb) o[mb] = (f32x4){0.f, 0.f, 0.f, 0.f};
#pragma unroll
    for (int ks = 0; ks < 4; ++ks) {
        float acc[8] = {0.f, 0.f, 0.f, 0.f, 0.f, 0.f, 0.f, 0.f};
        float self[8];
        u32x4 wv[win];
#pragma unroll
        for (int i = 0; i < win; ++i) wv[i] = (i < cnt) ? *(const u32x4*)(hp - (size_t)i * NP + ks * 32) : (u32x4){0u, 0u, 0u, 0u};
#pragma unroll
        for (int i = 0; i < win; ++i) {
            const u32x4 w = wv[i];
            const float f[8] = {bflo(w.x), bfhi(w.x), bflo(w.y), bfhi(w.y), bflo(w.z), bfhi(w.z), bflo(w.w), bfhi(w.w)};
#pragma unroll
            for (int j = 0; j < 8; ++j) { acc[j] += f[j]; if (i == 0) self[j] = f[j]; }
        }
        asm volatile("" ::: "memory");
        u32x4 pw; pw.x = pk2(acc[0] * rc - self[0], acc[1] * rc - self[1]); pw.y = pk2(acc[2] * rc - self[2], acc[3] * rc - self[3]);
        pw.z = pk2(acc[4] * rc - self[4], acc[5] * rc - self[5]); pw.w = pk2(acc[6] * rc - self[6], acc[7] * rc - self[7]);
        const bf16x8 pf = __builtin_bit_cast(bf16x8, pw);
#pragma unroll
        for (int mb = 0; mb < 8; ++mb) {
            const bf16x8 wf = *(const bf16x8*)(wp + (size_t)mb * 16 * 128 + ks * 32);
            o[mb] = __builtin_amdgcn_mfma_f32_16x16x32_bf16(wf, pf, o[mb], 0, 0, 0);
        }
    }
    const float* sc = a.pool_scale + (size_t)layer * 512 + g * 128 + quad * 4;
    bf16_t* op = (bf16_t*)(a.ws + WS_BR) + row * DM + 3 * 512 + g * 128 + quad * 4;
    f32x4 svv[8];
#pragma unroll
    for (int mb = 0; mb < 8; ++mb) svv[mb] = *(const f32x4*)(sc + mb * 16);
#pragma unroll
    for (int mb = 0; mb < 8; ++mb) {
        const f32x4 sv = svv[mb];
        u32x2 w; w.x = pk2(o[mb][0] * sv[0], o[mb][1] * sv[1]); w.y = pk2(o[mb][2] * sv[2], o[mb][3] * sv[3]);
        *(u32x2*)(op + mb * 16) = w;
    }
}

__device__ __forceinline__ void mixer_phase(const Args& a, int cidx, int layer, LAS unsigned char* lds, int tid_) {
    int tid = tid_; asm volatile("" : "+v"(tid));
    unsigned* ctr = (unsigned*)(a.ws + WS_CTL) + 64 * cidx;
    LAS unsigned* slot = (LAS unsigned*)(lds + LDS_MISC);
    {
        const unsigned char* wl = a.ws + WS_W + (size_t)layer * WL_STRIDE;
        pg8::Gemm g{(const bf16_t*)(a.ws + WS_XN), (const bf16_t*)(wl + WO_IN), MROWS, NIN, DM};
        pg8::InOrder S; S.init(MROWS, NIN, (int)gridDim.x, (int)blockIdx.x, gridDim.x == 256 ? 6 : (1 << 30), 1 << 30);
        pg8::EpiIn E{(bf16_t*)(a.ws + WS_PROJ), (float*)(a.ws + WS_FLOG), (const float*)(a.ws + WS_ROT), a.fa_b_f + layer * 4};
        pg8::gemm_phase<pg8::EpiIn, pg8::InOrder>(lds, g, S, E);
    }
    for (;;) {
        __syncthreads();
        if (tid == 0) slot[0] = atomicAdd(ctr, 1u);
        __syncthreads();
        const int idx = (int)slot[0];
        if (idx >= 1024) break;
        int tu = tid; asm volatile("" : "+v"(tu));
        if (idx < 512) {
            const int qb = 15 - (idx >> 5), r = idx & 31, bh = r & 15;
            if (r < 16) attn_unit<true>(a, layer, bh, qb, lds, tu); else attn_unit<false>(a, layer, bh, qb, lds, tu);
        } else if (idx < 768) gmlp_unit(a, layer, idx - 512, lds, tu);
        else { const int pu = idx - 768; switch (pu & 3) { case 0: pool_unit_t<0>(a, layer, pu, tu); break; case 1: pool_unit_t<1>(a, layer, pu, tu); break; case 2: pool_unit_t<2>(a, layer, pu, tu); break; default: pool_unit_t<3>(a, layer, pu, tu); break; } }
    }
}

#define XB_TMO      128
#define XB_XCNT(j)  (256  + 64 * (j))
#define XB_XSUB(j)  (1280 + 64 * (j))
#define XB_XGEN(j)  (2304 + 64 * (j))
#define XB_TOP      3328
#define XB_TOPGEN   3392
#define XCD_BAR_WORDS 3456
#define XB_SPIN_CAP (1u << 22)
__device__ __forceinline__ unsigned xb_ld(unsigned* p)              { return __hip_atomic_load(p, __ATOMIC_RELAXED, __HIP_MEMORY_SCOPE_AGENT); }
__device__ __forceinline__ unsigned xb_add(unsigned* p, unsigned v) { return __hip_atomic_fetch_add(p, v, __ATOMIC_RELAXED, __HIP_MEMORY_SCOPE_AGENT); }
__device__ __forceinline__ unsigned xb_xcc_id() { return (unsigned)__builtin_amdgcn_s_getreg((3 << 11) | 20) & 0xFu; }
#define XB_SPIN(cond, bar) do { unsigned _sp = 0; while (cond) { __builtin_amdgcn_s_sleep(1); \
    if ((++_sp & 255u) == 0u) { if (xb_ld(&(bar)[XB_TMO])) break; if (_sp > XB_SPIN_CAP) { atomicAdd(&(bar)[XB_TMO], 1u); break; } } } } while (0)
struct XcdBarrier { unsigned* bar; unsigned x; volatile LAS unsigned* st; };
__device__ __forceinline__ XcdBarrier xcd_barrier_post(unsigned* bar, volatile LAS unsigned* st) {
    XcdBarrier b; b.bar = bar; b.x = xb_xcc_id(); b.st = st;
    if (threadIdx.x == 0) (void)xb_add(&bar[XB_XCNT(b.x)], 1u);
    return b;
}
__device__ __forceinline__ void xcd_barrier_complete(unsigned* bar, unsigned x, unsigned& nloc, unsigned& nx) {
    const unsigned G = gridDim.x * gridDim.y * gridDim.z;
    unsigned sum, cnt, mine, sp = 0u;
    for (;;) {
        sum = 0u; cnt = 0u; mine = 0u;
#pragma unroll
        for (unsigned j = 0; j < 16; ++j) { const unsigned c = xb_ld(&bar[XB_XCNT(j)]); sum += c; cnt += (c > 0u) ? 1u : 0u; mine = (j == x) ? c : mine; }
        if (sum == G) break;
        __builtin_amdgcn_s_sleep(1);
        if ((++sp & 255u) == 0u) { if (xb_ld(&bar[XB_TMO])) break; if (sp > XB_SPIN_CAP) { atomicAdd(&bar[XB_TMO], 1u); break; } }
    }
    nloc = mine > 0u ? mine : 1u; nx = cnt > 0u ? cnt : 1u;
}
__device__ __forceinline__ void xcd_barrier(const XcdBarrier& b) {
    asm volatile("s_waitcnt vmcnt(0)" ::: "memory");
    __syncthreads();
    if (threadIdx.x == 0) {
        unsigned* bar = b.bar;
        __builtin_amdgcn_s_waitcnt(0);
        unsigned nloc = b.st[0], nx = b.st[1];
        if (nloc == 0u) { xcd_barrier_complete(bar, b.x, nloc, nx); b.st[0] = nloc; b.st[1] = nx; }
        const unsigned old = xb_add(&bar[XB_XSUB(b.x)], 1u);
        const unsigned gen = old / nloc;
        if (old + 1u == (gen + 1u) * nloc) {
            __builtin_amdgcn_fence(__ATOMIC_RELEASE, "agent");
            asm volatile("s_waitcnt vmcnt(0)" ::: "memory");
            const unsigned og = xb_add(&bar[XB_TOP], 1u);
            const unsigned tg = og / nx;
            if (og + 1u == (tg + 1u) * nx) xb_add(&bar[XB_TOPGEN], 1u);
            else XB_SPIN(xb_ld(&bar[XB_TOPGEN]) == tg, bar);
            __builtin_amdgcn_fence(__ATOMIC_ACQUIRE, "agent");
            xb_add(&bar[XB_XGEN(b.x)], 1u);
            asm volatile("s_waitcnt vmcnt(0)" ::: "memory");
        } else {
            XB_SPIN(xb_ld(&bar[XB_XGEN(b.x)]) == gen, bar);
            __builtin_amdgcn_fence(__ATOMIC_ACQUIRE, "agent");
            asm volatile("s_waitcnt vmcnt(0)" ::: "memory");
        }
    }
    __syncthreads();
}

typedef const __attribute__((address_space(4))) Args* CArgsPtr;
__device__ __forceinline__ Args load_args() {
#if defined(__HIP_DEVICE_COMPILE__)
    CArgsPtr p = (CArgsPtr)__builtin_amdgcn_kernarg_segment_ptr(); asm volatile("" : "+s"(p)); return *p;
#else
    return Args{};
#endif
}

__global__ void __launch_bounds__(512, 2) fwd_kernel(Args a_in) {
    extern __shared__ __attribute__((aligned(16))) unsigned char lds_raw[];
    LAS unsigned char* lds = (LAS unsigned char*)lds_raw;
    cg::grid_group grid = cg::this_grid();
    const int G = gridDim.x;
    unsigned* xbar_words; unsigned xbar_x;
    {
        const Args a = load_args();
        xbar_words = (unsigned*)(a.ws + WS_CTL) + CW_BAR;
        if (threadIdx.x < 2) ((LAS unsigned*)(lds + LDS_MISC + 32))[threadIdx.x] = 0u;
        __syncthreads();
        const XcdBarrier b0 = xcd_barrier_post(xbar_words, (volatile LAS unsigned*)(lds + LDS_MISC + 32));
        xbar_x = b0.x;
    }
#define TIDS() int tid = threadIdx.x; asm volatile("" : "+v"(tid)); const int lane = tid & 63, wave = __builtin_amdgcn_readfirstlane(tid >> 6), gw = blockIdx.x * 8 + wave, NGW = G * 8; (void)lane; (void)gw; (void)NGW
    for (int rep = 0; rep < REP_P0; ++rep) {
        const Args a = load_args(); TIDS();
        phase0(a, lds, gw, NGW, wave, lane);
    }
    grid.sync();
    for (int _r = 1; _r < REP_SYNC; ++_r) grid.sync();

    for (int l = 0; l < DEPTH; ++l) {
        {
            const Args a = load_args();
            const unsigned char* wl = a.ws + WS_W + (size_t)l * WL_STRIDE;
            pg8::Gemm g{(const bf16_t*)(a.ws + WS_XN), (const bf16_t*)(wl + WO_IN), MROWS, NIN, DM}; pg8::InOrder S; S.init(MROWS, NIN, G, (int)blockIdx.x, 0, G == 256 ? 6 : (1 << 30));
            pg8::EpiIn E{(bf16_t*)(a.ws + WS_PROJ), (float*)(a.ws + WS_FLOG), (const float*)(a.ws + WS_ROT), a.fa_b_f + l * 4};
            pg8::gemm_phase<pg8::EpiIn, pg8::InOrder>(lds, g, S, E);
        }
        GSYNC();
        for (int rep = 0; rep < REP_MIX; ++rep) {
            const Args a = load_args();
            mixer_phase(a, l + 2 * rep, l, lds, threadIdx.x);
        }
        GSYNC();
        for (int rep = 0; rep < REP_MERGE; ++rep) {
            const Args a = load_args();
            const unsigned char* wl = a.ws + WS_W + (size_t)l * WL_STRIDE;
            pg8::Gemm g{(const bf16_t*)(a.ws + WS_BR), (const bf16_t*)(wl + WO_BR), MROWS, DM, DM}; pg8::StaticOrder S; S.init(MROWS, DM, G, (int)blockIdx.x);
            pg8::EpiMergeFold E{(const bf16_t*)(a.ws + WS_PROJ) + P_GATE, (bf16_t*)(a.ws + WS_MB)};
            pg8::gemm_phase<pg8::EpiMergeFold, pg8::StaticOrder>(lds, g, S, E);
        }
        GSYNC();
        for (int rep = 0; rep < REP_OUT; ++rep) {
            const Args a = load_args();
            const unsigned char* wl = a.ws + WS_W + (size_t)l * WL_STRIDE;
            pg8::Gemm g{(const bf16_t*)(a.ws + WS_MB), (const bf16_t*)(wl + WO_OUT), MROWS, DM, DM}; pg8::StaticOrder S; S.init(MROWS, DM, G, (int)blockIdx.x);
            pg8::EpiBf<0> E{(bf16_t*)(a.ws + WS_Y), DM};
            pg8::gemm_phase<pg8::EpiBf<0>, pg8::StaticOrder>(lds, g, S, E);
        }
        GSYNC();
        {
            const Args a = load_args(); TIDS();
            if (l == 0) row_phase<false, true>((const bf16_t*)(a.ws + WS_Y), a.x, a.ws + WS_HB, a.n_mix_post + (size_t)l * DM, a.n_ffn_pre + (size_t)l * DM, (bf16_t*)(a.ws + WS_XN), gw, NGW, lane);
            else row_phase<true, true>((const bf16_t*)(a.ws + WS_Y), a.ws + WS_HB, a.ws + WS_HB, a.n_mix_post + (size_t)l * DM, a.n_ffn_pre + (size_t)l * DM, (bf16_t*)(a.ws + WS_XN), gw, NGW, lane);
        }
        GSYNC();
        {
            const Args a = load_args();
            const unsigned char* wl = a.ws + WS_W + (size_t)l * WL_STRIDE;
            pg8::Gemm g{(const bf16_t*)(a.ws + WS_XN), (const bf16_t*)(wl + WO_UP), MROWS, FFN, DM}; pg8::StaticOrder S; S.init(MROWS, FFN, G, (int)blockIdx.x, REP_UP);
            pg8::EpiBf<1> E{(bf16_t*)(a.ws + WS_PROJ), FFN};
            pg8::gemm_phase<pg8::EpiBf<1>, pg8::StaticOrder>(lds, g, S, E);
        }
        GSYNC();
        for (int rep = 0; rep < REP_DN; ++rep) {
            const Args a = load_args();
            const unsigned char* wl = a.ws + WS_W + (size_t)l * WL_STRIDE;
            pg8::Gemm g{(const bf16_t*)(a.ws + WS_PROJ), (const bf16_t*)(wl + WO_DN), MROWS, DM, FFN}; pg8::StaticOrder S; S.init(MROWS, DM, G, (int)blockIdx.x);
            pg8::EpiBf<0> E{(bf16_t*)(a.ws + WS_Y), DM};
            pg8::gemm_phase<pg8::EpiBf<0>, pg8::StaticOrder>(lds, g, S, E);
        }
        GSYNC();
        {
            const Args a = load_args(); TIDS();
            if (l + 1 < DEPTH) row_phase<true, true>((const bf16_t*)(a.ws + WS_Y), a.ws + WS_HB, a.ws + WS_HB, a.n_ffn_post + (size_t)l * DM, a.n_mix_pre + (size_t)(l + 1) * DM, (bf16_t*)(a.ws + WS_XN), gw, NGW, lane);
            else row_phase<true, false>((const bf16_t*)(a.ws + WS_Y), a.ws + WS_HB, a.out, a.n_ffn_post + (size_t)l * DM, nullptr, (bf16_t*)(a.ws + WS_XN), gw, NGW, lane);
        }
        if (l + 1 < DEPTH) GSYNC();
    }
#undef TIDS
}

extern "C" void kernel_launch(void* const* d_in, const int* in_sizes, int n_in, void* d_out, int out_size, void* d_ws, size_t ws_size, hipStream_t stream) {
    static int grid = 0;
    if (grid == 0) {
        if (n_in != 20 || out_size != MROWS * DM || ws_size < WS_END) { fprintf(stderr, "kernel_launch: unexpected shapes (n_in %d out %d ws %zu)\n", n_in, out_size, ws_size); grid = -1; return; }
        int dev = 0, cus = 0, per_cu = 0;
        (void)hipGetDevice(&dev);
        (void)hipDeviceGetAttribute(&cus, hipDeviceAttributeMultiprocessorCount, dev);
        if (hipFuncSetAttribute((const void*)fwd_kernel, hipFuncAttributeMaxDynamicSharedMemorySize, LDS_BYTES) != hipSuccess) { fprintf(stderr, "kernel_launch: hipFuncSetAttribute failed\n"); grid = -1; return; }
        (void)hipOccupancyMaxActiveBlocksPerMultiprocessor(&per_cu, (const void*)fwd_kernel, 512, LDS_BYTES);
        if (per_cu < 1) { fprintf(stderr, "kernel_launch: occupancy query says %d\n", per_cu); per_cu = 1; }
        (void)hipGetLastError();
        grid = cus;
        if (grid > 256) grid = 256;
    }
    if (grid < 0) return;
    (void)hipMemsetAsync((char*)d_ws + WS_CTL, 0, CTL_BYTES, stream);
    Args a{};
    a.x = (const float*)d_in[0]; a.pos = (const int*)d_in[1];
    a.n_mix_pre = (const float*)d_in[2]; a.n_mix_post = (const float*)d_in[3]; a.n_ffn_pre = (const float*)d_in[4]; a.n_ffn_post = (const float*)d_in[5];
    a.w_in = (const float*)d_in[6]; a.gm_ln_g = (const float*)d_in[7]; a.gm_ln_b = (const float*)d_in[8]; a.gm_w_s = (const float*)d_in[9]; a.gm_b_s = (const float*)d_in[10];
    a.da_lambda = (const float*)d_in[11]; a.da_subln_g = (const float*)d_in[12]; a.fa_b_f = (const float*)d_in[13]; a.pool_w = (const float*)d_in[14]; a.pool_scale = (const float*)d_in[15];
    a.w_branch = (const float*)d_in[16]; a.w_out = (const float*)d_in[17]; a.w_ffn_up = (const float*)d_in[18]; a.w_ffn_down = (const float*)d_in[19];
    a.out = (float*)d_out; a.ws = (unsigned char*)d_ws;
    void* args[] = {&a};
    hipError_t e = hipLaunchCooperativeKernel((const void*)fwd_kernel, dim3(grid), dim3(512), args, LDS_BYTES, stream);
    if (e != hipSuccess) fprintf(stderr, "cooperative launch failed: %s (grid %d)\n", hipGetErrorString(e), grid);
}
```

```cpp
#include <hip/hip_runtime.h>
#include <hip/hip_cooperative_groups.h>
#include <cstdio>
#include <cstdint>
namespace cg = cooperative_groups;
#ifndef REP_P0
#define REP_P0 1
#endif
#ifndef REP_IN
#define REP_IN 1
#endif
#ifndef REP_MIX
#define REP_MIX 1
#endif
#ifndef REP_MERGE
#define REP_MERGE 1
#endif
#ifndef REP_OUT
#define REP_OUT 1
#endif
#ifndef REP_UP
#define REP_UP 1
#endif
#ifndef REP_DN
#define REP_DN 1
#endif
#ifndef REP_ROW
#define REP_ROW 1
#endif
#ifndef REP_SYNC
#define REP_SYNC 1
#endif
#ifndef USE_CG_SYNC
#define USE_CG_SYNC 0
#endif
#define GSYNC() do { for (int _r = 0; _r < REP_SYNC; ++_r) { if (USE_CG_SYNC) grid.sync(); else { XcdBarrier _b; _b.bar = xbar_words; _b.x = xbar_x; _b.st = (volatile LAS unsigned*)(lds + LDS_MISC + 32); xcd_barrier(_b); } } } while (0)

#define LAS __attribute__((address_space(3)))
typedef unsigned short bf16_t;
typedef short bf16x8 __attribute__((ext_vector_type(8)));
typedef float f32x4 __attribute__((ext_vector_type(4)));
typedef unsigned u32x4 __attribute__((ext_vector_type(4)));
typedef unsigned u32x2 __attribute__((ext_vector_type(2)));

constexpr int DM = 2048, NBATCH = 4, SEQ = 2048, MROWS = NBATCH * SEQ, DEPTH = 2;
constexpr int INC = 12804;
constexpr int NP = 12800;
constexpr int NIN = 13056;
constexpr int FFN = 8192;
constexpr int P_AU = 0, P_AV = 512, P_BQ = 1024, P_BK = 1536, P_BV = 2048, P_CQ = 2560, P_CK = 3072, P_CV = 3584, P_DH = 4096, P_GATE = 4608;
constexpr float NORM_EPS = 1e-6f;
constexpr float LOG2E = 1.4426950408889634f;

constexpr size_t MiB = 1u << 20;
constexpr size_t WS_CTL = 0, CTL_BYTES = 65536;
constexpr int CW_BAR = 4096;
constexpr size_t WS_W = 1 * MiB, WL_STRIDE = 132 * MiB;
constexpr size_t WO_IN = 0, WO_BR = 51 * MiB, WO_OUT = 59 * MiB, WO_UP = 67 * MiB, WO_DN = 99 * MiB, WO_POOL = 131 * MiB;
constexpr size_t WS_PROJ = 266 * MiB;
constexpr size_t WS_XN = 466 * MiB;
constexpr size_t WS_BR = 498 * MiB;
constexpr size_t WS_MB = 530 * MiB;
constexpr size_t WS_Y = 562 * MiB;
constexpr size_t WS_FLOG = 626 * MiB;
constexpr size_t WS_ROT = 627 * MiB;
constexpr size_t WS_HB = 628 * MiB;
constexpr size_t WS_END = 660 * MiB;

constexpr int LDS_BYTES = 139264;
constexpr int LDS_MISC = 135168;

__device__ __forceinline__ unsigned f2bf(float f) { unsigned u = __builtin_bit_cast(unsigned, f); return (u + 0x7fffu + ((u >> 16) & 1u)) >> 16; }
__device__ __forceinline__ unsigned pk2(float lo, float hi) { return f2bf(lo) | (f2bf(hi) << 16); }
__device__ __forceinline__ float bflo(unsigned w) { return __builtin_bit_cast(float, w << 16); }
__device__ __forceinline__ float bfhi(unsigned w) { return __builtin_bit_cast(float, w & 0xffff0000u); }
__device__ __forceinline__ float wave_sum(float v) {
#pragma unroll
    for (int o = 1; o < 64; o <<= 1) v += __shfl_xor(v, o);
    return v;
}
#define LDS_WAIT() asm volatile("s_waitcnt lgkmcnt(0)" ::: "memory")

namespace pg8 {
constexpr int BM = 256, BK = 64, HALF = 128, HTB = HALF * BK * 2, STAGE_BYTES = 8 * HTB, NXCD = 8, WGM = 8;
__host__ __device__ __forceinline__ int lds_byte(int r, int c) { const int st = (r >> 4) * 2 + (c >> 5), rr = r & 15, cc = c & 31, ob = rr * 64 + cc * 2; return st * 1024 + (ob ^ (((ob >> 9) & 1) << 5)); }
__host__ __device__ __forceinline__ void stage_rc(int b, int& R, int& C) { const int st = b / 1024, sb = b % 1024, swz = sb ^ (((sb >> 9) & 1) << 5); R = (st >> 1) * 16 + swz / 64; C = (st & 1) * 32 + (swz % 64) / 2; }
__host__ __device__ __forceinline__ int perm32(int rho) { const int n = rho >> 4, i = rho & 15; return 8 * (i >> 2) + 4 * n + (i & 3); }

struct Unit { int pm, pn; };
struct Gemm { const bf16_t* A; const bf16_t* Bt; int M, N, K; };

struct StaticOrder {
    int nM, nN, nwg, G, c, nrep;
    __device__ void init(int M, int N, int G_, int c_, int nrep_ = 1) { nM = M / BM; nN = N / BM; nwg = nM * nN; G = G_; c = c_; nrep = nrep_; asm volatile("" : "+s"(c), "+s"(G)); }
    __device__ bool next(int i, Unit& u) const {
        long L = (long)i * G + c; if (L >= (long)nwg * nrep) return false;
        if (nrep > 1) L %= nwg;
        int wgid = (int)L; { const int q = nwg / NXCD, r = nwg % NXCD, xcd = wgid % NXCD, off = wgid / NXCD; wgid = (xcd < r ? xcd * (q + 1) : r * (q + 1) + (xcd - r) * q) + off; }
        const int nig = WGM * nN, gid = wgid / nig, fm = gid * WGM, gsz = (nM - fm) < WGM ? (nM - fm) : WGM;
        u.pm = fm + ((wgid % nig) % gsz); u.pn = (wgid % nig) / gsz; return true;
    }
};

struct InOrder : StaticOrder {
    int i0, i1;
    __device__ void init(int M, int N, int G_, int c_, int i0_, int i1_) { StaticOrder::init(M, N, G_, c_, 1); i0 = i0_; i1 = i1_; }
    __device__ bool next(int i, Unit& u) const {
        if (i + i0 >= i1) return false;
        const long L = (long)(i + i0) * G + c; if (L >= nwg) return false;
        if (nwg != 1632) { const bool ok = StaticOrder::next(i + i0, u); if (ok) u.pn = (u.pn == 0) ? 50 : u.pn - 1; return ok; }
        const int xcd = (int)(L & 7), off = (int)(L >> 3), g = xcd >> 1, h = xcd & 1;
        int col, pmi;
        if (off < 200) { col = 2 * (off >> 3) + h; pmi = off & 7; } else { col = 50; pmi = (off - 200) + 4 * h; }
        u.pm = 8 * g + pmi; u.pn = (col == 0) ? 50 : col - 1;
        return true;
    }
};
__device__ __forceinline__ unsigned cvt_pk_bf16(float lo, float hi) { unsigned r; asm volatile("v_cvt_pk_bf16_f32 %0, %1, %2" : "=v"(r) : "v"(lo), "v"(hi)); return r; }


struct EpiIn {
    static constexpr bool PERM = true, FOLD = false;
    bf16_t* O; float* flog; const float* rot; const float* bfv;
    __device__ __forceinline__ void operator()(const f32x4 (&acc)[2][2][4][2], const Unit& u, int wr, int wc, int fr, int fq) const {
        const int row0 = u.pm * BM + wr * 64 + fr;
        if (u.pn == 50) {
            if (wc == 0 && fq == 0) {
                const f32x4 b = *(const f32x4*)bfv;
#pragma unroll
                for (int ai = 0; ai < 2; ++ai)
#pragma unroll
                    for (int m = 0; m < 4; ++m) *(f32x4*)(flog + (size_t)(row0 + ai * HALF + m * 16) * 4) = acc[ai][0][m][0] + b;
            }
            return;
        }
        const int col0 = u.pn * BM + wc * 32 + 8 * fq;
        const bool sig = u.pn >= 18;
        const bool rotary = (u.pn >= 4) && (u.pn < 8) && ((wc & 1) == 0);
        const float sg = (fq == 0) ? -1.f : 1.f;
#pragma unroll
        for (int ai = 0; ai < 2; ++ai)
#pragma unroll
            for (int m = 0; m < 4; ++m) {
                const int row = row0 + ai * HALF + m * 16;
                bf16_t* rowp = O + (size_t)row * NP + col0;
                f32x4 v[2][2];
#pragma unroll
                for (int bj = 0; bj < 2; ++bj) { v[bj][0] = acc[ai][bj][m][0]; v[bj][1] = acc[ai][bj][m][1]; }
                if (rotary) {
                    const f32x4* rp = (const f32x4*)(rot + (size_t)row * 16);
#pragma unroll
                    for (int n = 0; n < 2; ++n) {
                        const f32x4 ca = rp[2 * n], cb = rp[2 * n + 1];
                        const float cc[4] = {ca[0], ca[2], cb[0], cb[2]};
                        const float ss[4] = {ca[1] * sg, ca[3] * sg, cb[1] * sg, cb[3] * sg};
#pragma unroll
                        for (int bj = 0; bj < 2; ++bj)
#pragma unroll
                            for (int j = 0; j < 4; ++j) {
                                const float own = v[bj][n][j];
                                const float par = __shfl_xor(own, 16);
                                const float nv = own * cc[j] + par * ss[j];
                                v[bj][n][j] = (fq < 2) ? nv : own;
                            }
                    }
                    asm volatile("" ::: "memory");
                }
#pragma unroll
                for (int bj = 0; bj < 2; ++bj) {
                    f32x4 v0 = v[bj][0], v1 = v[bj][1];
                    if (sig) {
#pragma unroll
                        for (int j = 0; j < 4; ++j) {
                            v0[j] = __builtin_amdgcn_rcpf(1.0f + __builtin_amdgcn_exp2f(v0[j]));
                            v1[j] = __builtin_amdgcn_rcpf(1.0f + __builtin_amdgcn_exp2f(v1[j]));
                        }
                    }
                    u32x4 w; w.x = cvt_pk_bf16(v0[0], v0[1]); w.y = cvt_pk_bf16(v0[2], v0[3]); w.z = cvt_pk_bf16(v1[0], v1[1]); w.w = cvt_pk_bf16(v1[2], v1[3]);
                    *(u32x4*)(rowp + bj * HALF) = w;
                }
            }
    }
};
template <int ACT> struct EpiBf {
    static constexpr bool PERM = true, FOLD = false;
    bf16_t* O; int ldc;
    __device__ __forceinline__ void operator()(const f32x4 (&acc)[2][2][4][2], const Unit& u, int wr, int wc, int fr, int fq) const {
        const int row0 = u.pm * BM + wr * 64 + fr, col0 = u.pn * BM + wc * 32 + 8 * fq;
#pragma unroll
        for (int ai = 0; ai < 2; ++ai)
#pragma unroll
            for (int m = 0; m < 4; ++m) {
                bf16_t* rowp = O + (size_t)(row0 + ai * HALF + m * 16) * ldc + col0;
#pragma unroll
                for (int bj = 0; bj < 2; ++bj) {
                    f32x4 v0 = acc[ai][bj][m][0], v1 = acc[ai][bj][m][1];
#pragma unroll
                    for (int j = 0; j < 4; ++j) { if (ACT == 1) { const float a = fmaxf(v0[j], 0.f), b = fmaxf(v1[j], 0.f); v0[j] = a * a; v1[j] = b * b; } }
                    u32x4 w; w.x = cvt_pk_bf16(v0[0], v0[1]); w.y = cvt_pk_bf16(v0[2], v0[3]); w.z = cvt_pk_bf16(v1[0], v1[1]); w.w = cvt_pk_bf16(v1[2], v1[3]);
                    *(u32x4*)(rowp + bj * HALF) = w;
                }
            }
    }
};
struct EpiF32 {
    static constexpr bool PERM = false, FOLD = false;
    float* C; int ldc;
    __device__ __forceinline__ void operator()(const f32x4 (&acc)[2][2][4][2], const Unit& u, int wr, int wc, int fr, int fq) const {
        const int row0 = u.pm * BM + wr * 64 + fr, col0 = u.pn * BM + wc * 32 + 4 * fq;
#pragma unroll
        for (int ai = 0; ai < 2; ++ai)
#pragma unroll
            for (int m = 0; m < 4; ++m) {
                float* rowp = C + (size_t)(row0 + ai * HALF + m * 16) * ldc + col0;
#pragma unroll
                for (int bj = 0; bj < 2; ++bj)
#pragma unroll
                    for (int n = 0; n < 2; ++n) *(f32x4*)(rowp + bj * HALF + n * 16) = acc[ai][bj][m][n];
            }
    }
};
struct EpiMergeFold {
    static constexpr bool PERM = true, FOLD = true;
    const bf16_t* gate;
    bf16_t* MBo;
    static __device__ __forceinline__ void unpack8(const u32x4 w, float (&f)[8]) {
        f[0] = bflo(w.x); f[1] = bfhi(w.x); f[2] = bflo(w.y); f[3] = bfhi(w.y); f[4] = bflo(w.z); f[5] = bfhi(w.z); f[6] = bflo(w.w); f[7] = bfhi(w.w);
#pragma unroll
        for (int j = 0; j < 8; ++j) f[j] = fmaxf(f[j], 1e-30f);
    }
    static __device__ __forceinline__ float ratio(float n, float d) { return fmaxf(n, 1e-30f) * __builtin_amdgcn_rcpf(fmaxf(d, 1e-30f)); }
    __device__ __forceinline__ void fold(f32x4 (&acc)[2][2][4][2], const Unit& u, int nb, int wr, int wc, int fr, int fq) const {
        const bf16_t* gbase = gate + (size_t)(u.pm * BM + wr * 64 + fr) * NP + (size_t)nb * DM + (u.pn * BM + wc * 32 + 8 * fq);
#pragma unroll
        for (int ai = 0; ai < 2; ++ai) {
            u32x4 wn[4][2], wd[4][2];
#pragma unroll
            for (int m = 0; m < 4; ++m)
#pragma unroll
                for (int bj = 0; bj < 2; ++bj) {
                    const bf16_t* gp = gbase + (size_t)(ai * HALF + m * 16) * NP + bj * HALF;
                    wn[m][bj] = *(const u32x4*)(gp - DM);
                    wd[m][bj] = *(const u32x4*)gp;
                }
#pragma unroll
            for (int m = 0; m < 4; ++m)
#pragma unroll
                for (int bj = 0; bj < 2; ++bj) {
                    const u32x4 a = wn[m][bj], d = wd[m][bj];
                    f32x4 r0, r1;
                    r0[0] = ratio(bflo(a.x), bflo(d.x)); r0[1] = ratio(bfhi(a.x), bfhi(d.x)); r0[2] = ratio(bflo(a.y), bflo(d.y)); r0[3] = ratio(bfhi(a.y), bfhi(d.y));
                    r1[0] = ratio(bflo(a.z), bflo(d.z)); r1[1] = ratio(bfhi(a.z), bfhi(d.z)); r1[2] = ratio(bflo(a.w), bflo(d.w)); r1[3] = ratio(bfhi(a.w), bfhi(d.w));
                    acc[ai][bj][m][0] *= r0; acc[ai][bj][m][1] *= r1;
                }
            asm volatile("" ::: "memory");
        }
    }
    __device__ __forceinline__ void operator()(const f32x4 (&acc)[2][2][4][2], const Unit& u, int wr, int wc, int fr, int fq) const {
        const int row0 = u.pm * BM + wr * 64 + fr, col0 = u.pn * BM + wc * 32 + 8 * fq;
        u32x4 gw[2][4][2];
#pragma unroll
        for (int ai = 0; ai < 2; ++ai)
#pragma unroll
            for (int m = 0; m < 4; ++m)
#pragma unroll
                for (int bj = 0; bj < 2; ++bj) gw[ai][m][bj] = *(const u32x4*)(gate + (size_t)(row0 + ai * HALF + m * 16) * NP + (size_t)3 * DM + col0 + bj * HALF);
#pragma unroll
        for (int ai = 0; ai < 2; ++ai)
#pragma unroll
            for (int m = 0; m < 4; ++m) {
                bf16_t* rowp = MBo + (size_t)(row0 + ai * HALF + m * 16) * DM + col0;
#pragma unroll
                for (int bj = 0; bj < 2; ++bj) {
                    float g[8]; unpack8(gw[ai][m][bj], g);
                    const f32x4 v0 = acc[ai][bj][m][0], v1 = acc[ai][bj][m][1];
                    u32x4 w; w.x = cvt_pk_bf16(v0[0] * g[0], v0[1] * g[1]); w.y = cvt_pk_bf16(v0[2] * g[2], v0[3] * g[3]); w.z = cvt_pk_bf16(v1[0] * g[4], v1[1] * g[5]); w.w = cvt_pk_bf16(v1[2] * g[6], v1[3] * g[7]);
                    *(u32x4*)(rowp + bj * HALF) = w;
                }
            }
    }
};

template <class Epi, class Sched, bool ALIGN_EPI = true, bool SP2 = true>
__device__ __forceinline__ void gemm_phase(LAS unsigned char* lds, const Gemm g, const Sched& S, const Epi& E) {
    int tid = threadIdx.x; asm volatile("" : "+v"(tid));
    const int wid = __builtin_amdgcn_readfirstlane(tid >> 6), lane = tid & 63, wr = wid >> 2, wc = wid & 3, fr = lane & 15, fq = lane >> 4;
    const int K = g.K, nt = K / BK;
    unsigned voffA[2], voffB[2];
#pragma unroll
    for (int i = 0; i < 2; ++i) { int R, C; stage_rc(tid * 16 + i * 8192, R, C); const int Rb = Epi::PERM ? ((R & ~31) + perm32(R & 31)) : R;
        voffA[i] = (unsigned)(R * K + C) * 2u; voffB[i] = (unsigned)(Rb * K + C) * 2u; }
    const size_t kstep = (size_t)(BK * 2);
    const size_t hstep = (size_t)HALF * K * 2;
    const size_t tstep = 2 * hstep;
    const unsigned ldsw = (unsigned)wid * 1024u;
    const int aoff = lds_byte(wr * 64 + fr, fq * 8), boff = lds_byte(wc * 32 + fr, fq * 8);
#define PG8_SA(b, h) (((b) * 2 + (h)) * HTB)
#define PG8_SB(b, h) ((4 + (b) * 2 + (h)) * HTB)
#define PG8_STAGE(bufoff, gbase, voff) do { _Pragma("unroll") for (int _i = 0; _i < 2; ++_i) \
        __builtin_amdgcn_global_load_lds((const unsigned*)((const char*)(gbase) + (voff)[_i]), (LAS unsigned*)(lds + (bufoff) + ldsw + _i * 8192), 16, 0, 0); } while (0)
#define PG8_LDA(dst, b, h) do { _Pragma("unroll") for (int m = 0; m < 4; ++m) _Pragma("unroll") for (int k = 0; k < 2; ++k) dst[m][k] = *(const LAS bf16x8*)(lds + PG8_SA(b, h) + aoff + m * 2048 + k * 1024); } while (0)
#define PG8_LDB(dst, b, h) do { _Pragma("unroll") for (int n = 0; n < 2; ++n) _Pragma("unroll") for (int k = 0; k < 2; ++k) dst[n][k] = *(const LAS bf16x8*)(lds + PG8_SB(b, h) + boff + n * 2048 + k * 1024); } while (0)
#define PG8_MMA(ai, bj, At, Bt) do { __builtin_amdgcn_s_setprio(1); _Pragma("unroll") for (int m = 0; m < 4; ++m) _Pragma("unroll") for (int n = 0; n < 2; ++n) _Pragma("unroll") for (int k = 0; k < 2; ++k) \
        acc[ai][bj][m][n] = __builtin_amdgcn_mfma_f32_16x16x32_bf16(Bt[n][k], At[m][k], acc[ai][bj][m][n], 0, 0, 0); __builtin_amdgcn_s_setprio(0); } while (0)
#define PG8_WAIT_V(n) asm volatile("s_waitcnt vmcnt(" #n ")" ::: "memory")
#define PG8_WAIT_L(n) asm volatile("s_waitcnt lgkmcnt(" #n ")" ::: "memory")
#define PG8_BAR __builtin_amdgcn_s_barrier()
#define PG8_SCHED __builtin_amdgcn_sched_barrier(0)
    Unit cur, nxt; int ui = 0;
    if (!S.next(0, cur)) return;
    f32x4 acc[2][2][4][2];
#pragma unroll
    for (int a = 0; a < 2; ++a)
#pragma unroll
        for (int b = 0; b < 2; ++b)
#pragma unroll
            for (int m = 0; m < 4; ++m)
#pragma unroll
                for (int n = 0; n < 2; ++n) acc[a][b][m][n] = (f32x4){0.f, 0.f, 0.f, 0.f};
    bf16x8 At[4][2], B0[2][2], B1[2][2];
    const char* cA = (const char*)g.A + (size_t)cur.pm * tstep; const char* cB = (const char*)g.Bt + (size_t)cur.pn * tstep;
    if constexpr (SP2) {
        PG8_STAGE(PG8_SB(0, 0), cB, voffB); PG8_STAGE(PG8_SB(0, 1), cB + hstep, voffB); PG8_STAGE(PG8_SA(0, 0), cA, voffA); PG8_STAGE(PG8_SA(0, 1), cA + hstep, voffA);
        if (wr == 1) PG8_BAR;
        PG8_WAIT_V(2); PG8_BAR;
        PG8_STAGE(PG8_SB(1, 0), cB + kstep, voffB); PG8_STAGE(PG8_SA(1, 0), cA + kstep, voffA); PG8_STAGE(PG8_SB(1, 1), cB + hstep + kstep, voffB);
        PG8_WAIT_V(6); PG8_BAR;
    } else {
        PG8_STAGE(PG8_SB(0, 0), cB, voffB); PG8_STAGE(PG8_SA(0, 0), cA, voffA); PG8_STAGE(PG8_SB(0, 1), cB + hstep, voffB); PG8_STAGE(PG8_SA(0, 1), cA + hstep, voffA);
        if (wr == 1) PG8_BAR;
        PG8_WAIT_V(4); PG8_BAR;
        PG8_STAGE(PG8_SB(1, 0), cB + kstep, voffB); PG8_STAGE(PG8_SA(1, 0), cA + kstep, voffA); PG8_STAGE(PG8_SB(1, 1), cB + hstep + kstep, voffB);
        PG8_WAIT_V(6); PG8_BAR;
    }
    for (;;) {
        const bool has_next = S.next(ui + 1, nxt);
        const char* nA = has_next ? (const char*)g.A + (size_t)nxt.pm * tstep : cA; const char* nB = has_next ? (const char*)g.Bt + (size_t)nxt.pn * tstep : cB;
        for (int t = 0; t < nt; t += 2) {
            const bool last = (t == nt - 2);
            const char* a1 = cA + (size_t)(t + 1) * kstep;
            const char* a2 = last ? nA : cA + (size_t)(t + 2) * kstep; const char* b2 = last ? nB : cB + (size_t)(t + 2) * kstep;
            const char* a3 = a2 + kstep; const char* b3 = b2 + kstep;
            if constexpr (Epi::FOLD) { if (t > 0 && (t & 7) == 0) E.fold(acc, cur, t >> 3, wr, wc, fr, fq); }
            if constexpr (SP2) {
            PG8_LDB(B0, 0, 0); PG8_LDB(B1, 0, 1); PG8_SCHED; PG8_LDA(At, 0, 0); PG8_STAGE(PG8_SA(1, 1), a1 + hstep, voffA);
            PG8_WAIT_V(8); PG8_WAIT_L(0); PG8_BAR; PG8_MMA(0, 0, At, B0); PG8_MMA(0, 1, At, B1); PG8_BAR; PG8_SCHED;
            PG8_LDA(At, 0, 1); PG8_STAGE(PG8_SB(0, 0), b2, voffB); PG8_STAGE(PG8_SB(0, 1), b2 + hstep, voffB); PG8_STAGE(PG8_SA(0, 0), a2, voffA);
            PG8_WAIT_V(8); PG8_WAIT_L(0); PG8_BAR; PG8_MMA(1, 0, At, B0); PG8_MMA(1, 1, At, B1); PG8_BAR; PG8_SCHED;
            PG8_LDB(B0, 1, 0); PG8_LDB(B1, 1, 1); PG8_SCHED; PG8_LDA(At, 1, 0); PG8_STAGE(PG8_SA(0, 1), a2 + hstep, voffA);
            PG8_WAIT_V(8); PG8_WAIT_L(0); PG8_BAR; PG8_MMA(0, 0, At, B0); PG8_MMA(0, 1, At, B1); PG8_BAR; PG8_SCHED;
            PG8_LDA(At, 1, 1); PG8_STAGE(PG8_SB(1, 0), b3, voffB); PG8_STAGE(PG8_SB(1, 1), b3 + hstep, voffB); PG8_STAGE(PG8_SA(1, 0), a3, voffA);
            PG8_WAIT_V(8); PG8_WAIT_L(0); PG8_BAR; PG8_MMA(1, 0, At, B0); PG8_MMA(1, 1, At, B1); PG8_BAR; PG8_SCHED;
            } else {
            PG8_LDB(B0, 0, 0); PG8_SCHED; PG8_LDA(At, 0, 0); PG8_STAGE(PG8_SA(1, 1), a1 + hstep, voffA);
            PG8_WAIT_L(8); PG8_BAR; PG8_WAIT_L(0); PG8_MMA(0, 0, At, B0); PG8_BAR; PG8_SCHED;
            PG8_LDB(B1, 0, 1); PG8_STAGE(PG8_SB(0, 0), b2, voffB);
            PG8_BAR; PG8_WAIT_L(0); PG8_MMA(0, 1, At, B1); PG8_BAR;
            PG8_LDA(At, 0, 1); PG8_STAGE(PG8_SA(0, 0), a2, voffA);
            PG8_BAR; PG8_WAIT_L(0); PG8_MMA(1, 0, At, B0); PG8_BAR; PG8_SCHED;
            PG8_STAGE(PG8_SB(0, 1), b2 + hstep, voffB);
            PG8_WAIT_V(6); PG8_BAR; PG8_MMA(1, 1, At, B1); PG8_BAR;
            PG8_LDB(B0, 1, 0); PG8_SCHED; PG8_LDA(At, 1, 0); PG8_STAGE(PG8_SA(0, 1), a2 + hstep, voffA);
            PG8_WAIT_L(8); PG8_BAR; PG8_WAIT_L(0); PG8_MMA(0, 0, At, B0); PG8_BAR; PG8_SCHED;
            PG8_LDB(B1, 1, 1); PG8_STAGE(PG8_SB(1, 0), b3, voffB);
            PG8_BAR; PG8_WAIT_L(0); PG8_MMA(0, 1, At, B1); PG8_BAR;
            PG8_LDA(At, 1, 1); PG8_STAGE(PG8_SA(1, 0), a3, voffA);
            PG8_BAR; PG8_WAIT_L(0); PG8_MMA(1, 0, At, B0); PG8_BAR; PG8_SCHED;
            PG8_STAGE(PG8_SB(1, 1), b3 + hstep, voffB);
            PG8_WAIT_V(6); PG8_BAR; PG8_MMA(1, 1, At, B1); PG8_BAR;
            }
        }
        if constexpr (ALIGN_EPI) { if (wr == 0) PG8_BAR; }
        E(acc, cur, wr, wc, fr, fq);
        if (!has_next) break;
#pragma unroll
        for (int a = 0; a < 2; ++a)
#pragma unroll
            for (int b = 0; b < 2; ++b)
#pragma unroll
                for (int m = 0; m < 4; ++m)
#pragma unroll
                    for (int n = 0; n < 2; ++n) acc[a][b][m][n] = (f32x4){0.f, 0.f, 0.f, 0.f};
        cur = nxt; cA = nA; cB = nB; ++ui;
        if constexpr (ALIGN_EPI) { if (wr == 1) PG8_BAR; }
    }
    PG8_WAIT_V(0);
    if constexpr (!ALIGN_EPI) { if (wr == 0) PG8_BAR; }
    PG8_BAR;
#undef PG8_SA
#undef PG8_SB
#undef PG8_STAGE
#undef PG8_LDA
#undef PG8_LDB
#undef PG8_MMA
#undef PG8_WAIT_V
#undef PG8_WAIT_L
#undef PG8_BAR
#undef PG8_SCHED
}
}

struct Args {
    const float* x; const int* pos;
    const float *n_mix_pre, *n_mix_post, *n_ffn_pre, *n_ffn_post, *w_in, *gm_ln_g, *gm_ln_b, *gm_w_s, *gm_b_s, *da_lambda, *da_subln_g, *fa_b_f,
                *pool_w, *pool_scale, *w_branch, *w_out, *w_ffn_up, *w_ffn_down;
    float* out; unsigned char* ws;
};

struct TrDesc { const float* sp; size_t ld; bf16_t* dp; int K; float scale; bool ok; };
__device__ __forceinline__ void tr_load(const TrDesc& d, f32x4 (&v)[16]) {
#pragma unroll
    for (int i = 0; i < 16; ++i) v[i] = d.ok ? __builtin_nontemporal_load((const f32x4*)(d.sp + (size_t)(4 * i) * d.ld)) : (f32x4){0.f, 0.f, 0.f, 0.f};
}
__device__ __forceinline__ void tr_finish(const TrDesc& d, const f32x4 (&v)[16], LAS float* scr, int lane) {
    const int c4 = (lane & 15) * 4, kr = lane >> 4;
#pragma unroll
    for (int i = 0; i < 16; ++i) {
        LAS float* p = scr + (4 * i + kr) * 65 + c4;
        p[0] = v[i][0] * d.scale; p[1] = v[i][1] * d.scale; p[2] = v[i][2] * d.scale; p[3] = v[i][3] * d.scale;
    }
    LDS_WAIT();
    const int c = lane & 7;
#pragma unroll
    for (int j = 0; j < 8; ++j) {
        const int n = (lane >> 3) + 8 * j;
        const LAS float* s = scr + (8 * c) * 65 + n;
        u32x4 o; o.x = pg8::cvt_pk_bf16(s[0], s[65]); o.y = pg8::cvt_pk_bf16(s[2 * 65], s[3 * 65]); o.z = pg8::cvt_pk_bf16(s[4 * 65], s[5 * 65]); o.w = pg8::cvt_pk_bf16(s[6 * 65], s[7 * 65]);
        *(u32x4*)(d.dp + (size_t)n * d.K + 8 * c) = o;
    }
    LDS_WAIT();
}

__device__ __forceinline__ void rms_row_bf16(const float* xrow, const f32x4 (&gv)[8], bf16_t* orow, int lane) {
    f32x4 v[8]; float s = 0.f;
#pragma unroll
    for (int j = 0; j < 8; ++j) { v[j] = *((const f32x4*)xrow + lane + 64 * j); s += (v[j][0] * v[j][0] + v[j][1] * v[j][1]) + (v[j][2] * v[j][2] + v[j][3] * v[j][3]); }
    const float rstd = 1.0f / sqrtf(wave_sum(s) * (1.0f / DM) + NORM_EPS);
#pragma unroll
    for (int j = 0; j < 8; ++j) {
        u32x2 w; w.x = pk2(v[j][0] * rstd * gv[j][0], v[j][1] * rstd * gv[j][1]); w.y = pk2(v[j][2] * rstd * gv[j][2], v[j][3] * rstd * gv[j][3]);
        *((u32x2*)orow + lane + 64 * j) = w;
    }
}

__device__ __forceinline__ void phase0(const Args& a, LAS unsigned char* lds, int gw, int NGW, int wave, int lane) {
    LAS float* scr = (LAS float*)(lds + wave * 16640);
    constexpr int I_IN = 32 * 204, I_BR = 4 * 8 * 32, I_OUT = 32 * 32, I_UP = 32 * 128, I_DN = 128 * 32, I_POOL = 16;
    constexpr int I_LAYER = I_IN + I_BR + I_OUT + I_UP + I_DN + I_POOL, I_ALL = DEPTH * I_LAYER;
    const int c4 = (lane & 15) * 4, kr = lane >> 4;
    auto decode = [&](int it) -> TrDesc {
        const int l = it / I_LAYER; int r = it - l * I_LAYER;
        unsigned char* wl = a.ws + WS_W + (size_t)l * WL_STRIDE;
        const float* src; size_t ld; int sc, nv = 64, k0, n0, K; bf16_t* dst; float scale = 1.0f;
        if (r < I_IN) {
            const int kb = r / 204, nb = r % 204; n0 = nb * 64; k0 = kb * 64;
            if (nb < 64) { sc = n0; } else if (nb < 200) { sc = n0 + 4; } else if (nb == 200) { sc = 4096; nv = 4; } else { sc = 0; nv = 0; }
            src = a.w_in + (size_t)l * DM * INC; ld = INC; dst = (bf16_t*)(wl + WO_IN); K = DM;
            scale = (nb >= 72 && nb < 200) ? -LOG2E : 1.0f;
        } else if ((r -= I_IN) < I_BR) {
            const int n = r / 256, rr = r % 256, kb = rr / 32, nb = rr % 32; n0 = nb * 64; k0 = kb * 64; sc = n0;
            src = a.w_branch + ((size_t)l * 4 + n) * 512 * DM; ld = DM; dst = (bf16_t*)(wl + WO_BR) + n * 512; K = DM;
        } else if ((r -= I_BR) < I_OUT) {
            const int kb = r / 32, nb = r % 32; n0 = nb * 64; k0 = kb * 64; sc = n0;
            src = a.w_out + (size_t)l * DM * DM; ld = DM; dst = (bf16_t*)(wl + WO_OUT); K = DM;
        } else if ((r -= I_OUT) < I_UP) {
            const int kb = r / 128, nb = r % 128; n0 = nb * 64; k0 = kb * 64; sc = n0;
            src = a.w_ffn_up + (size_t)l * DM * FFN; ld = FFN; dst = (bf16_t*)(wl + WO_UP); K = DM;
        } else if ((r -= I_UP) < I_DN) {
            const int kb = r / 32, nb = r % 32; n0 = nb * 64; k0 = kb * 64; sc = n0;
            src = a.w_ffn_down + (size_t)l * FFN * DM; ld = DM; dst = (bf16_t*)(wl + WO_DN); K = FFN;
        } else {
            r -= I_DN;
            const int g = r / 4, rr = r % 4, kb = rr / 2, nb = rr % 2; n0 = nb * 64; k0 = kb * 64; sc = n0;
            src = a.pool_w + ((size_t)l * 4 + g) * 128 * 128; ld = 128; dst = (bf16_t*)(wl + WO_POOL) + (size_t)g * 128 * 128; K = 128;
        }
        TrDesc d; d.sp = src + (size_t)(k0 + kr) * ld + sc + c4; d.ld = ld; d.dp = dst + (size_t)n0 * K + k0; d.K = K; d.scale = scale; d.ok = c4 < nv;
        return d;
    };
    {
        int it = gw; TrDesc dA, dB; f32x4 vA[16], vB[16];
        if (it < I_ALL) { dA = decode(it); tr_load(dA, vA); }
        while (it < I_ALL) {
            const int itB = it + NGW;
            if (itB < I_ALL) { dB = decode(itB); tr_load(dB, vB); }
            tr_finish(dA, vA, scr, lane);
            const int itA = itB + NGW;
            if (itA < I_ALL) { dA = decode(itA); tr_load(dA, vA); }
            if (itB < I_ALL) tr_finish(dB, vB, scr, lane);
            it = itA;
        }
    }
    {
        float* rot = (float*)(a.ws + WS_ROT);
        const float inv[8] = {1.0f, 0.193922758102417f, 0.03760603070259094f, 0.00729266507551074f, 0.001414213445968926f, 0.00027424818836152554f, 5.318296462064609e-05f, 1.0313385246263351e-05f};
        for (int e = gw * 64 + lane; e < MROWS * 8; e += NGW * 64) {
            const int row = e >> 3, i = e & 7;
            float iv = inv[0];
#pragma unroll
            for (int q = 1; q < 8; ++q) iv = (i == q) ? inv[q] : iv;
            const float ang = (float)a.pos[row] * iv;
            const double ad = (double)ang;
            const double kk = __builtin_rint(ad * 0.15915494309189535);
            const float rr = (float)(ad - kk * 6.283185307179586);
            rot[2 * e] = cosf(rr); rot[2 * e + 1] = sinf(rr);
        }
    }
    {
        f32x4 g0[8];
#pragma unroll
        for (int j = 0; j < 8; ++j) g0[j] = *((const f32x4*)a.n_mix_pre + lane + 64 * j);
        for (int m = gw; m < MROWS; m += NGW) rms_row_bf16(a.x + (size_t)m * DM, g0, (bf16_t*)(a.ws + WS_XN) + (size_t)m * DM, lane);
    }
}

template <bool HIN_BF, bool HOUT_BF>
__device__ __forceinline__ void row_phase(const bf16_t* Y, const void* hin, void* hout, const float* gpost, const float* gpre, bf16_t* XN, int gw, int NGW, int lane) {
    f32x4 gpo[8], gpr[8];
#pragma unroll
    for (int j = 0; j < 8; ++j) { gpo[j] = *((const f32x4*)gpost + lane + 64 * j); gpr[j] = gpre ? *((const f32x4*)gpre + lane + 64 * j) : (f32x4){0.f, 0.f, 0.f, 0.f}; }
    for (int m = gw; m < MROWS; m += NGW) {
        const u32x2* yr = (const u32x2*)(Y + (size_t)m * DM);
        u32x2 yw[8]; u32x2 hw[8]; f32x4 hf[8];
#pragma unroll
        for (int j = 0; j < 8; ++j) yw[j] = yr[lane + 64 * j];
#pragma unroll
        for (int j = 0; j < 8; ++j) {
            if (HIN_BF) hw[j] = *((const u32x2*)((const bf16_t*)hin + (size_t)m * DM) + lane + 64 * j);
            else hf[j] = *((const f32x4*)((const float*)hin + (size_t)m * DM) + lane + 64 * j);
        }
        f32x4 v[8]; float s = 0.f;
#pragma unroll
        for (int j = 0; j < 8; ++j) { v[j] = (f32x4){bflo(yw[j].x), bfhi(yw[j].x), bflo(yw[j].y), bfhi(yw[j].y)}; s += (v[j][0] * v[j][0] + v[j][1] * v[j][1]) + (v[j][2] * v[j][2] + v[j][3] * v[j][3]); }
        const float rstd = 1.0f / sqrtf(wave_sum(s) * (1.0f / DM) + NORM_EPS);
        float s2 = 0.f;
#pragma unroll
        for (int j = 0; j < 8; ++j) {
            f32x4 h;
            if (HIN_BF) h = (f32x4){bflo(hw[j].x), bfhi(hw[j].x), bflo(hw[j].y), bfhi(hw[j].y)}; else h = hf[j];
            v[j] = h + v[j] * rstd * gpo[j];
            if (HOUT_BF) { u32x2 w; w.x = pk2(v[j][0], v[j][1]); w.y = pk2(v[j][2], v[j][3]); *((u32x2*)((bf16_t*)hout + (size_t)m * DM) + lane + 64 * j) = w; }
            else *((f32x4*)((float*)hout + (size_t)m * DM) + lane + 64 * j) = v[j];
            s2 += (v[j][0] * v[j][0] + v[j][1] * v[j][1]) + (v[j][2] * v[j][2] + v[j][3] * v[j][3]);
        }
        if (gpre) {
            const float rstd2 = 1.0f / sqrtf(wave_sum(s2) * (1.0f / DM) + NORM_EPS);
#pragma unroll
            for (int j = 0; j < 8; ++j) {
                const f32x4 gv = gpr[j];
                u32x2 w; w.x = pk2(v[j][0] * rstd2 * gv[0], v[j][1] * rstd2 * gv[1]); w.y = pk2(v[j][2] * rstd2 * gv[2], v[j][3] * rstd2 * gv[3]);
                *((u32x2*)(XN + (size_t)m * DM) + lane + 64 * j) = w;
            }
        }
    }
}

constexpr int KSTR = 272;
constexpr int VSTR = 144;
constexpr int KBUF = 64 * KSTR;
constexpr int VBUF = 128 * VSTR;
constexpr int L_K0 = 0, L_V0 = 2 * KBUF, L_CUM = L_V0 + 2 * VBUF  , L_STAT = L_CUM + 8192  , L_WT = L_STAT + 1024  ;

struct KRegs { u32x4 a, b; };
struct VRegs { u32x4 a, b; };

__device__ __forceinline__ KRegs k_load(const bf16_t* base  , int tid) {
    const bf16_t* p = base + (size_t)(tid >> 3) * NP + (tid & 7) * 16;
    KRegs r; r.a = *(const u32x4*)p; r.b = *(const u32x4*)(p + 8); return r;
}
__device__ __forceinline__ void k_store(LAS unsigned char* buf, const KRegs& r, int tid) {
    LAS unsigned char* d = buf + (tid >> 3) * KSTR + (tid & 7) * 32;
    *(LAS u32x4*)d = r.a; *(LAS u32x4*)(d + 16) = r.b;
}
__device__ __forceinline__ void v_map(int tid, int& chunk, int& pair) { const int w = tid >> 6, l = tid & 63; chunk = 4 * (w & 3) + (l & 3); pair = 16 * (w >> 2) + (l >> 2); }
__device__ __forceinline__ VRegs v_load(const bf16_t* base, int tid) {
    int chunk, pair; v_map(tid, chunk, pair);
    const bf16_t* p = base + (size_t)(2 * pair) * NP + chunk * 8;
    VRegs r; r.a = *(const u32x4*)p; r.b = *(const u32x4*)(p + NP); return r;
}
__device__ __forceinline__ void v_store_words(LAS unsigned char* buf, const unsigned (&wa)[4], const unsigned (&wb)[4], int tid) {
    int chunk, pair; v_map(tid, chunk, pair);
    LAS unsigned char* d = buf + (8 * chunk) * VSTR + pair * 4;
#pragma unroll
    for (int i = 0; i < 4; ++i) {
        *(LAS unsigned*)(d + (2 * i) * VSTR) = (wa[i] & 0xffffu) | (wb[i] << 16);
        *(LAS unsigned*)(d + (2 * i + 1) * VSTR) = (wa[i] >> 16) | (wb[i] & 0xffff0000u);
    }
}
__device__ __forceinline__ void v_store(LAS unsigned char* buf, const VRegs& r, int tid) {
    const unsigned wa[4] = {r.a.x, r.a.y, r.a.z, r.a.w}, wb[4] = {r.b.x, r.b.y, r.b.z, r.b.w};
    v_store_words(buf, wa, wb, tid);
}

__device__ __forceinline__ void pv_mma(f32x4 (&o)[8], const LAS unsigned char* vbuf, const bf16x8 (&pf)[2], int lane) {
    const LAS unsigned char* vp = vbuf + (lane & 15) * VSTR + (lane >> 4) * 16;
#pragma unroll
    for (int mb = 0; mb < 8; ++mb)
#pragma unroll
        for (int pr = 0; pr < 2; ++pr) {
            const bf16x8 vf = *(const LAS bf16x8*)(vp + mb * 16 * VSTR + pr * 64);
            o[mb] = __builtin_amdgcn_mfma_f32_16x16x32_bf16(vf, pf[pr], o[mb], 0, 0, 0);
        }
}

__device__ __forceinline__ void softmax_tile(f32x4 (&s)[4], const f32x4 (&add)[4], float cs, float& lsum, bf16x8 (&pf)[2]) {
    float ps = 0.f;
#pragma unroll
    for (int rb = 0; rb < 4; ++rb)
#pragma unroll
        for (int j = 0; j < 4; ++j) { s[rb][j] = __builtin_amdgcn_exp2f(fminf(fmaf(s[rb][j], cs, add[rb][j]), 126.f)); ps += s[rb][j]; }
    lsum += ps;
#pragma unroll
    for (int pr = 0; pr < 2; ++pr) {
        u32x4 w; w.x = pg8::cvt_pk_bf16(s[2 * pr][0], s[2 * pr][1]); w.y = pg8::cvt_pk_bf16(s[2 * pr][2], s[2 * pr][3]); w.z = pg8::cvt_pk_bf16(s[2 * pr + 1][0], s[2 * pr + 1][1]); w.w = pg8::cvt_pk_bf16(s[2 * pr + 1][2], s[2 * pr + 1][3]);
        pf[pr] = __builtin_bit_cast(bf16x8, w);
    }
}

template <bool DIFF>
__device__ __forceinline__ void attn_unit(const Args& a, int layer, int bh, int qb, LAS unsigned char* lds, int tid) {
    const int wave = tid >> 6, lane = tid & 63, l15 = lane & 15, quad = lane >> 4;
    const int b = bh >> 2, h = bh & 3;
    const bf16_t* proj = (const bf16_t*)(a.ws + WS_PROJ) + (size_t)b * SEQ * NP;
    const bf16_t* Qg = proj + (DIFF ? P_BQ : P_CQ) + h * 128;
    const bf16_t* Kg = proj + (DIFF ? P_BK : P_CK) + h * 128;
    const bf16_t* Vg = proj + (DIFF ? P_BV : P_CV) + h * 128;
    const int q0 = qb * 128, ntiles = 2 * qb + 2;
    __syncthreads();
    { KRegs r0 = k_load(Qg + (size_t)q0 * NP, tid), r1 = k_load(Qg + (size_t)(q0 + 64) * NP, tid);
      k_store(lds + L_K0, r0, tid); k_store(lds + L_K0 + KBUF, r1, tid); }
    if (!DIFF) {
        const float* fl = (const float*)(a.ws + WS_FLOG) + (size_t)b * SEQ * 4 + h;
        const int nk = q0 + 128;
        float v[4];
#pragma unroll
        for (int i = 0; i < 4; ++i) {
            const int k = 4 * tid + i;
            float z = (k < nk) ? fl[(size_t)k * 4] : 0.f;
            float ls = fminf(z, 0.f) - log1pf(expf(-fabsf(z)));
            v[i] = (k < nk) ? ls : 0.f;
        }
        const float s0 = v[0], s1 = s0 + v[1], s2 = s1 + v[2], s3 = s2 + v[3];
        float x = s3;
#pragma unroll
        for (int d = 1; d < 64; d <<= 1) { const float y = __shfl_up(x, d); if (lane >= d) x += y; }
        LAS float* wt = (LAS float*)(lds + L_WT);
        if (lane == 63) wt[wave] = x;
        __syncthreads();
        float off = 0.f;
#pragma unroll
        for (int w = 0; w < 8; ++w) off += (w < wave) ? wt[w] : 0.f;
        const float ex = off + x - s3;
        LAS f32x4* cum = (LAS f32x4*)(lds + L_CUM);
        cum[tid] = (f32x4){(ex + s0) * LOG2E, (ex + s1) * LOG2E, (ex + s2) * LOG2E, (ex + s3) * LOG2E};
    }
    __syncthreads();
    bf16x8 qf[4];
    {
        const LAS unsigned char* qp = lds + L_K0 + (wave * 16 + l15) * KSTR + quad * 16;
#pragma unroll
        for (int ks = 0; ks < 4; ++ks) qf[ks] = *(const LAS bf16x8*)(qp + ks * 64);
    }
    KRegs kr = k_load(Kg, tid); VRegs vr = v_load(Vg, tid);
    __syncthreads();

    constexpr int NMAP = DIFF ? 2 : 1;
    const float cs = (DIFF ? 0.125f : 0.08838834764831845f) * LOG2E;
    f32x4 o[NMAP][8]; float lsum[NMAP];
#pragma unroll
    for (int mp = 0; mp < NMAP; ++mp) { lsum[mp] = 0.f;
#pragma unroll
        for (int mb = 0; mb < 8; ++mb) o[mp][mb] = (f32x4){0.f, 0.f, 0.f, 0.f}; }
    const int qi = q0 + wave * 16 + l15;
    float cumq = 0.f; if (!DIFF) cumq = *(const LAS float*)(lds + L_CUM + qi * 4);

    for (int jt = 0; jt < ntiles; ++jt) {
        LAS unsigned char* kb = lds + L_K0 + (jt & 1) * KBUF;
        LAS unsigned char* vb = lds + L_V0 + (jt & 1) * VBUF;
        k_store(kb, kr, tid); v_store(vb, vr, tid);
        __syncthreads();
        if (jt + 1 < ntiles) { kr = k_load(Kg + (size_t)(jt + 1) * 64 * NP, tid); vr = v_load(Vg + (size_t)(jt + 1) * 64 * NP, tid); }
        f32x4 s[NMAP][4];
        {
            bf16x8 kf[4][4];
#pragma unroll
            for (int rb = 0; rb < 4; ++rb) {
                const int trow = 32 * (rb >> 1) + 8 * (l15 >> 2) + 4 * (rb & 1) + (l15 & 3);
                const LAS unsigned char* kp = kb + trow * KSTR + quad * 16;
#pragma unroll
                for (int ks = 0; ks < 4; ++ks) kf[rb][ks] = *(const LAS bf16x8*)(kp + ks * 64);
            }
            __builtin_amdgcn_sched_barrier(0);
#pragma unroll
            for (int rb = 0; rb < 4; ++rb) {
                if (DIFF) {
                    f32x4 c0 = (f32x4){0.f, 0.f, 0.f, 0.f}, c1 = c0;
                    c0 = __builtin_amdgcn_mfma_f32_16x16x32_bf16(kf[rb][0], qf[0], c0, 0, 0, 0);
                    c0 = __builtin_amdgcn_mfma_f32_16x16x32_bf16(kf[rb][1], qf[1], c0, 0, 0, 0);
                    c1 = __builtin_amdgcn_mfma_f32_16x16x32_bf16(kf[rb][2], qf[2], c1, 0, 0, 0);
                    c1 = __builtin_amdgcn_mfma_f32_16x16x32_bf16(kf[rb][3], qf[3], c1, 0, 0, 0);
                    s[0][rb] = c0; s[NMAP - 1][rb] = c1;
                } else {
                    f32x4 c0 = (f32x4){0.f, 0.f, 0.f, 0.f};
#pragma unroll
                    for (int ks = 0; ks < 4; ++ks) c0 = __builtin_amdgcn_mfma_f32_16x16x32_bf16(kf[rb][ks], qf[ks], c0, 0, 0, 0);
                    s[0][rb] = c0;
                }
            }
        }
        bf16x8 vf[8][2];
        {
            const LAS unsigned char* vp = vb + l15 * VSTR + quad * 16;
#pragma unroll
            for (int mb = 0; mb < 8; ++mb)
#pragma unroll
                for (int pr = 0; pr < 2; ++pr) vf[mb][pr] = *(const LAS bf16x8*)(vp + mb * 16 * VSTR + pr * 64);
        }
        __builtin_amdgcn_sched_barrier(0);
        f32x4 addv[4];
#pragma unroll
        for (int rb = 0; rb < 4; ++rb) {
            const int key0 = jt * 64 + 32 * (rb >> 1) + 8 * quad + 4 * (rb & 1);
            if (!DIFF) addv[rb] = cumq - *(const LAS f32x4*)(lds + L_CUM + key0 * 4);
            else addv[rb] = (f32x4){0.f, 0.f, 0.f, 0.f};
        }
        if (jt >= 2 * qb) {
#pragma unroll
            for (int rb = 0; rb < 4; ++rb) {
                const int key0 = jt * 64 + 32 * (rb >> 1) + 8 * quad + 4 * (rb & 1);
#pragma unroll
                for (int mp = 0; mp < NMAP; ++mp)
#pragma unroll
                    for (int j = 0; j < 4; ++j) s[mp][rb][j] = (key0 + j > qi) ? -INFINITY : s[mp][rb][j];
            }
        }
        bf16x8 pf[NMAP][2];
#pragma unroll
        for (int mp = 0; mp < NMAP; ++mp) softmax_tile(s[mp], addv, cs, lsum[mp], pf[mp]);
#pragma unroll
        for (int mb = 0; mb < 8; ++mb)
#pragma unroll
            for (int pr = 0; pr < 2; ++pr)
#pragma unroll
                for (int mp = 0; mp < NMAP; ++mp) o[mp][mb] = __builtin_amdgcn_mfma_f32_16x16x32_bf16(vf[mb][pr], pf[mp][pr], o[mp][mb], 0, 0, 0);
    }
    float inv[NMAP];
#pragma unroll
    for (int mp = 0; mp < NMAP; ++mp) { float l = lsum[mp]; l += __shfl_xor(l, 16); l += __shfl_xor(l, 32); inv[mp] = 1.0f / l; }
    const size_t orow = (size_t)b * SEQ + qi;
    if (DIFF) {
        const float li = 0.8f - 0.6f * expf(-0.3f * (float)layer);
        const float* lp = a.da_lambda + (size_t)layer * 256;
        float d1 = lp[lane] * lp[64 + lane], d2 = lp[128 + lane] * lp[192 + lane];
        d1 = wave_sum(d1); d2 = wave_sum(d2);
        const float lam = expf(d1) - expf(d2) + li;
        const float c1 = inv[0], c2 = lam * inv[NMAP - 1];
        float ss = 0.f;
#pragma unroll
        for (int mb = 0; mb < 8; ++mb) { o[0][mb] = o[0][mb] * c1 - o[NMAP - 1][mb] * c2; ss += (o[0][mb][0] * o[0][mb][0] + o[0][mb][1] * o[0][mb][1]) + (o[0][mb][2] * o[0][mb][2] + o[0][mb][3] * o[0][mb][3]); }
        ss += __shfl_xor(ss, 16); ss += __shfl_xor(ss, 32);
        const float rstd = (1.0f / sqrtf(ss * (1.0f / 128.0f) + NORM_EPS)) * (1.0f - li);
        const float* sg = a.da_subln_g + (size_t)layer * 128;
        bf16_t* op = (bf16_t*)(a.ws + WS_BR) + orow * DM + 1 * 512 + h * 128 + quad * 4;
        f32x4 sgv[8];
#pragma unroll
        for (int mb = 0; mb < 8; ++mb) sgv[mb] = *(const f32x4*)(sg + mb * 16 + quad * 4);
#pragma unroll
        for (int mb = 0; mb < 8; ++mb) {
            const f32x4 gv = sgv[mb];
            u32x2 w; w.x = pk2(o[0][mb][0] * rstd * gv[0], o[0][mb][1] * rstd * gv[1]); w.y = pk2(o[0][mb][2] * rstd * gv[2], o[0][mb][3] * rstd * gv[3]);
            *(u32x2*)(op + mb * 16) = w;
        }
    } else {
        bf16_t* op = (bf16_t*)(a.ws + WS_BR) + orow * DM + 2 * 512 + h * 128 + quad * 4;
#pragma unroll
        for (int mb = 0; mb < 8; ++mb) {
            const f32x4 v = o[0][mb] * inv[0];
            u32x2 w; w.x = pk2(v[0], v[1]); w.y = pk2(v[2], v[3]);
            *(u32x2*)(op + mb * 16) = w;
        }
    }
}

__device__ __forceinline__ void gmlp_unit(const Args& a, int layer, int unit, LAS unsigned char* lds, int tid) {
    const int wave = tid >> 6, lane = tid & 63, l15 = lane & 15, quad = lane >> 4;
    const int g = unit & 3, bn = unit >> 2;
    const size_t r0 = (size_t)bn * 128;
    const bf16_t* proj = (const bf16_t*)(a.ws + WS_PROJ) + r0 * NP;
    __syncthreads();
    LAS float* stat = (LAS float*)(lds + L_STAT);
    {
        const int t = wave * 16 + (lane >> 2), part = lane & 3;
        const bf16_t* vp = proj + (size_t)t * NP + P_AV + part * 128;
        u32x4 w[16];
#pragma unroll
        for (int j = 0; j < 16; ++j) w[j] = *(const u32x4*)(vp + j * 8);
        float s1 = 0.f, s2 = 0.f;
#pragma unroll
        for (int j = 0; j < 16; ++j) {
            const float f[8] = {bflo(w[j].x), bfhi(w[j].x), bflo(w[j].y), bfhi(w[j].y), bflo(w[j].z), bfhi(w[j].z), bflo(w[j].w), bfhi(w[j].w)};
#pragma unroll
            for (int e = 0; e < 8; ++e) { s1 += f[e]; s2 += f[e] * f[e]; }
        }
        s1 += __shfl_xor(s1, 1); s1 += __shfl_xor(s1, 2); s2 += __shfl_xor(s2, 1); s2 += __shfl_xor(s2, 2);
        const float mu = s1 * (1.0f / 512.0f), var = fmaxf(s2 * (1.0f / 512.0f) - mu * mu, 0.f);
        if (part == 0) { stat[2 * t] = mu; stat[2 * t + 1] = 1.0f / sqrtf(var + NORM_EPS); }
    }
    __syncthreads();
    {
        int chunk, pair; v_map(tid, chunk, pair);
        const float* lg = a.gm_ln_g + (size_t)layer * 512 + g * 128 + chunk * 8;
        const float* lb = a.gm_ln_b + (size_t)layer * 512 + g * 128 + chunk * 8;
        const f32x4 g0 = *(const f32x4*)lg, g1 = *(const f32x4*)(lg + 4), b0 = *(const f32x4*)lb, b1 = *(const f32x4*)(lb + 4);
        const float gg[8] = {g0[0], g0[1], g0[2], g0[3], g1[0], g1[1], g1[2], g1[3]};
        const float bb[8] = {b0[0], b0[1], b0[2], b0[3], b1[0], b1[1], b1[2], b1[3]};
#pragma unroll
        for (int half = 0; half < 2; ++half) {
            const VRegs r = v_load(proj + (size_t)(half * 64) * NP + P_AV + g * 128, tid);
            const int sA = half * 64 + 2 * pair, sB = sA + 1;
            const float muA = stat[2 * sA], rsA = stat[2 * sA + 1], muB = stat[2 * sB], rsB = stat[2 * sB + 1];
            const unsigned ra[4] = {r.a.x, r.a.y, r.a.z, r.a.w}, rb[4] = {r.b.x, r.b.y, r.b.z, r.b.w};
            unsigned wa[4], wb[4];
#pragma unroll
            for (int i = 0; i < 4; ++i) {
                wa[i] = pk2((bflo(ra[i]) - muA) * rsA * gg[2 * i] + bb[2 * i], (bfhi(ra[i]) - muA) * rsA * gg[2 * i + 1] + bb[2 * i + 1]);
                wb[i] = pk2((bflo(rb[i]) - muB) * rsB * gg[2 * i] + bb[2 * i], (bfhi(rb[i]) - muB) * rsB * gg[2 * i + 1] + bb[2 * i + 1]);
            }
            v_store_words(lds + L_V0 + half * VBUF, wa, wb, tid);
        }
    }
    __syncthreads();
    const int t = wave * 16 + l15;
    const float* W = a.gm_w_s + ((size_t)layer * 4 + g) * 128 * 128 + (size_t)t * 128;
    f32x4 o[8];
#pragma unroll
    for (int mb = 0; mb < 8; ++mb) o[mb] = (f32x4){0.f, 0.f, 0.f, 0.f};
#pragma unroll
    for (int st = 0; st < 2; ++st) {
        if (st * 64 <= wave * 16 + 15) {
            bf16x8 pf[2];
#pragma unroll
            for (int pr = 0; pr < 2; ++pr) {
                const int sbase = st * 64 + pr * 32 + quad * 8;
                const f32x4 w0 = *(const f32x4*)(W + sbase), w1 = *(const f32x4*)(W + sbase + 4);
                float f[8] = {w0[0], w0[1], w0[2], w0[3], w1[0], w1[1], w1[2], w1[3]};
#pragma unroll
                for (int j = 0; j < 8; ++j) f[j] = (sbase + j <= t) ? f[j] : 0.f;
                u32x4 w; w.x = pk2(f[0], f[1]); w.y = pk2(f[2], f[3]); w.z = pk2(f[4], f[5]); w.w = pk2(f[6], f[7]);
                pf[pr] = __builtin_bit_cast(bf16x8, w);
            }
            pv_mma(o, lds + L_V0 + st * VBUF, pf, lane);
        }
    }
    const float bs = a.gm_b_s[((size_t)layer * 4 + g) * 128 + t];
    const bf16_t* up = proj + (size_t)t * NP + P_AU + g * 128 + quad * 4;
    bf16_t* op = (bf16_t*)(a.ws + WS_BR) + (r0 + t) * DM + g * 128 + quad * 4;
    u32x2 uwv[8];
#pragma unroll
    for (int mb = 0; mb < 8; ++mb) uwv[mb] = *(const u32x2*)(up + mb * 16);
#pragma unroll
    for (int mb = 0; mb < 8; ++mb) {
        const u32x2 uw = uwv[mb];
        u32x2 w; w.x = pk2(bflo(uw.x) * (o[mb][0] + bs), bfhi(uw.x) * (o[mb][1] + bs)); w.y = pk2(bflo(uw.y) * (o[mb][2] + bs), bfhi(uw.y) * (o[mb][3] + bs));
        *(u32x2*)(op + mb * 16) = w;
    }
}

template <int G_>
__device__ __forceinline__ void pool_unit_t(const Args& a, int layer, int unit, int tid) {
    const int wave = tid >> 6, lane = tid & 63, l15 = lane & 15, quad = lane >> 4;
    constexpr int g = G_; const int tile = unit >> 2;
    const int t = wave * 16 + l15;
    const size_t row = (size_t)tile * 128 + t;
    const int tseq = (int)(row & (SEQ - 1));
    constexpr int win = 2 << g;
    const int cnt = (tseq + 1 < win) ? (tseq + 1) : win;
    const float rc = 1.0f / (float)cnt;
    const bf16_t* hp = (const bf16_t*)(a.ws + WS_PROJ) + row * NP + P_DH + g * 128 + quad * 8;
    const bf16_t* wp = (const bf16_t*)(a.ws + WS_W + (size_t)layer * WL_STRIDE + WO_POOL) + (size_t)g * 128 * 128 + (size_t)l15 * 128 + quad * 8;
    f32x4 o[8];
#pragma unroll
    for (int mb = 0; mb < 8; ++mb) o[mb] = (f32x4){0.f, 0.f, 0.f, 0.f};
#pragma unroll
    for (int ks = 0; ks < 4; ++ks) {
        float acc[8] = {0.f, 0.f, 0.f, 0.f, 0.f, 0.f, 0.f, 0.f};
        float self[8];
        u32x4 wv[win];
#pragma unroll
        for (int i = 0; i < win; ++i) wv[i] = (i < cnt) ? *(const u32x4*)(hp - (size_t)i * NP + ks * 32) : (u32x4){0u, 0u, 0u, 0u};
#pragma unroll
        for (int i = 0; i < win; ++i) {
            const u32x4 w = wv[i];
            const float f[8] = {bflo(w.x), bfhi(w.x), bflo(w.y), bfhi(w.y), bflo(w.z), bfhi(w.z), bflo(w.w), bfhi(w.w)};
#pragma unroll
            for (int j = 0; j < 8; ++j) { acc[j] += f[j]; if (i == 0) self[j] = f[j]; }
        }
        asm volatile("" ::: "memory");
        u32x4 pw; pw.x = pk2(acc[0] * rc - self[0], acc[1] * rc - self[1]); pw.y = pk2(acc[2] * rc - self[2], acc[3] * rc - self[3]);
        pw.z = pk2(acc[4] * rc - self[4], acc[5] * rc - self[5]); pw.w = pk2(acc[6] * rc - self[6], acc[7] * rc - self[7]);
        const bf16x8 pf = __builtin_bit_cast(bf16x8, pw);
#pragma unroll
        for (int mb = 0; mb < 8; ++mb) {
            const bf16x8 wf = *(const bf16x8*)(wp + (size_t)mb * 16 * 128 + ks * 32);
            o[mb] = __builtin_amdgcn_mfma_f32_16x16x32_bf16(wf, pf, o[mb], 0, 0, 0);
        }
    }
    const float* sc = a.pool_scale + (size_t)layer * 512 + g * 128 + quad * 4;
    bf16_t* op = (bf16_t*)(a.ws + WS_BR) + row * DM + 3 * 512 + g * 128 + quad * 4;
    f32x4 svv[8];
#pragma unroll
    for (int mb = 0; mb < 8; ++mb) svv[mb] = *(const f32x4*)(sc + mb * 16);
#pragma unroll
    for (int mb = 0; mb < 8; ++mb) {
        const f32x4 sv = svv[mb];
        u32x2 w; w.x = pk2(o[mb][0] * sv[0], o[mb][1] * sv[1]); w.y = pk2(o[mb][2] * sv[2], o[mb][3] * sv[3]);
        *(u32x2*)(op + mb * 16) = w;
    }
}

__device__ __forceinline__ void mixer_phase(const Args& a, int cidx, int layer, LAS unsigned char* lds, int tid_) {
    int tid = tid_; asm volatile("" : "+v"(tid));
    unsigned* ctr = (unsigned*)(a.ws + WS_CTL) + 64 * cidx;
    LAS unsigned* slot = (LAS unsigned*)(lds + LDS_MISC);
    {
        const unsigned char* wl = a.ws + WS_W + (size_t)layer * WL_STRIDE;
        pg8::Gemm g{(const bf16_t*)(a.ws + WS_XN), (const bf16_t*)(wl + WO_IN), MROWS, NIN, DM};
        pg8::InOrder S; S.init(MROWS, NIN, (int)gridDim.x, (int)blockIdx.x, gridDim.x == 256 ? 6 : (1 << 30), 1 << 30);
        pg8::EpiIn E{(bf16_t*)(a.ws + WS_PROJ), (float*)(a.ws + WS_FLOG), (const float*)(a.ws + WS_ROT), a.fa_b_f + layer * 4};
        pg8::gemm_phase<pg8::EpiIn, pg8::InOrder>(lds, g, S, E);
    }
    for (;;) {
        __syncthreads();
        if (tid == 0) slot[0] = atomicAdd(ctr, 1u);
        __syncthreads();
        const int idx = (int)slot[0];
        if (idx >= 1024) break;
        int tu = tid; asm volatile("" : "+v"(tu));
        if (idx < 512) {
            const int qb = 15 - (idx >> 5), r = idx & 31, bh = r & 15;
            if (r < 16) attn_unit<true>(a, layer, bh, qb, lds, tu); else attn_unit<false>(a, layer, bh, qb, lds, tu);
        } else if (idx < 768) gmlp_unit(a, layer, idx - 512, lds, tu);
        else { const int pu = idx - 768; switch (pu & 3) { case 0: pool_unit_t<0>(a, layer, pu, tu); break; case 1: pool_unit_t<1>(a, layer, pu, tu); break; case 2: pool_unit_t<2>(a, layer, pu, tu); break; default: pool_unit_t<3>(a, layer, pu, tu); break; } }
    }
}

#define XB_TMO      128
#define XB_XCNT(j)  (256  + 64 * (j))
#define XB_XSUB(j)  (1280 + 64 * (j))
#define XB_XGEN(j)  (2304 + 64 * (j))
#define XB_TOP      3328
#define XB_TOPGEN   3392
#define XCD_BAR_WORDS 3456
#define XB_SPIN_CAP (1u << 22)
__device__ __forceinline__ unsigned xb_ld(unsigned* p)              { return __hip_atomic_load(p, __ATOMIC_RELAXED, __HIP_MEMORY_SCOPE_AGENT); }
__device__ __forceinline__ unsigned xb_add(unsigned* p, unsigned v) { return __hip_atomic_fetch_add(p, v, __ATOMIC_RELAXED, __HIP_MEMORY_SCOPE_AGENT); }
__device__ __forceinline__ unsigned xb_xcc_id() { return (unsigned)__builtin_amdgcn_s_getreg((3 << 11) | 20) & 0xFu; }
#define XB_SPIN(cond, bar) do { unsigned _sp = 0; while (cond) { __builtin_amdgcn_s_sleep(1); \
    if ((++_sp & 255u) == 0u) { if (xb_ld(&(bar)[XB_TMO])) break; if (_sp > XB_SPIN_CAP) { atomicAdd(&(bar)[XB_TMO], 1u); break; } } } } while (0)
struct XcdBarrier { unsigned* bar; unsigned x; volatile LAS unsigned* st; };
__device__ __forceinline__ XcdBarrier xcd_barrier_post(unsigned* bar, volatile LAS unsigned* st) {
    XcdBarrier b; b.bar = bar; b.x = xb_xcc_id(); b.st = st;
    if (threadIdx.x == 0) (void)xb_add(&bar[XB_XCNT(b.x)], 1u);
    return b;
}
__device__ __forceinline__ void xcd_barrier_complete(unsigned* bar, unsigned x, unsigned& nloc, unsigned& nx) {
    const unsigned G = gridDim.x * gridDim.y * gridDim.z;
    unsigned sum, cnt, mine, sp = 0u;
    for (;;) {
        sum = 0u; cnt = 0u; mine = 0u;
#pragma unroll
        for (unsigned j = 0; j < 16; ++j) { const unsigned c = xb_ld(&bar[XB_XCNT(j)]); sum += c; cnt += (c > 0u) ? 1u : 0u; mine = (j == x) ? c : mine; }
        if (sum == G) break;
        __builtin_amdgcn_s_sleep(1);
        if ((++sp & 255u) == 0u) { if (xb_ld(&bar[XB_TMO])) break; if (sp > XB_SPIN_CAP) { atomicAdd(&bar[XB_TMO], 1u); break; } }
    }
    nloc = mine > 0u ? mine : 1u; nx = cnt > 0u ? cnt : 1u;
}
__device__ __forceinline__ void xcd_barrier(const XcdBarrier& b) {
    asm volatile("s_waitcnt vmcnt(0)" ::: "memory");
    __syncthreads();
    if (threadIdx.x == 0) {
        unsigned* bar = b.bar;
        __builtin_amdgcn_s_waitcnt(0);
        unsigned nloc = b.st[0], nx = b.st[1];
        if (nloc == 0u) { xcd_barrier_complete(bar, b.x, nloc, nx); b.st[0] = nloc; b.st[1] = nx; }
        const unsigned old = xb_add(&bar[XB_XSUB(b.x)], 1u);
        const unsigned gen = old / nloc;
        if (old + 1u == (gen + 1u) * nloc) {
            __builtin_amdgcn_fence(__ATOMIC_RELEASE, "agent");
            asm volatile("s_waitcnt vmcnt(0)" ::: "memory");
            const unsigned og = xb_add(&bar[XB_TOP], 1u);
            const unsigned tg = og / nx;
            if (og + 1u == (tg + 1u) * nx) xb_add(&bar[XB_TOPGEN], 1u);
            else XB_SPIN(xb_ld(&bar[XB_TOPGEN]) == tg, bar);
            __builtin_amdgcn_fence(__ATOMIC_ACQUIRE, "agent");
            xb_add(&bar[XB_XGEN(b.x)], 1u);
            asm volatile("s_waitcnt vmcnt(0)" ::: "memory");
        } else {
            XB_SPIN(xb_ld(&bar[XB_XGEN(b.x)]) == gen, bar);
            __builtin_amdgcn_fence(__ATOMIC_ACQUIRE, "agent");
            asm volatile("s_waitcnt vmcnt(0)" ::: "memory");
        }
    }
    __syncthreads();
}

typedef const __attribute__((address_space(4))) Args* CArgsPtr;
__device__ __forceinline__ Args load_args() {
#if defined(__HIP_DEVICE_COMPILE__)
    CArgsPtr p = (CArgsPtr)__builtin_amdgcn_kernarg_segment_ptr(); asm volatile("" : "+s"(p)); return *p;
#else
    return Args{};
#endif
}

__global__ void __launch_bounds__(512, 2) fwd_kernel(Args a_in) {
    extern __shared__ __attribute__((aligned(16))) unsigned char lds_raw[];
    LAS unsigned char* lds = (LAS unsigned char*)lds_raw;
    cg::grid_group grid = cg::this_grid();
    const int G = gridDim.x;
    unsigned* xbar_words; unsigned xbar_x;
    {
        const Args a = load_args();
        xbar_words = (unsigned*)(a.ws + WS_CTL) + CW_BAR;
        if (threadIdx.x < 2) ((LAS unsigned*)(lds + LDS_MISC + 32))[threadIdx.x] = 0u;
        __syncthreads();
        const XcdBarrier b0 = xcd_barrier_post(xbar_words, (volatile LAS unsigned*)(lds + LDS_MISC + 32));
        xbar_x = b0.x;
    }
#define TIDS() int tid = threadIdx.x; asm volatile("" : "+v"(tid)); const int lane = tid & 63, wave = __builtin_amdgcn_readfirstlane(tid >> 6), gw = blockIdx.x * 8 + wave, NGW = G * 8; (void)lane; (void)gw; (void)NGW
    for (int rep = 0; rep < REP_P0; ++rep) {
        const Args a = load_args(); TIDS();
        phase0(a, lds, gw, NGW, wave, lane);
    }
    grid.sync();
    for (int _r = 1; _r < REP_SYNC; ++_r) grid.sync();

    for (int l = 0; l < DEPTH; ++l) {
        {
            const Args a = load_args();
            const unsigned char* wl = a.ws + WS_W + (size_t)l * WL_STRIDE;
            pg8::Gemm g{(const bf16_t*)(a.ws + WS_XN), (const bf16_t*)(wl + WO_IN), MROWS, NIN, DM}; pg8::InOrder S; S.init(MROWS, NIN, G, (int)blockIdx.x, 0, G == 256 ? 6 : (1 << 30));
            pg8::EpiIn E{(bf16_t*)(a.ws + WS_PROJ), (float*)(a.ws + WS_FLOG), (const float*)(a.ws + WS_ROT), a.fa_b_f + l * 4};
            pg8::gemm_phase<pg8::EpiIn, pg8::InOrder>(lds, g, S, E);
        }
        GSYNC();
        for (int rep = 0; rep < REP_MIX; ++rep) {
            const Args a = load_args();
            mixer_phase(a, l + 2 * rep, l, lds, threadIdx.x);
        }
        GSYNC();
        for (int rep = 0; rep < REP_MERGE; ++rep) {
            const Args a = load_args();
            const unsigned char* wl = a.ws + WS_W + (size_t)l * WL_STRIDE;
            pg8::Gemm g{(const bf16_t*)(a.ws + WS_BR), (const bf16_t*)(wl + WO_BR), MROWS, DM, DM}; pg8::StaticOrder S; S.init(MROWS, DM, G, (int)blockIdx.x);
            pg8::EpiMergeFold E{(const bf16_t*)(a.ws + WS_PROJ) + P_GATE, (bf16_t*)(a.ws + WS_MB)};
            pg8::gemm_phase<pg8::EpiMergeFold, pg8::StaticOrder>(lds, g, S, E);
        }
        GSYNC();
        for (int rep = 0; rep < REP_OUT; ++rep) {
            const Args a = load_args();
            const unsigned char* wl = a.ws + WS_W + (size_t)l * WL_STRIDE;
            pg8::Gemm g{(const bf16_t*)(a.ws + WS_MB), (const bf16_t*)(wl + WO_OUT), MROWS, DM, DM}; pg8::StaticOrder S; S.init(MROWS, DM, G, (int)blockIdx.x);
            pg8::EpiBf<0> E{(bf16_t*)(a.ws + WS_Y), DM};
            pg8::gemm_phase<pg8::EpiBf<0>, pg8::StaticOrder>(lds, g, S, E);
        }
        GSYNC();
        {
            const Args a = load_args(); TIDS();
            if (l == 0) row_phase<false, true>((const bf16_t*)(a.ws + WS_Y), a.x, a.ws + WS_HB, a.n_mix_post + (size_t)l * DM, a.n_ffn_pre + (size_t)l * DM, (bf16_t*)(a.ws + WS_XN), gw, NGW, lane);
            else row_phase<true, true>((const bf16_t*)(a.ws + WS_Y), a.ws + WS_HB, a.ws + WS_HB, a.n_mix_post + (size_t)l * DM, a.n_ffn_pre + (size_t)l * DM, (bf16_t*)(a.ws + WS_XN), gw, NGW, lane);
        }
        GSYNC();
        {
            const Args a = load_args();
            const unsigned char* wl = a.ws + WS_W + (size_t)l * WL_STRIDE;
            pg8::Gemm g{(const bf16_t*)(a.ws + WS_XN), (const bf16_t*)(wl + WO_UP), MROWS, FFN, DM}; pg8::StaticOrder S; S.init(MROWS, FFN, G, (int)blockIdx.x, REP_UP);
            pg8::EpiBf<1> E{(bf16_t*)(a.ws + WS_PROJ), FFN};
            pg8::gemm_phase<pg8::EpiBf<1>, pg8::StaticOrder>(lds, g, S, E);
        }
        GSYNC();
        for (int rep = 0; rep < REP_DN; ++rep) {
            const Args a = load_args();
            const unsigned char* wl = a.ws + WS_W + (size_t)l * WL_STRIDE;
            pg8::Gemm g{(const bf16_t*)(a.ws + WS_PROJ), (const bf16_t*)(wl + WO_DN), MROWS, DM, FFN}; pg8::StaticOrder S; S.init(MROWS, DM, G, (int)blockIdx.x);
            pg8::EpiBf<0> E{(bf16_t*)(a.ws + WS_Y), DM};
            pg8::gemm_phase<pg8::EpiBf<0>, pg8::StaticOrder>(lds, g, S, E);
        }
        GSYNC();
        {
            const Args a = load_args(); TIDS();
            if (l + 1 < DEPTH) row_phase<true, true>((const bf16_t*)(a.ws + WS_Y), a.ws + WS_HB, a.ws + WS_HB, a.n_ffn_post + (size_t)l * DM, a.n_mix_pre + (size_t)(l + 1) * DM, (bf16_t*)(a.ws + WS_XN), gw, NGW, lane);
            else row_phase<true, false>((const bf16_t*)(a.ws + WS_Y), a.ws + WS_HB, a.out, a.n_ffn_post + (size_t)l * DM, nullptr, (bf16_t*)(a.ws + WS_XN), gw, NGW, lane);
        }
        if (l + 1 < DEPTH) GSYNC();
    }
#undef TIDS
}

extern "C" void kernel_launch(void* const* d_in, const int* in_sizes, int n_in, void* d_out, int out_size, void* d_ws, size_t ws_size, hipStream_t stream) {
    static int grid = 0;
    if (grid == 0) {
        if (n_in != 20 || out_size != MROWS * DM || ws_size < WS_END) { fprintf(stderr, "kernel_launch: unexpected shapes (n_in %d out %d ws %zu)\n", n_in, out_size, ws_size); grid = -1; return; }
        int dev = 0, cus = 0, per_cu = 0;
        (void)hipGetDevice(&dev);
        (void)hipDeviceGetAttribute(&cus, hipDeviceAttributeMultiprocessorCount, dev);
        if (hipFuncSetAttribute((const void*)fwd_kernel, hipFuncAttributeMaxDynamicSharedMemorySize, LDS_BYTES) != hipSuccess) { fprintf(stderr, "kernel_launch: hipFuncSetAttribute failed\n"); grid = -1; return; }
        (void)hipOccupancyMaxActiveBlocksPerMultiprocessor(&per_cu, (const void*)fwd_kernel, 512, LDS_BYTES);
        if (per_cu < 1) { fprintf(stderr, "kernel_launch: occupancy query says %d\n", per_cu); per_cu = 1; }
        (void)hipGetLastError();
        grid = cus;
        if (grid > 256) grid = 256;
    }
    if (grid < 0) return;
    (void)hipMemsetAsync((char*)d_ws + WS_CTL, 0, CTL_BYTES, stream);
    Args a{};
    a.x = (const float*)d_in[0]; a.pos = (const int*)d_in[1];
    a.n_mix_pre = (const float*)d_in[2]; a.n_mix_post = (const float*)d_in[3]; a.n_ffn_pre = (const float*)d_in[4]; a.n_ffn_post = (const float*)d_in[5];
    a.w_in = (const float*)d_in[6]; a.gm_ln_g = (const float*)d_in[7]; a.gm_ln_b = (const float*)d_in[8]; a.gm_w_s = (const float*)d_in[9]; a.gm_b_s = (const float*)d_in[10];
    a.da_lambda = (const float*)d_in[11]; a.da_subln_g = (const float*)d_in[12]; a.fa_b_f = (const float*)d_in[13]; a.pool_w = (const float*)d_in[14]; a.pool_scale = (const float*)d_in[15];
    a.w_branch = (const float*)d_in[16]; a.w_out = (const float*)d_in[17]; a.w_ffn_up = (const float*)d_in[18]; a.w_ffn_down = (const float*)d_in[19];
    a.out = (float*)d_out; a.ws = (unsigned char*)d_ws;
    void* args[] = {&a};
    hipError_t e = hipLaunchCooperativeKernel((const void*)fwd_kernel, dim3(grid), dim3(512), args, LDS_BYTES, stream);
    if (e != hipSuccess) fprintf(stderr, "cooperative launch failed: %s (grid %d)\n", hipGetErrorString(e), grid);
}
```

```cpp
#include <hip/hip_runtime.h>
#include <hip/hip_cooperative_groups.h>
#include <cstdio>
#include <cstdint>
namespace cg = cooperative_groups;
#ifndef REP_P0
#define REP_P0 1
#endif
#ifndef REP_IN
#define REP_IN 1
#endif
#ifndef REP_MIX
#define REP_MIX 1
#endif
#ifndef REP_MERGE
#define REP_MERGE 1
#endif
#ifndef REP_OUT
#define REP_OUT 1
#endif
#ifndef REP_UP
#define REP_UP 1
#endif
#ifndef REP_DN
#define REP_DN 1
#endif
#ifndef REP_ROW
#define REP_ROW 1
#endif
#ifndef REP_SYNC
#define REP_SYNC 1
#endif
#ifndef USE_CG_SYNC
#define USE_CG_SYNC 0
#endif
#define GSYNC() do { for (int _r = 0; _r < REP_SYNC; ++_r) { if (USE_CG_SYNC) grid.sync(); else { XcdBarrier _b; _b.bar = xbar_words; _b.x = xbar_x; _b.st = (volatile LAS unsigned*)(lds + LDS_MISC + 32); xcd_barrier(_b); } } } while (0)

#define LAS __attribute__((address_space(3)))
typedef unsigned short bf16_t;
typedef short bf16x8 __attribute__((ext_vector_type(8)));
typedef float f32x4 __attribute__((ext_vector_type(4)));
typedef unsigned u32x4 __attribute__((ext_vector_type(4)));
typedef unsigned u32x2 __attribute__((ext_vector_type(2)));

constexpr int DM = 2048, NBATCH = 4, SEQ = 2048, MROWS = NBATCH * SEQ, DEPTH = 2;
constexpr int INC = 12804;
constexpr int NP = 12800;
constexpr int NIN = 13056;
constexpr int FFN = 8192;
constexpr int P_AU = 0, P_AV = 512, P_BQ = 1024, P_BK = 1536, P_BV = 2048, P_CQ = 2560, P_CK = 3072, P_CV = 3584, P_DH = 4096, P_GATE = 4608;
constexpr float NORM_EPS = 1e-6f;
constexpr float LOG2E = 1.4426950408889634f;

constexpr size_t MiB = 1u << 20;
constexpr size_t WS_CTL = 0, CTL_BYTES = 65536;
constexpr int CW_BAR = 4096;
constexpr size_t WS_W = 1 * MiB, WL_STRIDE = 132 * MiB;
constexpr size_t WO_IN = 0, WO_BR = 51 * MiB, WO_OUT = 59 * MiB, WO_UP = 67 * MiB, WO_DN = 99 * MiB, WO_POOL = 131 * MiB;
constexpr size_t WS_PROJ = 266 * MiB;
constexpr size_t WS_XN = 466 * MiB;
constexpr size_t WS_BR = 498 * MiB;
constexpr size_t WS_MB = 530 * MiB;
constexpr size_t WS_Y = 562 * MiB;
constexpr size_t WS_FLOG = 626 * MiB;
constexpr size_t WS_ROT = 627 * MiB;
constexpr size_t WS_HB = 628 * MiB;
constexpr size_t WS_END = 660 * MiB;

constexpr int LDS_BYTES = 139264;
constexpr int LDS_MISC = 135168;

__device__ __forceinline__ unsigned f2bf(float f) { unsigned u = __builtin_bit_cast(unsigned, f); return (u + 0x7fffu + ((u >> 16) & 1u)) >> 16; }
__device__ __forceinline__ unsigned pk2(float lo, float hi) { return f2bf(lo) | (f2bf(hi) << 16); }
__device__ __forceinline__ float bflo(unsigned w) { return __builtin_bit_cast(float, w << 16); }
__device__ __forceinline__ float bfhi(unsigned w) { return __builtin_bit_cast(float, w & 0xffff0000u); }
__device__ __forceinline__ float wave_sum(float v) {
#pragma unroll
    for (int o = 1; o < 64; o <<= 1) v += __shfl_xor(v, o);
    return v;
}
#define LDS_WAIT() asm volatile("s_waitcnt lgkmcnt(0)" ::: "memory")

namespace pg8 {
constexpr int BM = 256, BK = 64, HALF = 128, HTB = HALF * BK * 2, STAGE_BYTES = 8 * HTB, NXCD = 8, WGM = 8;
__host__ __device__ __forceinline__ int lds_byte(int r, int c) { const int st = (r >> 4) * 2 + (c >> 5), rr = r & 15, cc = c & 31, ob = rr * 64 + cc * 2; return st * 1024 + (ob ^ (((ob >> 9) & 1) << 5)); }
__host__ __device__ __forceinline__ void stage_rc(int b, int& R, int& C) { const int st = b / 1024, sb = b % 1024, swz = sb ^ (((sb >> 9) & 1) << 5); R = (st >> 1) * 16 + swz / 64; C = (st & 1) * 32 + (swz % 64) / 2; }
__host__ __device__ __forceinline__ int perm32(int rho) { const int n = rho >> 4, i = rho & 15; return 8 * (i >> 2) + 4 * n + (i & 3); }

struct Unit { int pm, pn; };
struct Gemm { const bf16_t* A; const bf16_t* Bt; int M, N, K; };

struct StaticOrder {
    int nM, nN, nwg, G, c, nrep;
    __device__ void init(int M, int N, int G_, int c_, int nrep_ = 1) { nM = M / BM; nN = N / BM; nwg = nM * nN; G = G_; c = c_; nrep = nrep_; asm volatile("" : "+s"(c), "+s"(G)); }
    __device__ bool next(int i, Unit& u) const {
        long L = (long)i * G + c; if (L >= (long)nwg * nrep) return false;
        if (nrep > 1) L %= nwg;
        int wgid = (int)L; { const int q = nwg / NXCD, r = nwg % NXCD, xcd = wgid % NXCD, off = wgid / NXCD; wgid = (xcd < r ? xcd * (q + 1) : r * (q + 1) + (xcd - r) * q) + off; }
        const int nig = WGM * nN, gid = wgid / nig, fm = gid * WGM, gsz = (nM - fm) < WGM ? (nM - fm) : WGM;
        u.pm = fm + ((wgid % nig) % gsz); u.pn = (wgid % nig) / gsz; return true;
    }
};

struct InOrder : StaticOrder {
    int i0, i1;
    __device__ void init(int M, int N, int G_, int c_, int i0_, int i1_) { StaticOrder::init(M, N, G_, c_, 1); i0 = i0_; i1 = i1_; }
    __device__ bool next(int i, Unit& u) const {
        if (i + i0 >= i1) return false;
        const bool ok = StaticOrder::next(i + i0, u);
        if (ok) { const int v = u.pn;
            u.pn = (v == 0) ? 50 : (v <= 9 ? v - 1 : (v <= 25 ? v + 8 : (v <= 34 ? v - 17 : v - 1))); }
        return ok;
    }
};
__device__ __forceinline__ unsigned cvt_pk_bf16(float lo, float hi) { unsigned r; asm volatile("v_cvt_pk_bf16_f32 %0, %1, %2" : "=v"(r) : "v"(lo), "v"(hi)); return r; }


struct EpiIn {
    static constexpr bool PERM = true, FOLD = false;
    bf16_t* O; float* flog; const float* rot; const float* bfv;
    __device__ __forceinline__ void operator()(const f32x4 (&acc)[2][2][4][2], const Unit& u, int wr, int wc, int fr, int fq) const {
        const int row0 = u.pm * BM + wr * 64 + fr;
        if (u.pn == 50) {
            if (wc == 0 && fq == 0) {
                const f32x4 b = *(const f32x4*)bfv;
#pragma unroll
                for (int ai = 0; ai < 2; ++ai)
#pragma unroll
                    for (int m = 0; m < 4; ++m) *(f32x4*)(flog + (size_t)(row0 + ai * HALF + m * 16) * 4) = acc[ai][0][m][0] + b;
            }
            return;
        }
        const int col0 = u.pn * BM + wc * 32 + 8 * fq;
        const bool sig = u.pn >= 18;
        const bool rotary = (u.pn >= 4) && (u.pn < 8) && ((wc & 1) == 0);
        const float sg = (fq == 0) ? -1.f : 1.f;
#pragma unroll
        for (int ai = 0; ai < 2; ++ai)
#pragma unroll
            for (int m = 0; m < 4; ++m) {
                const int row = row0 + ai * HALF + m * 16;
                bf16_t* rowp = O + (size_t)row * NP + col0;
                f32x4 v[2][2];
#pragma unroll
                for (int bj = 0; bj < 2; ++bj) { v[bj][0] = acc[ai][bj][m][0]; v[bj][1] = acc[ai][bj][m][1]; }
                if (rotary) {
                    const f32x4* rp = (const f32x4*)(rot + (size_t)row * 16);
#pragma unroll
                    for (int n = 0; n < 2; ++n) {
                        const f32x4 ca = rp[2 * n], cb = rp[2 * n + 1];
                        const float cc[4] = {ca[0], ca[2], cb[0], cb[2]};
                        const float ss[4] = {ca[1] * sg, ca[3] * sg, cb[1] * sg, cb[3] * sg};
#pragma unroll
                        for (int bj = 0; bj < 2; ++bj)
#pragma unroll
                            for (int j = 0; j < 4; ++j) {
                                const float own = v[bj][n][j];
                                const float par = __shfl_xor(own, 16);
                                const float nv = own * cc[j] + par * ss[j];
                                v[bj][n][j] = (fq < 2) ? nv : own;
                            }
                    }
                    asm volatile("" ::: "memory");
                }
#pragma unroll
                for (int bj = 0; bj < 2; ++bj) {
                    f32x4 v0 = v[bj][0], v1 = v[bj][1];
                    if (sig) {
#pragma unroll
                        for (int j = 0; j < 4; ++j) {
                            v0[j] = __builtin_amdgcn_rcpf(1.0f + __builtin_amdgcn_exp2f(v0[j]));
                            v1[j] = __builtin_amdgcn_rcpf(1.0f + __builtin_amdgcn_exp2f(v1[j]));
                        }
                    }
                    u32x4 w; w.x = cvt_pk_bf16(v0[0], v0[1]); w.y = cvt_pk_bf16(v0[2], v0[3]); w.z = cvt_pk_bf16(v1[0], v1[1]); w.w = cvt_pk_bf16(v1[2], v1[3]);
                    *(u32x4*)(rowp + bj * HALF) = w;
                }
            }
    }
};
template <int ACT> struct EpiBf {
    static constexpr bool PERM = true, FOLD = false;
    bf16_t* O; int ldc;
    __device__ __forceinline__ void operator()(const f32x4 (&acc)[2][2][4][2], const Unit& u, int wr, int wc, int fr, int fq) const {
        const int row0 = u.pm * BM + wr * 64 + fr, col0 = u.pn * BM + wc * 32 + 8 * fq;
#pragma unroll
        for (int ai = 0; ai < 2; ++ai)
#pragma unroll
            for (int m = 0; m < 4; ++m) {
                bf16_t* rowp = O + (size_t)(row0 + ai * HALF + m * 16) * ldc + col0;
#pragma unroll
                for (int bj = 0; bj < 2; ++bj) {
                    f32x4 v0 = acc[ai][bj][m][0], v1 = acc[ai][bj][m][1];
#pragma unroll
                    for (int j = 0; j < 4; ++j) { if (ACT == 1) { const float a = fmaxf(v0[j], 0.f), b = fmaxf(v1[j], 0.f); v0[j] = a * a; v1[j] = b * b; } }
                    u32x4 w; w.x = cvt_pk_bf16(v0[0], v0[1]); w.y = cvt_pk_bf16(v0[2], v0[3]); w.z = cvt_pk_bf16(v1[0], v1[1]); w.w = cvt_pk_bf16(v1[2], v1[3]);
                    *(u32x4*)(rowp + bj * HALF) = w;
                }
            }
    }
};
struct EpiF32 {
    static constexpr bool PERM = false, FOLD = false;
    float* C; int ldc;
    __device__ __forceinline__ void operator()(const f32x4 (&acc)[2][2][4][2], const Unit& u, int wr, int wc, int fr, int fq) const {
        const int row0 = u.pm * BM + wr * 64 + fr, col0 = u.pn * BM + wc * 32 + 4 * fq;
#pragma unroll
        for (int ai = 0; ai < 2; ++ai)
#pragma unroll
            for (int m = 0; m < 4; ++m) {
                float* rowp = C + (size_t)(row0 + ai * HALF + m * 16) * ldc + col0;
#pragma unroll
                for (int bj = 0; bj < 2; ++bj)
#pragma unroll
                    for (int n = 0; n < 2; ++n) *(f32x4*)(rowp + bj * HALF + n * 16) = acc[ai][bj][m][n];
            }
    }
};
struct EpiMergeFold {
    static constexpr bool PERM = true, FOLD = true;
    const bf16_t* gate;
    bf16_t* MBo;
    static __device__ __forceinline__ void unpack8(const u32x4 w, float (&f)[8]) {
        f[0] = bflo(w.x); f[1] = bfhi(w.x); f[2] = bflo(w.y); f[3] = bfhi(w.y); f[4] = bflo(w.z); f[5] = bfhi(w.z); f[6] = bflo(w.w); f[7] = bfhi(w.w);
#pragma unroll
        for (int j = 0; j < 8; ++j) f[j] = fmaxf(f[j], 1e-30f);
    }
    static __device__ __forceinline__ float ratio(float n, float d) { return fmaxf(n, 1e-30f) * __builtin_amdgcn_rcpf(fmaxf(d, 1e-30f)); }
    __device__ __forceinline__ void fold(f32x4 (&acc)[2][2][4][2], const Unit& u, int nb, int wr, int wc, int fr, int fq) const {
        const bf16_t* gbase = gate + (size_t)(u.pm * BM + wr * 64 + fr) * NP + (size_t)nb * DM + (u.pn * BM + wc * 32 + 8 * fq);
#pragma unroll
        for (int ai = 0; ai < 2; ++ai) {
            u32x4 wn[4][2], wd[4][2];
#pragma unroll
            for (int m = 0; m < 4; ++m)
#pragma unroll
                for (int bj = 0; bj < 2; ++bj) {
                    const bf16_t* gp = gbase + (size_t)(ai * HALF + m * 16) * NP + bj * HALF;
                    wn[m][bj] = *(const u32x4*)(gp - DM);
                    wd[m][bj] = *(const u32x4*)gp;
                }
#pragma unroll
            for (int m = 0; m < 4; ++m)
#pragma unroll
                for (int bj = 0; bj < 2; ++bj) {
                    const u32x4 a = wn[m][bj], d = wd[m][bj];
                    f32x4 r0, r1;
                    r0[0] = ratio(bflo(a.x), bflo(d.x)); r0[1] = ratio(bfhi(a.x), bfhi(d.x)); r0[2] = ratio(bflo(a.y), bflo(d.y)); r0[3] = ratio(bfhi(a.y), bfhi(d.y));
                    r1[0] = ratio(bflo(a.z), bflo(d.z)); r1[1] = ratio(bfhi(a.z), bfhi(d.z)); r1[2] = ratio(bflo(a.w), bflo(d.w)); r1[3] = ratio(bfhi(a.w), bfhi(d.w));
                    acc[ai][bj][m][0] *= r0; acc[ai][bj][m][1] *= r1;
                }
            asm volatile("" ::: "memory");
        }
    }
    __device__ __forceinline__ void operator()(const f32x4 (&acc)[2][2][4][2], const Unit& u, int wr, int wc, int fr, int fq) const {
        const int row0 = u.pm * BM + wr * 64 + fr, col0 = u.pn * BM + wc * 32 + 8 * fq;
        u32x4 gw[2][4][2];
#pragma unroll
        for (int ai = 0; ai < 2; ++ai)
#pragma unroll
            for (int m = 0; m < 4; ++m)
#pragma unroll
                for (int bj = 0; bj < 2; ++bj) gw[ai][m][bj] = *(const u32x4*)(gate + (size_t)(row0 + ai * HALF + m * 16) * NP + (size_t)3 * DM + col0 + bj * HALF);
#pragma unroll
        for (int ai = 0; ai < 2; ++ai)
#pragma unroll
            for (int m = 0; m < 4; ++m) {
                bf16_t* rowp = MBo + (size_t)(row0 + ai * HALF + m * 16) * DM + col0;
#pragma unroll
                for (int bj = 0; bj < 2; ++bj) {
                    float g[8]; unpack8(gw[ai][m][bj], g);
                    const f32x4 v0 = acc[ai][bj][m][0], v1 = acc[ai][bj][m][1];
                    u32x4 w; w.x = cvt_pk_bf16(v0[0] * g[0], v0[1] * g[1]); w.y = cvt_pk_bf16(v0[2] * g[2], v0[3] * g[3]); w.z = cvt_pk_bf16(v1[0] * g[4], v1[1] * g[5]); w.w = cvt_pk_bf16(v1[2] * g[6], v1[3] * g[7]);
                    *(u32x4*)(rowp + bj * HALF) = w;
                }
            }
    }
};

template <class Epi, class Sched, bool ALIGN_EPI = true, bool SP2 = true>
__device__ __forceinline__ void gemm_phase(LAS unsigned char* lds, const Gemm g, const Sched& S, const Epi& E) {
    int tid = threadIdx.x; asm volatile("" : "+v"(tid));
    const int wid = __builtin_amdgcn_readfirstlane(tid >> 6), lane = tid & 63, wr = wid >> 2, wc = wid & 3, fr = lane & 15, fq = lane >> 4;
    const int K = g.K, nt = K / BK;
    unsigned voffA[2], voffB[2];
#pragma unroll
    for (int i = 0; i < 2; ++i) { int R, C; stage_rc(tid * 16 + i * 8192, R, C); const int Rb = Epi::PERM ? ((R & ~31) + perm32(R & 31)) : R;
        voffA[i] = (unsigned)(R * K + C) * 2u; voffB[i] = (unsigned)(Rb * K + C) * 2u; }
    const size_t kstep = (size_t)(BK * 2);
    const size_t hstep = (size_t)HALF * K * 2;
    const size_t tstep = 2 * hstep;
    const unsigned ldsw = (unsigned)wid * 1024u;
    const int aoff = lds_byte(wr * 64 + fr, fq * 8), boff = lds_byte(wc * 32 + fr, fq * 8);
#define PG8_SA(b, h) (((b) * 2 + (h)) * HTB)
#define PG8_SB(b, h) ((4 + (b) * 2 + (h)) * HTB)
#define PG8_STAGE(bufoff, gbase, voff) do { _Pragma("unroll") for (int _i = 0; _i < 2; ++_i) \
        __builtin_amdgcn_global_load_lds((const unsigned*)((const char*)(gbase) + (voff)[_i]), (LAS unsigned*)(lds + (bufoff) + ldsw + _i * 8192), 16, 0, 0); } while (0)
#define PG8_LDA(dst, b, h) do { _Pragma("unroll") for (int m = 0; m < 4; ++m) _Pragma("unroll") for (int k = 0; k < 2; ++k) dst[m][k] = *(const LAS bf16x8*)(lds + PG8_SA(b, h) + aoff + m * 2048 + k * 1024); } while (0)
#define PG8_LDB(dst, b, h) do { _Pragma("unroll") for (int n = 0; n < 2; ++n) _Pragma("unroll") for (int k = 0; k < 2; ++k) dst[n][k] = *(const LAS bf16x8*)(lds + PG8_SB(b, h) + boff + n * 2048 + k * 1024); } while (0)
#define PG8_MMA(ai, bj, At, Bt) do { __builtin_amdgcn_s_setprio(1); _Pragma("unroll") for (int m = 0; m < 4; ++m) _Pragma("unroll") for (int n = 0; n < 2; ++n) _Pragma("unroll") for (int k = 0; k < 2; ++k) \
        acc[ai][bj][m][n] = __builtin_amdgcn_mfma_f32_16x16x32_bf16(Bt[n][k], At[m][k], acc[ai][bj][m][n], 0, 0, 0); __builtin_amdgcn_s_setprio(0); } while (0)
#define PG8_WAIT_V(n) asm volatile("s_waitcnt vmcnt(" #n ")" ::: "memory")
#define PG8_WAIT_L(n) asm volatile("s_waitcnt lgkmcnt(" #n ")" ::: "memory")
#define PG8_BAR __builtin_amdgcn_s_barrier()
#define PG8_SCHED __builtin_amdgcn_sched_barrier(0)
    Unit cur, nxt; int ui = 0;
    if (!S.next(0, cur)) return;
    f32x4 acc[2][2][4][2];
#pragma unroll
    for (int a = 0; a < 2; ++a)
#pragma unroll
        for (int b = 0; b < 2; ++b)
#pragma unroll
            for (int m = 0; m < 4; ++m)
#pragma unroll
                for (int n = 0; n < 2; ++n) acc[a][b][m][n] = (f32x4){0.f, 0.f, 0.f, 0.f};
    bf16x8 At[4][2], B0[2][2], B1[2][2];
    const char* cA = (const char*)g.A + (size_t)cur.pm * tstep; const char* cB = (const char*)g.Bt + (size_t)cur.pn * tstep;
    if constexpr (SP2) {
        PG8_STAGE(PG8_SB(0, 0), cB, voffB); PG8_STAGE(PG8_SB(0, 1), cB + hstep, voffB); PG8_STAGE(PG8_SA(0, 0), cA, voffA); PG8_STAGE(PG8_SA(0, 1), cA + hstep, voffA);
        if (wr == 1) PG8_BAR;
        PG8_WAIT_V(2); PG8_BAR;
        PG8_STAGE(PG8_SB(1, 0), cB + kstep, voffB); PG8_STAGE(PG8_SA(1, 0), cA + kstep, voffA); PG8_STAGE(PG8_SB(1, 1), cB + hstep + kstep, voffB);
        PG8_WAIT_V(6); PG8_BAR;
    } else {
        PG8_STAGE(PG8_SB(0, 0), cB, voffB); PG8_STAGE(PG8_SA(0, 0), cA, voffA); PG8_STAGE(PG8_SB(0, 1), cB + hstep, voffB); PG8_STAGE(PG8_SA(0, 1), cA + hstep, voffA);
        if (wr == 1) PG8_BAR;
        PG8_WAIT_V(4); PG8_BAR;
        PG8_STAGE(PG8_SB(1, 0), cB + kstep, voffB); PG8_STAGE(PG8_SA(1, 0), cA + kstep, voffA); PG8_STAGE(PG8_SB(1, 1), cB + hstep + kstep, voffB);
        PG8_WAIT_V(6); PG8_BAR;
    }
    for (;;) {
        const bool has_next = S.next(ui + 1, nxt);
        const char* nA = has_next ? (const char*)g.A + (size_t)nxt.pm * tstep : cA; const char* nB = has_next ? (const char*)g.Bt + (size_t)nxt.pn * tstep : cB;
        for (int t = 0; t < nt; t += 2) {
            const bool last = (t == nt - 2);
            const char* a1 = cA + (size_t)(t + 1) * kstep;
            const char* a2 = last ? nA : cA + (size_t)(t + 2) * kstep; const char* b2 = last ? nB : cB + (size_t)(t + 2) * kstep;
            const char* a3 = a2 + kstep; const char* b3 = b2 + kstep;
            if constexpr (Epi::FOLD) { if (t > 0 && (t & 7) == 0) E.fold(acc, cur, t >> 3, wr, wc, fr, fq); }
            if constexpr (SP2) {
            PG8_LDB(B0, 0, 0); PG8_LDB(B1, 0, 1); PG8_SCHED; PG8_LDA(At, 0, 0); PG8_STAGE(PG8_SA(1, 1), a1 + hstep, voffA);
            PG8_WAIT_V(8); PG8_WAIT_L(0); PG8_BAR; PG8_MMA(0, 0, At, B0); PG8_MMA(0, 1, At, B1); PG8_BAR; PG8_SCHED;
            PG8_LDA(At, 0, 1); PG8_STAGE(PG8_SB(0, 0), b2, voffB); PG8_STAGE(PG8_SB(0, 1), b2 + hstep, voffB); PG8_STAGE(PG8_SA(0, 0), a2, voffA);
            PG8_WAIT_V(8); PG8_WAIT_L(0); PG8_BAR; PG8_MMA(1, 0, At, B0); PG8_MMA(1, 1, At, B1); PG8_BAR; PG8_SCHED;
            PG8_LDB(B0, 1, 0); PG8_LDB(B1, 1, 1); PG8_SCHED; PG8_LDA(At, 1, 0); PG8_STAGE(PG8_SA(0, 1), a2 + hstep, voffA);
            PG8_WAIT_V(8); PG8_WAIT_L(0); PG8_BAR; PG8_MMA(0, 0, At, B0); PG8_MMA(0, 1, At, B1); PG8_BAR; PG8_SCHED;
            PG8_LDA(At, 1, 1); PG8_STAGE(PG8_SB(1, 0), b3, voffB); PG8_STAGE(PG8_SB(1, 1), b3 + hstep, voffB); PG8_STAGE(PG8_SA(1, 0), a3, voffA);
            PG8_WAIT_V(8); PG8_WAIT_L(0); PG8_BAR; PG8_MMA(1, 0, At, B0); PG8_MMA(1, 1, At, B1); PG8_BAR; PG8_SCHED;
            } else {
            PG8_LDB(B0, 0, 0); PG8_SCHED; PG8_LDA(At, 0, 0); PG8_STAGE(PG8_SA(1, 1), a1 + hstep, voffA);
            PG8_WAIT_L(8); PG8_BAR; PG8_WAIT_L(0); PG8_MMA(0, 0, At, B0); PG8_BAR; PG8_SCHED;
            PG8_LDB(B1, 0, 1); PG8_STAGE(PG8_SB(0, 0), b2, voffB);
            PG8_BAR; PG8_WAIT_L(0); PG8_MMA(0, 1, At, B1); PG8_BAR;
            PG8_LDA(At, 0, 1); PG8_STAGE(PG8_SA(0, 0), a2, voffA);
            PG8_BAR; PG8_WAIT_L(0); PG8_MMA(1, 0, At, B0); PG8_BAR; PG8_SCHED;
            PG8_STAGE(PG8_SB(0, 1), b2 + hstep, voffB);
            PG8_WAIT_V(6); PG8_BAR; PG8_MMA(1, 1, At, B1); PG8_BAR;
            PG8_LDB(B0, 1, 0); PG8_SCHED; PG8_LDA(At, 1, 0); PG8_STAGE(PG8_SA(0, 1), a2 + hstep, voffA);
            PG8_WAIT_L(8); PG8_BAR; PG8_WAIT_L(0); PG8_MMA(0, 0, At, B0); PG8_BAR; PG8_SCHED;
            PG8_LDB(B1, 1, 1); PG8_STAGE(PG8_SB(1, 0), b3, voffB);
            PG8_BAR; PG8_WAIT_L(0); PG8_MMA(0, 1, At, B1); PG8_BAR;
            PG8_LDA(At, 1, 1); PG8_STAGE(PG8_SA(1, 0), a3, voffA);
            PG8_BAR; PG8_WAIT_L(0); PG8_MMA(1, 0, At, B0); PG8_BAR; PG8_SCHED;
            PG8_STAGE(PG8_SB(1, 1), b3 + hstep, voffB);
            PG8_WAIT_V(6); PG8_BAR; PG8_MMA(1, 1, At, B1); PG8_BAR;
            }
        }
        if constexpr (ALIGN_EPI) { if (wr == 0) PG8_BAR; }
        E(acc, cur, wr, wc, fr, fq);
        if (!has_next) break;
#pragma unroll
        for (int a = 0; a < 2; ++a)
#pragma unroll
            for (int b = 0; b < 2; ++b)
#pragma unroll
                for (int m = 0; m < 4; ++m)
#pragma unroll
                    for (int n = 0; n < 2; ++n) acc[a][b][m][n] = (f32x4){0.f, 0.f, 0.f, 0.f};
        cur = nxt; cA = nA; cB = nB; ++ui;
        if constexpr (ALIGN_EPI) { if (wr == 1) PG8_BAR; }
    }
    PG8_WAIT_V(0);
    if constexpr (!ALIGN_EPI) { if (wr == 0) PG8_BAR; }
    PG8_BAR;
#undef PG8_SA
#undef PG8_SB
#undef PG8_STAGE
#undef PG8_LDA
#undef PG8_LDB
#undef PG8_MMA
#undef PG8_WAIT_V
#undef PG8_WAIT_L
#undef PG8_BAR
#undef PG8_SCHED
}
}

struct Args {
    const float* x; const int* pos;
    const float *n_mix_pre, *n_mix_post, *n_ffn_pre, *n_ffn_post, *w_in, *gm_ln_g, *gm_ln_b, *gm_w_s, *gm_b_s, *da_lambda, *da_subln_g, *fa_b_f,
                *pool_w, *pool_scale, *w_branch, *w_out, *w_ffn_up, *w_ffn_down;
    float* out; unsigned char* ws;
};

struct TrDesc { const float* sp; size_t ld; bf16_t* dp; int K; float scale; bool ok; };
__device__ __forceinline__ void tr_load(const TrDesc& d, f32x4 (&v)[16]) {
#pragma unroll
    for (int i = 0; i < 16; ++i) v[i] = d.ok ? __builtin_nontemporal_load((const f32x4*)(d.sp + (size_t)(4 * i) * d.ld)) : (f32x4){0.f, 0.f, 0.f, 0.f};
}
__device__ __forceinline__ void tr_finish(const TrDesc& d, const f32x4 (&v)[16], LAS float* scr, int lane) {
    const int c4 = (lane & 15) * 4, kr = lane >> 4;
#pragma unroll
    for (int i = 0; i < 16; ++i) {
        LAS float* p = scr + (4 * i + kr) * 65 + c4;
        p[0] = v[i][0] * d.scale; p[1] = v[i][1] * d.scale; p[2] = v[i][2] * d.scale; p[3] = v[i][3] * d.scale;
    }
    LDS_WAIT();
    const int c = lane & 7;
#pragma unroll
    for (int j = 0; j < 8; ++j) {
        const int n = (lane >> 3) + 8 * j;
        const LAS float* s = scr + (8 * c) * 65 + n;
        u32x4 o; o.x = pg8::cvt_pk_bf16(s[0], s[65]); o.y = pg8::cvt_pk_bf16(s[2 * 65], s[3 * 65]); o.z = pg8::cvt_pk_bf16(s[4 * 65], s[5 * 65]); o.w = pg8::cvt_pk_bf16(s[6 * 65], s[7 * 65]);
        *(u32x4*)(d.dp + (size_t)n * d.K + 8 * c) = o;
    }
    LDS_WAIT();
}

__device__ __forceinline__ void rms_row_bf16(const float* xrow, const f32x4 (&gv)[8], bf16_t* orow, int lane) {
    f32x4 v[8]; float s = 0.f;
#pragma unroll
    for (int j = 0; j < 8; ++j) { v[j] = *((const f32x4*)xrow + lane + 64 * j); s += (v[j][0] * v[j][0] + v[j][1] * v[j][1]) + (v[j][2] * v[j][2] + v[j][3] * v[j][3]); }
    const float rstd = 1.0f / sqrtf(wave_sum(s) * (1.0f / DM) + NORM_EPS);
#pragma unroll
    for (int j = 0; j < 8; ++j) {
        u32x2 w; w.x = pk2(v[j][0] * rstd * gv[j][0], v[j][1] * rstd * gv[j][1]); w.y = pk2(v[j][2] * rstd * gv[j][2], v[j][3] * rstd * gv[j][3]);
        *((u32x2*)orow + lane + 64 * j) = w;
    }
}

__device__ __forceinline__ void phase0(const Args& a, LAS unsigned char* lds, int gw, int NGW, int wave, int lane) {
    LAS float* scr = (LAS float*)(lds + wave * 16640);
    constexpr int I_IN = 32 * 204, I_BR = 4 * 8 * 32, I_OUT = 32 * 32, I_UP = 32 * 128, I_DN = 128 * 32, I_POOL = 16;
    constexpr int I_LAYER = I_IN + I_BR + I_OUT + I_UP + I_DN + I_POOL, I_ALL = DEPTH * I_LAYER;
    const int c4 = (lane & 15) * 4, kr = lane >> 4;
    auto decode = [&](int it) -> TrDesc {
        const int l = it / I_LAYER; int r = it - l * I_LAYER;
        unsigned char* wl = a.ws + WS_W + (size_t)l * WL_STRIDE;
        const float* src; size_t ld; int sc, nv = 64, k0, n0, K; bf16_t* dst; float scale = 1.0f;
        if (r < I_IN) {
            const int kb = r / 204, nb = r % 204; n0 = nb * 64; k0 = kb * 64;
            if (nb < 64) { sc = n0; } else if (nb < 200) { sc = n0 + 4; } else if (nb == 200) { sc = 4096; nv = 4; } else { sc = 0; nv = 0; }
            src = a.w_in + (size_t)l * DM * INC; ld = INC; dst = (bf16_t*)(wl + WO_IN); K = DM;
            scale = (nb >= 72 && nb < 200) ? -LOG2E : 1.0f;
        } else if ((r -= I_IN) < I_BR) {
            const int n = r / 256, rr = r % 256, kb = rr / 32, nb = rr % 32; n0 = nb * 64; k0 = kb * 64; sc = n0;
            src = a.w_branch + ((size_t)l * 4 + n) * 512 * DM; ld = DM; dst = (bf16_t*)(wl + WO_BR) + n * 512; K = DM;
        } else if ((r -= I_BR) < I_OUT) {
            const int kb = r / 32, nb = r % 32; n0 = nb * 64; k0 = kb * 64; sc = n0;
            src = a.w_out + (size_t)l * DM * DM; ld = DM; dst = (bf16_t*)(wl + WO_OUT); K = DM;
        } else if ((r -= I_OUT) < I_UP) {
            const int kb = r / 128, nb = r % 128; n0 = nb * 64; k0 = kb * 64; sc = n0;
            src = a.w_ffn_up + (size_t)l * DM * FFN; ld = FFN; dst = (bf16_t*)(wl + WO_UP); K = DM;
        } else if ((r -= I_UP) < I_DN) {
            const int kb = r / 32, nb = r % 32; n0 = nb * 64; k0 = kb * 64; sc = n0;
            src = a.w_ffn_down + (size_t)l * FFN * DM; ld = DM; dst = (bf16_t*)(wl + WO_DN); K = FFN;
        } else {
            r -= I_DN;
            const int g = r / 4, rr = r % 4, kb = rr / 2, nb = rr % 2; n0 = nb * 64; k0 = kb * 64; sc = n0;
            src = a.pool_w + ((size_t)l * 4 + g) * 128 * 128; ld = 128; dst = (bf16_t*)(wl + WO_POOL) + (size_t)g * 128 * 128; K = 128;
        }
        TrDesc d; d.sp = src + (size_t)(k0 + kr) * ld + sc + c4; d.ld = ld; d.dp = dst + (size_t)n0 * K + k0; d.K = K; d.scale = scale; d.ok = c4 < nv;
        return d;
    };
    {
        int it = gw; TrDesc dA, dB; f32x4 vA[16], vB[16];
        if (it < I_ALL) { dA = decode(it); tr_load(dA, vA); }
        while (it < I_ALL) {
            const int itB = it + NGW;
            if (itB < I_ALL) { dB = decode(itB); tr_load(dB, vB); }
            tr_finish(dA, vA, scr, lane);
            const int itA = itB + NGW;
            if (itA < I_ALL) { dA = decode(itA); tr_load(dA, vA); }
            if (itB < I_ALL) tr_finish(dB, vB, scr, lane);
            it = itA;
        }
    }
    {
        float* rot = (float*)(a.ws + WS_ROT);
        const float inv[8] = {1.0f, 0.193922758102417f, 0.03760603070259094f, 0.00729266507551074f, 0.001414213445968926f, 0.00027424818836152554f, 5.318296462064609e-05f, 1.0313385246263351e-05f};
        for (int e = gw * 64 + lane; e < MROWS * 8; e += NGW * 64) {
            const int row = e >> 3, i = e & 7;
            float iv = inv[0];
#pragma unroll
            for (int q = 1; q < 8; ++q) iv = (i == q) ? inv[q] : iv;
            const float ang = (float)a.pos[row] * iv;
            const double ad = (double)ang;
            const double kk = __builtin_rint(ad * 0.15915494309189535);
            const float rr = (float)(ad - kk * 6.283185307179586);
            rot[2 * e] = cosf(rr); rot[2 * e + 1] = sinf(rr);
        }
    }
    {
        f32x4 g0[8];
#pragma unroll
        for (int j = 0; j < 8; ++j) g0[j] = *((const f32x4*)a.n_mix_pre + lane + 64 * j);
        for (int m = gw; m < MROWS; m += NGW) rms_row_bf16(a.x + (size_t)m * DM, g0, (bf16_t*)(a.ws + WS_XN) + (size_t)m * DM, lane);
    }
}

template <bool HIN_BF, bool HOUT_BF>
__device__ __forceinline__ void row_phase(const bf16_t* Y, const void* hin, void* hout, const float* gpost, const float* gpre, bf16_t* XN, int gw, int NGW, int lane) {
    f32x4 gpo[8], gpr[8];
#pragma unroll
    for (int j = 0; j < 8; ++j) { gpo[j] = *((const f32x4*)gpost + lane + 64 * j); gpr[j] = gpre ? *((const f32x4*)gpre + lane + 64 * j) : (f32x4){0.f, 0.f, 0.f, 0.f}; }
    for (int m = gw; m < MROWS; m += NGW) {
        const u32x2* yr = (const u32x2*)(Y + (size_t)m * DM);
        u32x2 yw[8]; u32x2 hw[8]; f32x4 hf[8];
#pragma unroll
        for (int j = 0; j < 8; ++j) yw[j] = yr[lane + 64 * j];
#pragma unroll
        for (int j = 0; j < 8; ++j) {
            if (HIN_BF) hw[j] = *((const u32x2*)((const bf16_t*)hin + (size_t)m * DM) + lane + 64 * j);
            else hf[j] = *((const f32x4*)((const float*)hin + (size_t)m * DM) + lane + 64 * j);
        }
        f32x4 v[8]; float s = 0.f;
#pragma unroll
        for (int j = 0; j < 8; ++j) { v[j] = (f32x4){bflo(yw[j].x), bfhi(yw[j].x), bflo(yw[j].y), bfhi(yw[j].y)}; s += (v[j][0] * v[j][0] + v[j][1] * v[j][1]) + (v[j][2] * v[j][2] + v[j][3] * v[j][3]); }
        const float rstd = 1.0f / sqrtf(wave_sum(s) * (1.0f / DM) + NORM_EPS);
        float s2 = 0.f;
#pragma unroll
        for (int j = 0; j < 8; ++j) {
            f32x4 h;
            if (HIN_BF) h = (f32x4){bflo(hw[j].x), bfhi(hw[j].x), bflo(hw[j].y), bfhi(hw[j].y)}; else h = hf[j];
            v[j] = h + v[j] * rstd * gpo[j];
            if (HOUT_BF) { u32x2 w; w.x = pk2(v[j][0], v[j][1]); w.y = pk2(v[j][2], v[j][3]); *((u32x2*)((bf16_t*)hout + (size_t)m * DM) + lane + 64 * j) = w; }
            else *((f32x4*)((float*)hout + (size_t)m * DM) + lane + 64 * j) = v[j];
            s2 += (v[j][0] * v[j][0] + v[j][1] * v[j][1]) + (v[j][2] * v[j][2] + v[j][3] * v[j][3]);
        }
        if (gpre) {
            const float rstd2 = 1.0f / sqrtf(wave_sum(s2) * (1.0f / DM) + NORM_EPS);
#pragma unroll
            for (int j = 0; j < 8; ++j) {
                const f32x4 gv = gpr[j];
                u32x2 w; w.x = pk2(v[j][0] * rstd2 * gv[0], v[j][1] * rstd2 * gv[1]); w.y = pk2(v[j][2] * rstd2 * gv[2], v[j][3] * rstd2 * gv[3]);
                *((u32x2*)(XN + (size_t)m * DM) + lane + 64 * j) = w;
            }
        }
    }
}

constexpr int KSTR = 272;
constexpr int VSTR = 144;
constexpr int KBUF = 64 * KSTR;
constexpr int VBUF = 128 * VSTR;
constexpr int L_K0 = 0, L_V0 = 2 * KBUF, L_CUM = L_V0 + 2 * VBUF  , L_STAT = L_CUM + 8192  , L_WT = L_STAT + 1024  ;

struct KRegs { u32x4 a, b; };
struct VRegs { u32x4 a, b; };

__device__ __forceinline__ KRegs k_load(const bf16_t* base  , int tid) {
    const bf16_t* p = base + (size_t)(tid >> 3) * NP + (tid & 7) * 16;
    KRegs r; r.a = *(const u32x4*)p; r.b = *(const u32x4*)(p + 8); return r;
}
__device__ __forceinline__ void k_store(LAS unsigned char* buf, const KRegs& r, int tid) {
    LAS unsigned char* d = buf + (tid >> 3) * KSTR + (tid & 7) * 32;
    *(LAS u32x4*)d = r.a; *(LAS u32x4*)(d + 16) = r.b;
}
__device__ __forceinline__ void v_map(int tid, int& chunk, int& pair) { const int w = tid >> 6, l = tid & 63; chunk = 4 * (w & 3) + (l & 3); pair = 16 * (w >> 2) + (l >> 2); }
__device__ __forceinline__ VRegs v_load(const bf16_t* base, int tid) {
    int chunk, pair; v_map(tid, chunk, pair);
    const bf16_t* p = base + (size_t)(2 * pair) * NP + chunk * 8;
    VRegs r; r.a = *(const u32x4*)p; r.b = *(const u32x4*)(p + NP); return r;
}
__device__ __forceinline__ void v_store_words(LAS unsigned char* buf, const unsigned (&wa)[4], const unsigned (&wb)[4], int tid) {
    int chunk, pair; v_map(tid, chunk, pair);
    LAS unsigned char* d = buf + (8 * chunk) * VSTR + pair * 4;
#pragma unroll
    for (int i = 0; i < 4; ++i) {
        *(LAS unsigned*)(d + (2 * i) * VSTR) = (wa[i] & 0xffffu) | (wb[i] << 16);
        *(LAS unsigned*)(d + (2 * i + 1) * VSTR) = (wa[i] >> 16) | (wb[i] & 0xffff0000u);
    }
}
__device__ __forceinline__ void v_store(LAS unsigned char* buf, const VRegs& r, int tid) {
    const unsigned wa[4] = {r.a.x, r.a.y, r.a.z, r.a.w}, wb[4] = {r.b.x, r.b.y, r.b.z, r.b.w};
    v_store_words(buf, wa, wb, tid);
}

__device__ __forceinline__ void pv_mma(f32x4 (&o)[8], const LAS unsigned char* vbuf, const bf16x8 (&pf)[2], int lane) {
    const LAS unsigned char* vp = vbuf + (lane & 15) * VSTR + (lane >> 4) * 16;
#pragma unroll
    for (int mb = 0; mb < 8; ++mb)
#pragma unroll
        for (int pr = 0; pr < 2; ++pr) {
            const bf16x8 vf = *(const LAS bf16x8*)(vp + mb * 16 * VSTR + pr * 64);
            o[mb] = __builtin_amdgcn_mfma_f32_16x16x32_bf16(vf, pf[pr], o[mb], 0, 0, 0);
        }
}

__device__ __forceinline__ void softmax_tile(f32x4 (&s)[4], const f32x4 (&add)[4], float cs, float& lsum, bf16x8 (&pf)[2]) {
    float ps = 0.f;
#pragma unroll
    for (int rb = 0; rb < 4; ++rb)
#pragma unroll
        for (int j = 0; j < 4; ++j) { s[rb][j] = __builtin_amdgcn_exp2f(fminf(fmaf(s[rb][j], cs, add[rb][j]), 126.f)); ps += s[rb][j]; }
    lsum += ps;
#pragma unroll
    for (int pr = 0; pr < 2; ++pr) {
        u32x4 w; w.x = pg8::cvt_pk_bf16(s[2 * pr][0], s[2 * pr][1]); w.y = pg8::cvt_pk_bf16(s[2 * pr][2], s[2 * pr][3]); w.z = pg8::cvt_pk_bf16(s[2 * pr + 1][0], s[2 * pr + 1][1]); w.w = pg8::cvt_pk_bf16(s[2 * pr + 1][2], s[2 * pr + 1][3]);
        pf[pr] = __builtin_bit_cast(bf16x8, w);
    }
}

template <bool DIFF>
__device__ __forceinline__ void attn_unit(const Args& a, int layer, int bh, int qb, LAS unsigned char* lds, int tid) {
    const int wave = tid >> 6, lane = tid & 63, l15 = lane & 15, quad = lane >> 4;
    const int b = bh >> 2, h = bh & 3;
    const bf16_t* proj = (const bf16_t*)(a.ws + WS_PROJ) + (size_t)b * SEQ * NP;
    const bf16_t* Qg = proj + (DIFF ? P_BQ : P_CQ) + h * 128;
    const bf16_t* Kg = proj + (DIFF ? P_BK : P_CK) + h * 128;
    const bf16_t* Vg = proj + (DIFF ? P_BV : P_CV) + h * 128;
    const int q0 = qb * 128, ntiles = 2 * qb + 2;
    __syncthreads();
    { KRegs r0 = k_load(Qg + (size_t)q0 * NP, tid), r1 = k_load(Qg + (size_t)(q0 + 64) * NP, tid);
      k_store(lds + L_K0, r0, tid); k_store(lds + L_K0 + KBUF, r1, tid); }
    if (!DIFF) {
        const float* fl = (const float*)(a.ws + WS_FLOG) + (size_t)b * SEQ * 4 + h;
        const int nk = q0 + 128;
        float v[4];
#pragma unroll
        for (int i = 0; i < 4; ++i) {
            const int k = 4 * tid + i;
            float z = (k < nk) ? fl[(size_t)k * 4] : 0.f;
            float ls = fminf(z, 0.f) - log1pf(expf(-fabsf(z)));
            v[i] = (k < nk) ? ls : 0.f;
        }
        const float s0 = v[0], s1 = s0 + v[1], s2 = s1 + v[2], s3 = s2 + v[3];
        float x = s3;
#pragma unroll
        for (int d = 1; d < 64; d <<= 1) { const float y = __shfl_up(x, d); if (lane >= d) x += y; }
        LAS float* wt = (LAS float*)(lds + L_WT);
        if (lane == 63) wt[wave] = x;
        __syncthreads();
        float off = 0.f;
#pragma unroll
        for (int w = 0; w < 8; ++w) off += (w < wave) ? wt[w] : 0.f;
        const float ex = off + x - s3;
        LAS f32x4* cum = (LAS f32x4*)(lds + L_CUM);
        cum[tid] = (f32x4){(ex + s0) * LOG2E, (ex + s1) * LOG2E, (ex + s2) * LOG2E, (ex + s3) * LOG2E};
    }
    __syncthreads();
    bf16x8 qf[4];
    {
        const LAS unsigned char* qp = lds + L_K0 + (wave * 16 + l15) * KSTR + quad * 16;
#pragma unroll
        for (int ks = 0; ks < 4; ++ks) qf[ks] = *(const LAS bf16x8*)(qp + ks * 64);
    }
    KRegs kr = k_load(Kg, tid); VRegs vr = v_load(Vg, tid);
    __syncthreads();

    constexpr int NMAP = DIFF ? 2 : 1;
    const float cs = (DIFF ? 0.125f : 0.08838834764831845f) * LOG2E;
    f32x4 o[NMAP][8]; float lsum[NMAP];
#pragma unroll
    for (int mp = 0; mp < NMAP; ++mp) { lsum[mp] = 0.f;
#pragma unroll
        for (int mb = 0; mb < 8; ++mb) o[mp][mb] = (f32x4){0.f, 0.f, 0.f, 0.f}; }
    const int qi = q0 + wave * 16 + l15;
    float cumq = 0.f; if (!DIFF) cumq = *(const LAS float*)(lds + L_CUM + qi * 4);

    for (int jt = 0; jt < ntiles; ++jt) {
        LAS unsigned char* kb = lds + L_K0 + (jt & 1) * KBUF;
        LAS unsigned char* vb = lds + L_V0 + (jt & 1) * VBUF;
        k_store(kb, kr, tid); v_store(vb, vr, tid);
        __syncthreads();
        if (jt + 1 < ntiles) { kr = k_load(Kg + (size_t)(jt + 1) * 64 * NP, tid); vr = v_load(Vg + (size_t)(jt + 1) * 64 * NP, tid); }
        f32x4 s[NMAP][4];
        {
            bf16x8 kf[4][4];
#pragma unroll
            for (int rb = 0; rb < 4; ++rb) {
                const int trow = 32 * (rb >> 1) + 8 * (l15 >> 2) + 4 * (rb & 1) + (l15 & 3);
                const LAS unsigned char* kp = kb + trow * KSTR + quad * 16;
#pragma unroll
                for (int ks = 0; ks < 4; ++ks) kf[rb][ks] = *(const LAS bf16x8*)(kp + ks * 64);
            }
            __builtin_amdgcn_sched_barrier(0);
#pragma unroll
            for (int rb = 0; rb < 4; ++rb) {
                if (DIFF) {
                    f32x4 c0 = (f32x4){0.f, 0.f, 0.f, 0.f}, c1 = c0;
                    c0 = __builtin_amdgcn_mfma_f32_16x16x32_bf16(kf[rb][0], qf[0], c0, 0, 0, 0);
                    c0 = __builtin_amdgcn_mfma_f32_16x16x32_bf16(kf[rb][1], qf[1], c0, 0, 0, 0);
                    c1 = __builtin_amdgcn_mfma_f32_16x16x32_bf16(kf[rb][2], qf[2], c1, 0, 0, 0);
                    c1 = __builtin_amdgcn_mfma_f32_16x16x32_bf16(kf[rb][3], qf[3], c1, 0, 0, 0);
                    s[0][rb] = c0; s[NMAP - 1][rb] = c1;
                } else {
                    f32x4 c0 = (f32x4){0.f, 0.f, 0.f, 0.f};
#pragma unroll
                    for (int ks = 0; ks < 4; ++ks) c0 = __builtin_amdgcn_mfma_f32_16x16x32_bf16(kf[rb][ks], qf[ks], c0, 0, 0, 0);
                    s[0][rb] = c0;
                }
            }
        }
        bf16x8 vf[8][2];
        {
            const LAS unsigned char* vp = vb + l15 * VSTR + quad * 16;
#pragma unroll
            for (int mb = 0; mb < 8; ++mb)
#pragma unroll
                for (int pr = 0; pr < 2; ++pr) vf[mb][pr] = *(const LAS bf16x8*)(vp + mb * 16 * VSTR + pr * 64);
        }
        __builtin_amdgcn_sched_barrier(0);
        f32x4 addv[4];
#pragma unroll
        for (int rb = 0; rb < 4; ++rb) {
            const int key0 = jt * 64 + 32 * (rb >> 1) + 8 * quad + 4 * (rb & 1);
            if (!DIFF) addv[rb] = cumq - *(const LAS f32x4*)(lds + L_CUM + key0 * 4);
            else addv[rb] = (f32x4){0.f, 0.f, 0.f, 0.f};
        }
        if (jt >= 2 * qb) {
#pragma unroll
            for (int rb = 0; rb < 4; ++rb) {
                const int key0 = jt * 64 + 32 * (rb >> 1) + 8 * quad + 4 * (rb & 1);
#pragma unroll
                for (int mp = 0; mp < NMAP; ++mp)
#pragma unroll
                    for (int j = 0; j < 4; ++j) s[mp][rb][j] = (key0 + j > qi) ? -INFINITY : s[mp][rb][j];
            }
        }
        bf16x8 pf[NMAP][2];
#pragma unroll
        for (int mp = 0; mp < NMAP; ++mp) softmax_tile(s[mp], addv, cs, lsum[mp], pf[mp]);
#pragma unroll
        for (int mb = 0; mb < 8; ++mb)
#pragma unroll
            for (int pr = 0; pr < 2; ++pr)
#pragma unroll
                for (int mp = 0; mp < NMAP; ++mp) o[mp][mb] = __builtin_amdgcn_mfma_f32_16x16x32_bf16(vf[mb][pr], pf[mp][pr], o[mp][mb], 0, 0, 0);
    }
    float inv[NMAP];
#pragma unroll
    for (int mp = 0; mp < NMAP; ++mp) { float l = lsum[mp]; l += __shfl_xor(l, 16); l += __shfl_xor(l, 32); inv[mp] = 1.0f / l; }
    const size_t orow = (size_t)b * SEQ + qi;
    if (DIFF) {
        const float li = 0.8f - 0.6f * expf(-0.3f * (float)layer);
        const float* lp = a.da_lambda + (size_t)layer * 256;
        float d1 = lp[lane] * lp[64 + lane], d2 = lp[128 + lane] * lp[192 + lane];
        d1 = wave_sum(d1); d2 = wave_sum(d2);
        const float lam = expf(d1) - expf(d2) + li;
        const float c1 = inv[0], c2 = lam * inv[NMAP - 1];
        float ss = 0.f;
#pragma unroll
        for (int mb = 0; mb < 8; ++mb) { o[0][mb] = o[0][mb] * c1 - o[NMAP - 1][mb] * c2; ss += (o[0][mb][0] * o[0][mb][0] + o[0][mb][1] * o[0][mb][1]) + (o[0][mb][2] * o[0][mb][2] + o[0][mb][3] * o[0][mb][3]); }
        ss += __shfl_xor(ss, 16); ss += __shfl_xor(ss, 32);
        const float rstd = (1.0f / sqrtf(ss * (1.0f / 128.0f) + NORM_EPS)) * (1.0f - li);
        const float* sg = a.da_subln_g + (size_t)layer * 128;
        bf16_t* op = (bf16_t*)(a.ws + WS_BR) + orow * DM + 1 * 512 + h * 128 + quad * 4;
        f32x4 sgv[8];
#pragma unroll
        for (int mb = 0; mb < 8; ++mb) sgv[mb] = *(const f32x4*)(sg + mb * 16 + quad * 4);
#pragma unroll
        for (int mb = 0; mb < 8; ++mb) {
            const f32x4 gv = sgv[mb];
            u32x2 w; w.x = pk2(o[0][mb][0] * rstd * gv[0], o[0][mb][1] * rstd * gv[1]); w.y = pk2(o[0][mb][2] * rstd * gv[2], o[0][mb][3] * rstd * gv[3]);
            *(u32x2*)(op + mb * 16) = w;
        }
    } else {
        bf16_t* op = (bf16_t*)(a.ws + WS_BR) + orow * DM + 2 * 512 + h * 128 + quad * 4;
#pragma unroll
        for (int mb = 0; mb < 8; ++mb) {
            const f32x4 v = o[0][mb] * inv[0];
            u32x2 w; w.x = pk2(v[0], v[1]); w.y = pk2(v[2], v[3]);
            *(u32x2*)(op + mb * 16) = w;
        }
    }
}

__device__ __forceinline__ void gmlp_unit(const Args& a, int layer, int unit, LAS unsigned char* lds, int tid) {
    const int wave = tid >> 6, lane = tid & 63, l15 = lane & 15, quad = lane >> 4;
    const int g = unit & 3, bn = unit >> 2;
    const size_t r0 = (size_t)bn * 128;
    const bf16_t* proj = (const bf16_t*)(a.ws + WS_PROJ) + r0 * NP;
    __syncthreads();
    LAS float* stat = (LAS float*)(lds + L_STAT);
    {
        const int t = wave * 16 + (lane >> 2), part = lane & 3;
        const bf16_t* vp = proj + (size_t)t * NP + P_AV + part * 128;
        u32x4 w[16];
#pragma unroll
        for (int j = 0; j < 16; ++j) w[j] = *(const u32x4*)(vp + j * 8);
        float s1 = 0.f, s2 = 0.f;
#pragma unroll
        for (int j = 0; j < 16; ++j) {
            const float f[8] = {bflo(w[j].x), bfhi(w[j].x), bflo(w[j].y), bfhi(w[j].y), bflo(w[j].z), bfhi(w[j].z), bflo(w[j].w), bfhi(w[j].w)};
#pragma unroll
            for (int e = 0; e < 8; ++e) { s1 += f[e]; s2 += f[e] * f[e]; }
        }
        s1 += __shfl_xor(s1, 1); s1 += __shfl_xor(s1, 2); s2 += __shfl_xor(s2, 1); s2 += __shfl_xor(s2, 2);
        const float mu = s1 * (1.0f / 512.0f), var = fmaxf(s2 * (1.0f / 512.0f) - mu * mu, 0.f);
        if (part == 0) { stat[2 * t] = mu; stat[2 * t + 1] = 1.0f / sqrtf(var + NORM_EPS); }
    }
    __syncthreads();
    {
        int chunk, pair; v_map(tid, chunk, pair);
        const float* lg = a.gm_ln_g + (size_t)layer * 512 + g * 128 + chunk * 8;
        const float* lb = a.gm_ln_b + (size_t)layer * 512 + g * 128 + chunk * 8;
        const f32x4 g0 = *(const f32x4*)lg, g1 = *(const f32x4*)(lg + 4), b0 = *(const f32x4*)lb, b1 = *(const f32x4*)(lb + 4);
        const float gg[8] = {g0[0], g0[1], g0[2], g0[3], g1[0], g1[1], g1[2], g1[3]};
        const float bb[8] = {b0[0], b0[1], b0[2], b0[3], b1[0], b1[1], b1[2], b1[3]};
#pragma unroll
        for (int half = 0; half < 2; ++half) {
            const VRegs r = v_load(proj + (size_t)(half * 64) * NP + P_AV + g * 128, tid);
            const int sA = half * 64 + 2 * pair, sB = sA + 1;
            const float muA = stat[2 * sA], rsA = stat[2 * sA + 1], muB = stat[2 * sB], rsB = stat[2 * sB + 1];
            const unsigned ra[4] = {r.a.x, r.a.y, r.a.z, r.a.w}, rb[4] = {r.b.x, r.b.y, r.b.z, r.b.w};
            unsigned wa[4], wb[4];
#pragma unroll
            for (int i = 0; i < 4; ++i) {
                wa[i] = pk2((bflo(ra[i]) - muA) * rsA * gg[2 * i] + bb[2 * i], (bfhi(ra[i]) - muA) * rsA * gg[2 * i + 1] + bb[2 * i + 1]);
                wb[i] = pk2((bflo(rb[i]) - muB) * rsB * gg[2 * i] + bb[2 * i], (bfhi(rb[i]) - muB) * rsB * gg[2 * i + 1] + bb[2 * i + 1]);
            }
            v_store_words(lds + L_V0 + half * VBUF, wa, wb, tid);
        }
    }
    __syncthreads();
    const int t = wave * 16 + l15;
    const float* W = a.gm_w_s + ((size_t)layer * 4 + g) * 128 * 128 + (size_t)t * 128;
    f32x4 o[8];
#pragma unroll
    for (int mb = 0; mb < 8; ++mb) o[mb] = (f32x4){0.f, 0.f, 0.f, 0.f};
#pragma unroll
    for (int st = 0; st < 2; ++st) {
        if (st * 64 <= wave * 16 + 15) {
            bf16x8 pf[2];
#pragma unroll
            for (int pr = 0; pr < 2; ++pr) {
                const int sbase = st * 64 + pr * 32 + quad * 8;
                const f32x4 w0 = *(const f32x4*)(W + sbase), w1 = *(const f32x4*)(W + sbase + 4);
                float f[8] = {w0[0], w0[1], w0[2], w0[3], w1[0], w1[1], w1[2], w1[3]};
#pragma unroll
                for (int j = 0; j < 8; ++j) f[j] = (sbase + j <= t) ? f[j] : 0.f;
                u32x4 w; w.x = pk2(f[0], f[1]); w.y = pk2(f[2], f[3]); w.z = pk2(f[4], f[5]); w.w = pk2(f[6], f[7]);
                pf[pr] = __builtin_bit_cast(bf16x8, w);
            }
            pv_mma(o, lds + L_V0 + st * VBUF, pf, lane);
        }
    }
    const float bs = a.gm_b_s[((size_t)layer * 4 + g) * 128 + t];
    const bf16_t* up = proj + (size_t)t * NP + P_AU + g * 128 + quad * 4;
    bf16_t* op = (bf16_t*)(a.ws + WS_BR) + (r0 + t) * DM + g * 128 + quad * 4;
    u32x2 uwv[8];
#pragma unroll
    for (int mb = 0; mb < 8; ++mb) uwv[mb] = *(const u32x2*)(up + mb * 16);
#pragma unroll
    for (int mb = 0; mb < 8; ++mb) {
        const u32x2 uw = uwv[mb];
        u32x2 w; w.x = pk2(bflo(uw.x) * (o[mb][0] + bs), bfhi(uw.x) * (o[mb][1] + bs)); w.y = pk2(bflo(uw.y) * (o[mb][2] + bs), bfhi(uw.y) * (o[mb][3] + bs));
        *(u32x2*)(op + mb * 16) = w;
    }
}

template <int G_>
__device__ __forceinline__ void pool_unit_t(const Args& a, int layer, int unit, int tid) {
    const int wave = tid >> 6, lane = tid & 63, l15 = lane & 15, quad = lane >> 4;
    constexpr int g = G_; const int tile = unit >> 2;
    const int t = wave * 16 + l15;
    const size_t row = (size_t)tile * 128 + t;
    const int tseq = (int)(row & (SEQ - 1));
    constexpr int win = 2 << g;
    const int cnt = (tseq + 1 < win) ? (tseq + 1) : win;
    const float rc = 1.0f / (float)cnt;
    const bf16_t* hp = (const bf16_t*)(a.ws + WS_PROJ) + row * NP + P_DH + g * 128 + quad * 8;
    const bf16_t* wp = (const bf16_t*)(a.ws + WS_W + (size_t)layer * WL_STRIDE + WO_POOL) + (size_t)g * 128 * 128 + (size_t)l15 * 128 + quad * 8;
    f32x4 o[8];
#pragma unroll
    for (int mb = 0; mb < 8; ++mb) o[mb] = (f32x4){0.f, 0.f, 0.f, 0.f};
#pragma unroll
    for (int ks = 0; ks < 4; ++ks) {
        float acc[8] = {0.f, 0.f, 0.f, 0.f, 0.f, 0.f, 0.f, 0.f};
        float self[8];
        u32x4 wv[win];
#pragma unroll
        for (int i = 0; i < win; ++i) wv[i] = (i < cnt) ? *(const u32x4*)(hp - (size_t)i * NP + ks * 32) : (u32x4){0u, 0u, 0u, 0u};
#pragma unroll
        for (int i = 0; i < win; ++i) {
            const u32x4 w = wv[i];
            const float f[8] = {bflo(w.x), bfhi(w.x), bflo(w.y), bfhi(w.y), bflo(w.z), bfhi(w.z), bflo(w.w), bfhi(w.w)};
#pragma unroll
            for (int j = 0; j < 8; ++j) { acc[j] += f[j]; if (i == 0) self[j] = f[j]; }
        }
        asm volatile("" ::: "memory");
        u32x4 pw; pw.x = pk2(acc[0] * rc - self[0], acc[1] * rc - self[1]); pw.y = pk2(acc[2] * rc - self[2], acc[3] * rc - self[3]);
        pw.z = pk2(acc[4] * rc - self[4], acc[5] * rc - self[5]); pw.w = pk2(acc[6] * rc - self[6], acc[7] * rc - self[7]);
        const bf16x8 pf = __builtin_bit_cast(bf16x8, pw);
#pragma unroll
        for (int mb = 0; mb < 8; ++mb) {
            const bf16x8 wf = *(const bf16x8*)(wp + (size_t)mb * 16 * 128 + ks * 32);
            o[mb] = __builtin_amdgcn_mfma_f32_16x16x32_bf16(wf, pf, o[mb], 0, 0, 0);
        }
    }
    const float* sc = a.pool_scale + (size_t)layer * 512 + g * 128 + quad * 4;
    bf16_t* op = (bf16_t*)(a.ws + WS_BR) + row * DM + 3 * 512 + g * 128 + quad * 4;
    f32x4 svv[8];
#pragma unroll
    for (int mb = 0; mb < 8; ++mb) svv[mb] = *(const f32x4*)(sc + mb * 16);
#pragma unroll
    for (int mb = 0; mb < 8; ++mb) {
        const f32x4 sv = svv[mb];
        u32x2 w; w.x = pk2(o[mb][0] * sv[0], o[mb][1] * sv[1]); w.y = pk2(o[mb][2] * sv[2], o[mb][3] * sv[3]);
        *(u32x2*)(op + mb * 16) = w;
    }
}

__device__ __forceinline__ void mixer_phase(const Args& a, int cidx, int layer, LAS unsigned char* lds, int tid_) {
    int tid = tid_; asm volatile("" : "+v"(tid));
    unsigned* ctr = (unsigned*)(a.ws + WS_CTL) + 64 * cidx;
    LAS unsigned* slot = (LAS unsigned*)(lds + LDS_MISC);
    {
        const unsigned char* wl = a.ws + WS_W + (size_t)layer * WL_STRIDE;
        pg8::Gemm g{(const bf16_t*)(a.ws + WS_XN), (const bf16_t*)(wl + WO_IN), MROWS, NIN, DM};
        pg8::InOrder S; S.init(MROWS, NIN, (int)gridDim.x, (int)blockIdx.x, gridDim.x == 256 ? 6 : (1 << 30), 1 << 30);
        pg8::EpiIn E{(bf16_t*)(a.ws + WS_PROJ), (float*)(a.ws + WS_FLOG), (const float*)(a.ws + WS_ROT), a.fa_b_f + layer * 4};
        pg8::gemm_phase<pg8::EpiIn, pg8::InOrder>(lds, g, S, E);
    }
    for (;;) {
        __syncthreads();
        if (tid == 0) slot[0] = atomicAdd(ctr, 1u);
        __syncthreads();
        const int idx = (int)slot[0];
        if (idx >= 1024) break;
        int tu = tid; asm volatile("" : "+v"(tu));
        if (idx < 512) {
            const int qb = 15 - (idx >> 5), r = idx & 31, bh = r & 15;
            if (r < 16) attn_unit<true>(a, layer, bh, qb, lds, tu); else attn_unit<false>(a, layer, bh, qb, lds, tu);
        } else if (idx < 768) gmlp_unit(a, layer, idx - 512, lds, tu);
        else { const int pu = idx - 768; switch (pu & 3) { case 0: pool_unit_t<0>(a, layer, pu, tu); break; case 1: pool_unit_t<1>(a, layer, pu, tu); break; case 2: pool_unit_t<2>(a, layer, pu, tu); break; default: pool_unit_t<3>(a, layer, pu, tu); break; } }
    }
}

#define XB_TMO      128
#define XB_XCNT(j)  (256  + 64 * (j))
#define XB_XSUB(j)  (1280 + 64 * (j))
#define XB_XGEN(j)  (2304 + 64 * (j))
#define XB_TOP      3328
#define XB_TOPGEN   3392
#define XCD_BAR_WORDS 3456
#define XB_SPIN_CAP (1u << 22)
__device__ __forceinline__ unsigned xb_ld(unsigned* p)              { return __hip_atomic_load(p, __ATOMIC_RELAXED, __HIP_MEMORY_SCOPE_AGENT); }
__device__ __forceinline__ unsigned xb_add(unsigned* p, unsigned v) { return __hip_atomic_fetch_add(p, v, __ATOMIC_RELAXED, __HIP_MEMORY_SCOPE_AGENT); }
__device__ __forceinline__ unsigned xb_xcc_id() { return (unsigned)__builtin_amdgcn_s_getreg((3 << 11) | 20) & 0xFu; }
#define XB_SPIN(cond, bar) do { unsigned _sp = 0; while (cond) { __builtin_amdgcn_s_sleep(1); \
    if ((++_sp & 255u) == 0u) { if (xb_ld(&(bar)[XB_TMO])) break; if (_sp > XB_SPIN_CAP) { atomicAdd(&(bar)[XB_TMO], 1u); break; } } } } while (0)
struct XcdBarrier { unsigned* bar; unsigned x; volatile LAS unsigned* st; };
__device__ __forceinline__ XcdBarrier xcd_barrier_post(unsigned* bar, volatile LAS unsigned* st) {
    XcdBarrier b; b.bar = bar; b.x = xb_xcc_id(); b.st = st;
    if (threadIdx.x == 0) (void)xb_add(&bar[XB_XCNT(b.x)], 1u);
    return b;
}
__device__ __forceinline__ void xcd_barrier_complete(unsigned* bar, unsigned x, unsigned& nloc, unsigned& nx) {
    const unsigned G = gridDim.x * gridDim.y * gridDim.z;
    unsigned sum, cnt, mine, sp = 0u;
    for (;;) {
        sum = 0u; cnt = 0u; mine = 0u;
#pragma unroll
        for (unsigned j = 0; j < 16; ++j) { const unsigned c = xb_ld(&bar[XB_XCNT(j)]); sum += c; cnt += (c > 0u) ? 1u : 0u; mine = (j == x) ? c : mine; }
        if (sum == G) break;
        __builtin_amdgcn_s_sleep(1);
        if ((++sp & 255u) == 0u) { if (xb_ld(&bar[XB_TMO])) break; if (sp > XB_SPIN_CAP) { atomicAdd(&bar[XB_TMO], 1u); break; } }
    }
    nloc = mine > 0u ? mine : 1u; nx = cnt > 0u ? cnt : 1u;
}
__device__ __forceinline__ void xcd_barrier(const XcdBarrier& b) {
    asm volatile("s_waitcnt vmcnt(0)" ::: "memory");
    __syncthreads();
    if (threadIdx.x == 0) {
        unsigned* bar = b.bar;
        __builtin_amdgcn_s_waitcnt(0);
        unsigned nloc = b.st[0], nx = b.st[1];
        if (nloc == 0u) { xcd_barrier_complete(bar, b.x, nloc, nx); b.st[0] = nloc; b.st[1] = nx; }
        const unsigned old = xb_add(&bar[XB_XSUB(b.x)], 1u);
        const unsigned gen = old / nloc;
        if (old + 1u == (gen + 1u) * nloc) {
            __builtin_amdgcn_fence(__ATOMIC_RELEASE, "agent");
            asm volatile("s_waitcnt vmcnt(0)" ::: "memory");
            const unsigned og = xb_add(&bar[XB_TOP], 1u);
            const unsigned tg = og / nx;
            if (og + 1u == (tg + 1u) * nx) xb_add(&bar[XB_TOPGEN], 1u);
            else XB_SPIN(xb_ld(&bar[XB_TOPGEN]) == tg, bar);
            __builtin_amdgcn_fence(__ATOMIC_ACQUIRE, "agent");
            xb_add(&bar[XB_XGEN(b.x)], 1u);
            asm volatile("s_waitcnt vmcnt(0)" ::: "memory");
        } else {
            XB_SPIN(xb_ld(&bar[XB_XGEN(b.x)]) == gen, bar);
            __builtin_amdgcn_fence(__ATOMIC_ACQUIRE, "agent");
            asm volatile("s_waitcnt vmcnt(0)" ::: "memory");
        }
    }
    __syncthreads();
}

typedef const __attribute__((address_space(4))) Args* CArgsPtr;
__device__ __forceinline__ Args load_args() {
#if defined(__HIP_DEVICE_COMPILE__)
    CArgsPtr p = (CArgsPtr)__builtin_amdgcn_kernarg_segment_ptr(); asm volatile("" : "+s"(p)); return *p;
#else
    return Args{};
#endif
}

__global__ void __launch_bounds__(512, 2) fwd_kernel(Args a_in) {
    extern __shared__ __attribute__((aligned(16))) unsigned char lds_raw[];
    LAS unsigned char* lds = (LAS unsigned char*)lds_raw;
    cg::grid_group grid = cg::this_grid();
    const int G = gridDim.x;
    unsigned* xbar_words; unsigned xbar_x;
    {
        const Args a = load_args();
        xbar_words = (unsigned*)(a.ws + WS_CTL) + CW_BAR;
        if (threadIdx.x < 2) ((LAS unsigned*)(lds + LDS_MISC + 32))[threadIdx.x] = 0u;
        __syncthreads();
        const XcdBarrier b0 = xcd_barrier_post(xbar_words, (volatile LAS unsigned*)(lds + LDS_MISC + 32));
        xbar_x = b0.x;
    }
#define TIDS() int tid = threadIdx.x; asm volatile("" : "+v"(tid)); const int lane = tid & 63, wave = __builtin_amdgcn_readfirstlane(tid >> 6), gw = blockIdx.x * 8 + wave, NGW = G * 8; (void)lane; (void)gw; (void)NGW
    for (int rep = 0; rep < REP_P0; ++rep) {
        const Args a = load_args(); TIDS();
        phase0(a, lds, gw, NGW, wave, lane);
    }
    grid.sync();
    for (int _r = 1; _r < REP_SYNC; ++_r) grid.sync();

    for (int l = 0; l < DEPTH; ++l) {
        {
            const Args a = load_args();
            const unsigned char* wl = a.ws + WS_W + (size_t)l * WL_STRIDE;
            pg8::Gemm g{(const bf16_t*)(a.ws + WS_XN), (const bf16_t*)(wl + WO_IN), MROWS, NIN, DM}; pg8::InOrder S; S.init(MROWS, NIN, G, (int)blockIdx.x, 0, G == 256 ? 6 : (1 << 30));
            pg8::EpiIn E{(bf16_t*)(a.ws + WS_PROJ), (float*)(a.ws + WS_FLOG), (const float*)(a.ws + WS_ROT), a.fa_b_f + l * 4};
            pg8::gemm_phase<pg8::EpiIn, pg8::InOrder>(lds, g, S, E);
        }
        GSYNC();
        for (int rep = 0; rep < REP_MIX; ++rep) {
            const Args a = load_args();
            mixer_phase(a, l + 2 * rep, l, lds, threadIdx.x);
        }
        GSYNC();
        for (int rep = 0; rep < REP_MERGE; ++rep) {
            const Args a = load_args();
            const unsigned char* wl = a.ws + WS_W + (size_t)l * WL_STRIDE;
            pg8::Gemm g{(const bf16_t*)(a.ws + WS_BR), (const bf16_t*)(wl + WO_BR), MROWS, DM, DM}; pg8::StaticOrder S; S.init(MROWS, DM, G, (int)blockIdx.x);
            pg8::EpiMergeFold E{(const bf16_t*)(a.ws + WS_PROJ) + P_GATE, (bf16_t*)(a.ws + WS_MB)};
            pg8::gemm_phase<pg8::EpiMergeFold, pg8::StaticOrder>(lds, g, S, E);
        }
        GSYNC();
        for (int rep = 0; rep < REP_OUT; ++rep) {
            const Args a = load_args();
            const unsigned char* wl = a.ws + WS_W + (size_t)l * WL_STRIDE;
            pg8::Gemm g{(const bf16_t*)(a.ws + WS_MB), (const bf16_t*)(wl + WO_OUT), MROWS, DM, DM}; pg8::StaticOrder S; S.init(MROWS, DM, G, (int)blockIdx.x);
            pg8::EpiBf<0> E{(bf16_t*)(a.ws + WS_Y), DM};
            pg8::gemm_phase<pg8::EpiBf<0>, pg8::StaticOrder>(lds, g, S, E);
        }
        GSYNC();
        {
            const Args a = load_args(); TIDS();
            if (l == 0) row_phase<false, true>((const bf16_t*)(a.ws + WS_Y), a.x, a.ws + WS_HB, a.n_mix_post + (size_t)l * DM, a.n_ffn_pre + (size_t)l * DM, (bf16_t*)(a.ws + WS_XN), gw, NGW, lane);
            else row_phase<true, true>((const bf16_t*)(a.ws + WS_Y), a.ws + WS_HB, a.ws + WS_HB, a.n_mix_post + (size_t)l * DM, a.n_ffn_pre + (size_t)l * DM, (bf16_t*)(a.ws + WS_XN), gw, NGW, lane);
        }
        GSYNC();
        {
            const Args a = load_args();
            const unsigned char* wl = a.ws + WS_W + (size_t)l * WL_STRIDE;
            pg8::Gemm g{(const bf16_t*)(a.ws + WS_XN), (const bf16_t*)(wl + WO_UP), MROWS, FFN, DM}; pg8::StaticOrder S; S.init(MROWS, FFN, G, (int)blockIdx.x, REP_UP);
            pg8::EpiBf<1> E{(bf16_t*)(a.ws + WS_PROJ), FFN};
            pg8::gemm_phase<pg8::EpiBf<1>, pg8::StaticOrder>(lds, g, S, E);
        }
        GSYNC();
        for (int rep = 0; rep < REP_DN; ++rep) {
            const Args a = load_args();
            const unsigned char* wl = a.ws + WS_W + (size_t)l * WL_STRIDE;
            pg8::Gemm g{(const bf16_t*)(a.ws + WS_PROJ), (const bf16_t*)(wl + WO_DN), MROWS, DM, FFN}; pg8::StaticOrder S; S.init(MROWS, DM, G, (int)blockIdx.x);
            pg8::EpiBf<0> E{(bf16_t*)(a.ws + WS_Y), DM};
            pg8::gemm_phase<pg8::EpiBf<0>, pg8::StaticOrder>(lds, g, S, E);
        }
        GSYNC();
        {
            const Args a = load_args(); TIDS();
            if (l + 1 < DEPTH) row_phase<true, true>((const bf16_t*)(a.ws + WS_Y), a.ws + WS_HB, a.ws + WS_HB, a.n_ffn_post + (size_t)l * DM, a.n_mix_pre + (size_t)(l + 1) * DM, (bf16_t*)(a.ws + WS_XN), gw, NGW, lane);
            else row_phase<true, false>((const bf16_t*)(a.ws + WS_Y), a.ws + WS_HB, a.out, a.n_ffn_post + (size_t)l * DM, nullptr, (bf16_t*)(a.ws + WS_XN), gw, NGW, lane);
        }
        if (l + 1 < DEPTH) GSYNC();
    }
#undef TIDS
}

extern "C" void kernel_launch(void* const* d_in, const int* in_sizes, int n_in, void* d_out, int out_size, void* d_ws, size_t ws_size, hipStream_t stream) {
    static int grid = 0;
    if (grid == 0) {
        if (n_in != 20 || out_size != MROWS * DM || ws_size < WS_END) { fprintf(stderr, "kernel_launch: unexpected shapes (n_in %d out %d ws %zu)\n", n_in, out_size, ws_size); grid = -1; return; }
        int dev = 0, cus = 0, per_cu = 0;
        (void)hipGetDevice(&dev);
        (void)hipDeviceGetAttribute(&cus, hipDeviceAttributeMultiprocessorCount, dev);
        if (hipFuncSetAttribute((const void*)fwd_kernel, hipFuncAttributeMaxDynamicSharedMemorySize, LDS_BYTES) != hipSuccess) { fprintf(stderr, "kernel_launch: hipFuncSetAttribute failed\n"); grid = -1; return; }
        (void)hipOccupancyMaxActiveBlocksPerMultiprocessor(&per_cu, (const void*)fwd_kernel, 512, LDS_BYTES);
        if (per_cu < 1) { fprintf(stderr, "kernel_launch: occupancy query says %d\n", per_cu); per_cu = 1; }
        (void)hipGetLastError();
        grid = cus;
        if (grid > 256) grid = 256;
    }
    if (grid < 0) return;
    (void)hipMemsetAsync((char*)d_ws + WS_CTL, 0, CTL_BYTES, stream);
    Args a{};
    a.x = (const float*)d_in[0]; a.pos = (const int*)d_in[1];
    a.n_mix_pre = (const float*)d_in[2]; a.n_mix_post = (const float*)d_in[3]; a.n_ffn_pre = (const float*)d_in[4]; a.n_ffn_post = (const float*)d_in[5];
    a.w_in = (const float*)d_in[6]; a.gm_ln_g = (const float*)d_in[7]; a.gm_ln_b = (const float*)d_in[8]; a.gm_w_s = (const float*)d_in[9]; a.gm_b_s = (const float*)d_in[10];
    a.da_lambda = (const float*)d_in[11]; a.da_subln_g = (const float*)d_in[12]; a.fa_b_f = (const float*)d_in[13]; a.pool_w = (const float*)d_in[14]; a.pool_scale = (const float*)d_in[15];
    a.w_branch = (const float*)d_in[16]; a.w_out = (const float*)d_in[17]; a.w_ffn_up = (const float*)d_in[18]; a.w_ffn_down = (const float*)d_in[19];
    a.out = (float*)d_out; a.ws = (unsigned char*)d_ws;
    void* args[] = {&a};
    hipError_t e = hipLaunchCooperativeKernel((const void*)fwd_kernel, dim3(grid), dim3(512), args, LDS_BYTES, stream);
    if (e != hipSuccess) fprintf(stderr, "cooperative launch failed: %s (grid %d)\n", hipGetErrorString(e), grid);
}
```

```cpp
#include <hip/hip_runtime.h>
#include <hip/hip_cooperative_groups.h>
#include <cstdio>
#include <cstdint>
namespace cg = cooperative_groups;
#ifndef REP_P0
#define REP_P0 1
#endif
#ifndef REP_IN
#define REP_IN 1
#endif
#ifndef REP_MIX
#define REP_MIX 1
#endif
#ifndef REP_MERGE
#define REP_MERGE 1
#endif
#ifndef REP_OUT
#define REP_OUT 1
#endif
#ifndef REP_UP
#define REP_UP 1
#endif
#ifndef REP_DN
#define REP_DN 1
#endif
#ifndef REP_ROW
#define REP_ROW 1
#endif
#ifndef REP_SYNC
#define REP_SYNC 1
#endif
#ifndef USE_CG_SYNC
#define USE_CG_SYNC 0
#endif
#define GSYNC() do { for (int _r = 0; _r < REP_SYNC; ++_r) { if (USE_CG_SYNC) grid.sync(); else { XcdBarrier _b; _b.bar = xbar_words; _b.x = xbar_x; _b.st = (volatile LAS unsigned*)(lds + LDS_MISC + 32); xcd_barrier(_b); } } } while (0)

#define LAS __attribute__((address_space(3)))
typedef unsigned short bf16_t;
typedef short bf16x8 __attribute__((ext_vector_type(8)));
typedef float f32x4 __attribute__((ext_vector_type(4)));
typedef unsigned u32x4 __attribute__((ext_vector_type(4)));
typedef unsigned u32x2 __attribute__((ext_vector_type(2)));

constexpr int DM = 2048, NBATCH = 4, SEQ = 2048, MROWS = NBATCH * SEQ, DEPTH = 2;
constexpr int INC = 12804;
constexpr int NP = 12800;
constexpr int NIN = 13056;
constexpr int FFN = 8192;
constexpr int P_AU = 0, P_AV = 512, P_BQ = 1024, P_BK = 1536, P_BV = 2048, P_CQ = 2560, P_CK = 3072, P_CV = 3584, P_DH = 4096, P_GATE = 4608;
constexpr float NORM_EPS = 1e-6f;
constexpr float LOG2E = 1.4426950408889634f;

constexpr size_t MiB = 1u << 20;
constexpr size_t WS_CTL = 0, CTL_BYTES = 65536;
constexpr int CW_BAR = 4096;
constexpr size_t WS_W = 1 * MiB, WL_STRIDE = 132 * MiB;
constexpr size_t WO_IN = 0, WO_BR = 51 * MiB, WO_OUT = 59 * MiB, WO_UP = 67 * MiB, WO_DN = 99 * MiB, WO_POOL = 131 * MiB;
constexpr size_t WS_PROJ = 266 * MiB;
constexpr size_t WS_XN = 466 * MiB;
constexpr size_t WS_BR = 498 * MiB;
constexpr size_t WS_MB = 530 * MiB;
constexpr size_t WS_Y = 562 * MiB;
constexpr size_t WS_FLOG = 626 * MiB;
constexpr size_t WS_ROT = 627 * MiB;
constexpr size_t WS_HB = 628 * MiB;
constexpr size_t WS_END = 660 * MiB;

constexpr int LDS_BYTES = 139264;
constexpr int LDS_MISC = 135168;

__device__ __forceinline__ unsigned f2bf(float f) { unsigned u = __builtin_bit_cast(unsigned, f); return (u + 0x7fffu + ((u >> 16) & 1u)) >> 16; }
__device__ __forceinline__ unsigned pk2(float lo, float hi) { return f2bf(lo) | (f2bf(hi) << 16); }
__device__ __forceinline__ float bflo(unsigned w) { return __builtin_bit_cast(float, w << 16); }
__device__ __forceinline__ float bfhi(unsigned w) { return __builtin_bit_cast(float, w & 0xffff0000u); }
__device__ __forceinline__ float wave_sum(float v) {
#pragma unroll
    for (int o = 1; o < 64; o <<= 1) v += __shfl_xor(v, o);
    return v;
}
#define LDS_WAIT() asm volatile("s_waitcnt lgkmcnt(0)" ::: "memory")

namespace pg8 {
constexpr int BM = 256, BK = 64, HALF = 128, HTB = HALF * BK * 2, STAGE_BYTES = 8 * HTB, NXCD = 8, WGM = 8;
__host__ __device__ __forceinline__ int lds_byte(int r, int c) { const int st = (r >> 4) * 2 + (c >> 5), rr = r & 15, cc = c & 31, ob = rr * 64 + cc * 2; return st * 1024 + (ob ^ (((ob >> 9) & 1) << 5)); }
__host__ __device__ __forceinline__ void stage_rc(int b, int& R, int& C) { const int st = b / 1024, sb = b % 1024, swz = sb ^ (((sb >> 9) & 1) << 5); R = (st >> 1) * 16 + swz / 64; C = (st & 1) * 32 + (swz % 64) / 2; }
__host__ __device__ __forceinline__ int perm32(int rho) { const int n = rho >> 4, i = rho & 15; return 8 * (i >> 2) + 4 * n + (i & 3); }

struct Unit { int pm, pn; };
struct Gemm { const bf16_t* A; const bf16_t* Bt; int M, N, K; };

struct StaticOrder {
    int nM, nN, nwg, G, c, nrep;
    __device__ void init(int M, int N, int G_, int c_, int nrep_ = 1) { nM = M / BM; nN = N / BM; nwg = nM * nN; G = G_; c = c_; nrep = nrep_; asm volatile("" : "+s"(c), "+s"(G)); }
    __device__ bool next(int i, Unit& u) const {
        long L = (long)i * G + c; if (L >= (long)nwg * nrep) return false;
        if (nrep > 1) L %= nwg;
        int wgid = (int)L; { const int q = nwg / NXCD, r = nwg % NXCD, xcd = wgid % NXCD, off = wgid / NXCD; wgid = (xcd < r ? xcd * (q + 1) : r * (q + 1) + (xcd - r) * q) + off; }
        const int nig = WGM * nN, gid = wgid / nig, fm = gid * WGM, gsz = (nM - fm) < WGM ? (nM - fm) : WGM;
        u.pm = fm + ((wgid % nig) % gsz); u.pn = (wgid % nig) / gsz; return true;
    }
};

struct InOrder : StaticOrder {
    int i0, i1;
    __device__ void init(int M, int N, int G_, int c_, int i0_, int i1_) { StaticOrder::init(M, N, G_, c_, 1); i0 = i0_; i1 = i1_; }
    __device__ bool next(int i, Unit& u) const {
        if (i + i0 >= i1) return false;
        const bool ok = StaticOrder::next(i + i0, u);
        if (ok) u.pn = (u.pn == 0) ? 50 : u.pn - 1;
        return ok;
    }
};
__device__ __forceinline__ unsigned cvt_pk_bf16(float lo, float hi) { unsigned r; asm volatile("v_cvt_pk_bf16_f32 %0, %1, %2" : "=v"(r) : "v"(lo), "v"(hi)); return r; }


struct EpiIn {
    static constexpr bool PERM = true, FOLD = false;
    bf16_t* O; float* flog; const float* rot; const float* bfv;
    __device__ __forceinline__ void operator()(const f32x4 (&acc)[2][2][4][2], const Unit& u, int wr, int wc, int fr, int fq) const {
        const int row0 = u.pm * BM + wr * 64 + fr;
        if (u.pn == 50) {
            if (wc == 0 && fq == 0) {
                const f32x4 b = *(const f32x4*)bfv;
#pragma unroll
                for (int ai = 0; ai < 2; ++ai)
#pragma unroll
                    for (int m = 0; m < 4; ++m) *(f32x4*)(flog + (size_t)(row0 + ai * HALF + m * 16) * 4) = acc[ai][0][m][0] + b;
            }
            return;
        }
        const int col0 = u.pn * BM + wc * 32 + 8 * fq;
        const bool sig = u.pn >= 18;
        const bool rotary = (u.pn >= 4) && (u.pn < 8) && ((wc & 1) == 0);
        const float sg = (fq == 0) ? -1.f : 1.f;
#pragma unroll
        for (int ai = 0; ai < 2; ++ai)
#pragma unroll
            for (int m = 0; m < 4; ++m) {
                const int row = row0 + ai * HALF + m * 16;
                bf16_t* rowp = O + (size_t)row * NP + col0;
                f32x4 v[2][2];
#pragma unroll
                for (int bj = 0; bj < 2; ++bj) { v[bj][0] = acc[ai][bj][m][0]; v[bj][1] = acc[ai][bj][m][1]; }
                if (rotary) {
                    const f32x4* rp = (const f32x4*)(rot + (size_t)row * 16);
#pragma unroll
                    for (int n = 0; n < 2; ++n) {
                        const f32x4 ca = rp[2 * n], cb = rp[2 * n + 1];
                        const float cc[4] = {ca[0], ca[2], cb[0], cb[2]};
                        const float ss[4] = {ca[1] * sg, ca[3] * sg, cb[1] * sg, cb[3] * sg};
#pragma unroll
                        for (int bj = 0; bj < 2; ++bj)
#pragma unroll
                            for (int j = 0; j < 4; ++j) {
                                const float own = v[bj][n][j];
                                const float par = __shfl_xor(own, 16);
                                const float nv = own * cc[j] + par * ss[j];
                                v[bj][n][j] = (fq < 2) ? nv : own;
                            }
                    }
                    asm volatile("" ::: "memory");
                }
#pragma unroll
                for (int bj = 0; bj < 2; ++bj) {
                    f32x4 v0 = v[bj][0], v1 = v[bj][1];
                    if (sig) {
#pragma unroll
                        for (int j = 0; j < 4; ++j) {
                            v0[j] = __builtin_amdgcn_rcpf(1.0f + __builtin_amdgcn_exp2f(v0[j]));
                            v1[j] = __builtin_amdgcn_rcpf(1.0f + __builtin_amdgcn_exp2f(v1[j]));
                        }
                    }
                    u32x4 w; w.x = cvt_pk_bf16(v0[0], v0[1]); w.y = cvt_pk_bf16(v0[2], v0[3]); w.z = cvt_pk_bf16(v1[0], v1[1]); w.w = cvt_pk_bf16(v1[2], v1[3]);
                    *(u32x4*)(rowp + bj * HALF) = w;
                }
            }
    }
};
template <int ACT> struct EpiBf {
    static constexpr bool PERM = true, FOLD = false;
    bf16_t* O; int ldc;
    __device__ __forceinline__ void operator()(const f32x4 (&acc)[2][2][4][2], const Unit& u, int wr, int wc, int fr, int fq) const {
        const int row0 = u.pm * BM + wr * 64 + fr, col0 = u.pn * BM + wc * 32 + 8 * fq;
#pragma unroll
        for (int ai = 0; ai < 2; ++ai)
#pragma unroll
            for (int m = 0; m < 4; ++m) {
                bf16_t* rowp = O + (size_t)(row0 + ai * HALF + m * 16) * ldc + col0;
#pragma unroll
                for (int bj = 0; bj < 2; ++bj) {
                    f32x4 v0 = acc[ai][bj][m][0], v1 = acc[ai][bj][m][1];
#pragma unroll
                    for (int j = 0; j < 4; ++j) { if (ACT == 1) { const float a = fmaxf(v0[j], 0.f), b = fmaxf(v1[j], 0.f); v0[j] = a * a; v1[j] = b * b; } }
                    u32x4 w; w.x = cvt_pk_bf16(v0[0], v0[1]); w.y = cvt_pk_bf16(v0[2], v0[3]); w.z = cvt_pk_bf16(v1[0], v1[1]); w.w = cvt_pk_bf16(v1[2], v1[3]);
                    *(u32x4*)(rowp + bj * HALF) = w;
                }
            }
    }
};
struct EpiF32 {
    static constexpr bool PERM = false, FOLD = false;
    float* C; int ldc;
    __device__ __forceinline__ void operator()(const f32x4 (&acc)[2][2][4][2], const Unit& u, int wr, int wc, int fr, int fq) const {
        const int row0 = u.pm * BM + wr * 64 + fr, col0 = u.pn * BM + wc * 32 + 4 * fq;
#pragma unroll
        for (int ai = 0; ai < 2; ++ai)
#pragma unroll
            for (int m = 0; m < 4; ++m) {
                float* rowp = C + (size_t)(row0 + ai * HALF + m * 16) * ldc + col0;
#pragma unroll
                for (int bj = 0; bj < 2; ++bj)
#pragma unroll
                    for (int n = 0; n < 2; ++n) *(f32x4*)(rowp + bj * HALF + n * 16) = acc[ai][bj][m][n];
            }
    }
};
struct EpiMergeFold {
    static constexpr bool PERM = true, FOLD = true;
    const bf16_t* gate;
    bf16_t* MBo;
    static __device__ __forceinline__ void unpack8(const u32x4 w, float (&f)[8]) {
        f[0] = bflo(w.x); f[1] = bfhi(w.x); f[2] = bflo(w.y); f[3] = bfhi(w.y); f[4] = bflo(w.z); f[5] = bfhi(w.z); f[6] = bflo(w.w); f[7] = bfhi(w.w);
#pragma unroll
        for (int j = 0; j < 8; ++j) f[j] = fmaxf(f[j], 1e-30f);
    }
    static __device__ __forceinline__ float ratio(float n, float d) { return fmaxf(n, 1e-30f) * __builtin_amdgcn_rcpf(fmaxf(d, 1e-30f)); }
    __device__ __forceinline__ void fold(f32x4 (&acc)[2][2][4][2], const Unit& u, int nb, int wr, int wc, int fr, int fq) const {
        const bf16_t* gbase = gate + (size_t)(u.pm * BM + wr * 64 + fr) * NP + (size_t)nb * DM + (u.pn * BM + wc * 32 + 8 * fq);
#pragma unroll
        for (int ai = 0; ai < 2; ++ai) {
            u32x4 wn[4][2], wd[4][2];
#pragma unroll
            for (int m = 0; m < 4; ++m)
#pragma unroll
                for (int bj = 0; bj < 2; ++bj) {
                    const bf16_t* gp = gbase + (size_t)(ai * HALF + m * 16) * NP + bj * HALF;
                    wn[m][bj] = *(const u32x4*)(gp - DM);
                    wd[m][bj] = *(const u32x4*)gp;
                }
#pragma unroll
            for (int m = 0; m < 4; ++m)
#pragma unroll
                for (int bj = 0; bj < 2; ++bj) {
                    const u32x4 a = wn[m][bj], d = wd[m][bj];
                    f32x4 r0, r1;
                    r0[0] = ratio(bflo(a.x), bflo(d.x)); r0[1] = ratio(bfhi(a.x), bfhi(d.x)); r0[2] = ratio(bflo(a.y), bflo(d.y)); r0[3] = ratio(bfhi(a.y), bfhi(d.y));
                    r1[0] = ratio(bflo(a.z), bflo(d.z)); r1[1] = ratio(bfhi(a.z), bfhi(d.z)); r1[2] = ratio(bflo(a.w), bflo(d.w)); r1[3] = ratio(bfhi(a.w), bfhi(d.w));
                    acc[ai][bj][m][0] *= r0; acc[ai][bj][m][1] *= r1;
                }
            asm volatile("" ::: "memory");
        }
    }
    __device__ __forceinline__ void operator()(const f32x4 (&acc)[2][2][4][2], const Unit& u, int wr, int wc, int fr, int fq) const {
        const int row0 = u.pm * BM + wr * 64 + fr, col0 = u.pn * BM + wc * 32 + 8 * fq;
        u32x4 gw[2][4][2];
#pragma unroll
        for (int ai = 0; ai < 2; ++ai)
#pragma unroll
            for (int m = 0; m < 4; ++m)
#pragma unroll
                for (int bj = 0; bj < 2; ++bj) gw[ai][m][bj] = *(const u32x4*)(gate + (size_t)(row0 + ai * HALF + m * 16) * NP + (size_t)3 * DM + col0 + bj * HALF);
#pragma unroll
        for (int ai = 0; ai < 2; ++ai)
#pragma unroll
            for (int m = 0; m < 4; ++m) {
                bf16_t* rowp = MBo + (size_t)(row0 + ai * HALF + m * 16) * DM + col0;
#pragma unroll
                for (int bj = 0; bj < 2; ++bj) {
                    float g[8]; unpack8(gw[ai][m][bj], g);
                    const f32x4 v0 = acc[ai][bj][m][0], v1 = acc[ai][bj][m][1];
                    u32x4 w; w.x = cvt_pk_bf16(v0[0] * g[0], v0[1] * g[1]); w.y = cvt_pk_bf16(v0[2] * g[2], v0[3] * g[3]); w.z = cvt_pk_bf16(v1[0] * g[4], v1[1] * g[5]); w.w = cvt_pk_bf16(v1[2] * g[6], v1[3] * g[7]);
                    *(u32x4*)(rowp + bj * HALF) = w;
                }
            }
    }
};

template <class Epi, class Sched, bool ALIGN_EPI = true, bool SP2 = true>
__device__ __forceinline__ void gemm_phase(LAS unsigned char* lds, const Gemm g, const Sched& S, const Epi& E) {
    int tid = threadIdx.x; asm volatile("" : "+v"(tid));
    const int wid = __builtin_amdgcn_readfirstlane(tid >> 6), lane = tid & 63, wr = wid >> 2, wc = wid & 3, fr = lane & 15, fq = lane >> 4;
    const int K = g.K, nt = K / BK;
    unsigned voffA[2], voffB[2];
#pragma unroll
    for (int i = 0; i < 2; ++i) { int R, C; stage_rc(tid * 16 + i * 8192, R, C); const int Rb = Epi::PERM ? ((R & ~31) + perm32(R & 31)) : R;
        voffA[i] = (unsigned)(R * K + C) * 2u; voffB[i] = (unsigned)(Rb * K + C) * 2u; }
    const size_t kstep = (size_t)(BK * 2);
    const size_t hstep = (size_t)HALF * K * 2;
    const size_t tstep = 2 * hstep;
    const unsigned ldsw = (unsigned)wid * 1024u;
    const int aoff = lds_byte(wr * 64 + fr, fq * 8), boff = lds_byte(wc * 32 + fr, fq * 8);
#define PG8_SA(b, h) (((b) * 2 + (h)) * HTB)
#define PG8_SB(b, h) ((4 + (b) * 2 + (h)) * HTB)
#define PG8_STAGE(bufoff, gbase, voff) do { _Pragma("unroll") for (int _i = 0; _i < 2; ++_i) \
        __builtin_amdgcn_global_load_lds((const unsigned*)((const char*)(gbase) + (voff)[_i]), (LAS unsigned*)(lds + (bufoff) + ldsw + _i * 8192), 16, 0, 0); } while (0)
#define PG8_LDA(dst, b, h) do { _Pragma("unroll") for (int m = 0; m < 4; ++m) _Pragma("unroll") for (int k = 0; k < 2; ++k) dst[m][k] = *(const LAS bf16x8*)(lds + PG8_SA(b, h) + aoff + m * 2048 + k * 1024); } while (0)
#define PG8_LDB(dst, b, h) do { _Pragma("unroll") for (int n = 0; n < 2; ++n) _Pragma("unroll") for (int k = 0; k < 2; ++k) dst[n][k] = *(const LAS bf16x8*)(lds + PG8_SB(b, h) + boff + n * 2048 + k * 1024); } while (0)
#define PG8_MMA(ai, bj, At, Bt) do { __builtin_amdgcn_s_setprio(1); _Pragma("unroll") for (int m = 0; m < 4; ++m) _Pragma("unroll") for (int n = 0; n < 2; ++n) _Pragma("unroll") for (int k = 0; k < 2; ++k) \
        acc[ai][bj][m][n] = __builtin_amdgcn_mfma_f32_16x16x32_bf16(Bt[n][k], At[m][k], acc[ai][bj][m][n], 0, 0, 0); __builtin_amdgcn_s_setprio(0); } while (0)
#define PG8_WAIT_V(n) asm volatile("s_waitcnt vmcnt(" #n ")" ::: "memory")
#define PG8_WAIT_L(n) asm volatile("s_waitcnt lgkmcnt(" #n ")" ::: "memory")
#define PG8_BAR __builtin_amdgcn_s_barrier()
#define PG8_SCHED __builtin_amdgcn_sched_barrier(0)
    Unit cur, nxt; int ui = 0;
    if (!S.next(0, cur)) return;
    f32x4 acc[2][2][4][2];
#pragma unroll
    for (int a = 0; a < 2; ++a)
#pragma unroll
        for (int b = 0; b < 2; ++b)
#pragma unroll
            for (int m = 0; m < 4; ++m)
#pragma unroll
                for (int n = 0; n < 2; ++n) acc[a][b][m][n] = (f32x4){0.f, 0.f, 0.f, 0.f};
    bf16x8 At[4][2], B0[2][2], B1[2][2];
    const char* cA = (const char*)g.A + (size_t)cur.pm * tstep; const char* cB = (const char*)g.Bt + (size_t)cur.pn * tstep;
    if constexpr (SP2) {
        PG8_STAGE(PG8_SB(0, 0), cB, voffB); PG8_STAGE(PG8_SB(0, 1), cB + hstep, voffB); PG8_STAGE(PG8_SA(0, 0), cA, voffA); PG8_STAGE(PG8_SA(0, 1), cA + hstep, voffA);
        if (wr == 1) PG8_BAR;
        PG8_WAIT_V(2); PG8_BAR;
        PG8_STAGE(PG8_SB(1, 0), cB + kstep, voffB); PG8_STAGE(PG8_SA(1, 0), cA + kstep, voffA); PG8_STAGE(PG8_SB(1, 1), cB + hstep + kstep, voffB);
        PG8_WAIT_V(6); PG8_BAR;
    } else {
        PG8_STAGE(PG8_SB(0, 0), cB, voffB); PG8_STAGE(PG8_SA(0, 0), cA, voffA); PG8_STAGE(PG8_SB(0, 1), cB + hstep, voffB); PG8_STAGE(PG8_SA(0, 1), cA + hstep, voffA);
        if (wr == 1) PG8_BAR;
        PG8_WAIT_V(4); PG8_BAR;
        PG8_STAGE(PG8_SB(1, 0), cB + kstep, voffB); PG8_STAGE(PG8_SA(1, 0), cA + kstep, voffA); PG8_STAGE(PG8_SB(1, 1), cB + hstep + kstep, voffB);
        PG8_WAIT_V(6); PG8_BAR;
    }
    for (;;) {
        const bool has_next = S.next(ui + 1, nxt);
        const char* nA = has_next ? (const char*)g.A + (size_t)nxt.pm * tstep : cA; const char* nB = has_next ? (const char*)g.Bt + (size_t)nxt.pn * tstep : cB;
        for (int t = 0; t < nt; t += 2) {
            const bool last = (t == nt - 2);
            const char* a1 = cA + (size_t)(t + 1) * kstep;
            const char* a2 = last ? nA : cA + (size_t)(t + 2) * kstep; const char* b2 = last ? nB : cB + (size_t)(t + 2) * kstep;
            const char* a3 = a2 + kstep; const char* b3 = b2 + kstep;
            if constexpr (Epi::FOLD) { if (t > 0 && (t & 7) == 0) E.fold(acc, cur, t >> 3, wr, wc, fr, fq); }
            if constexpr (SP2) {
            PG8_LDB(B0, 0, 0); PG8_LDB(B1, 0, 1); PG8_SCHED; PG8_LDA(At, 0, 0); PG8_STAGE(PG8_SA(1, 1), a1 + hstep, voffA);
            PG8_WAIT_V(8); PG8_WAIT_L(0); PG8_BAR; PG8_MMA(0, 0, At, B0); PG8_MMA(0, 1, At, B1); PG8_BAR; PG8_SCHED;
            PG8_LDA(At, 0, 1); PG8_STAGE(PG8_SB(0, 0), b2, voffB); PG8_STAGE(PG8_SB(0, 1), b2 + hstep, voffB); PG8_STAGE(PG8_SA(0, 0), a2, voffA);
            PG8_WAIT_V(8); PG8_WAIT_L(0); PG8_BAR; PG8_MMA(1, 0, At, B0); PG8_MMA(1, 1, At, B1); PG8_BAR; PG8_SCHED;
            PG8_LDB(B0, 1, 0); PG8_LDB(B1, 1, 1); PG8_SCHED; PG8_LDA(At, 1, 0); PG8_STAGE(PG8_SA(0, 1), a2 + hstep, voffA);
            PG8_WAIT_V(8); PG8_WAIT_L(0); PG8_BAR; PG8_MMA(0, 0, At, B0); PG8_MMA(0, 1, At, B1); PG8_BAR; PG8_SCHED;
            PG8_LDA(At, 1, 1); PG8_STAGE(PG8_SB(1, 0), b3, voffB); PG8_STAGE(PG8_SB(1, 1), b3 + hstep, voffB); PG8_STAGE(PG8_SA(1, 0), a3, voffA);
            PG8_WAIT_V(8); PG8_WAIT_L(0); PG8_BAR; PG8_MMA(1, 0, At, B0); PG8_MMA(1, 1, At, B1); PG8_BAR; PG8_SCHED;
            } else {
            PG8_LDB(B0, 0, 0); PG8_SCHED; PG8_LDA(At, 0, 0); PG8_STAGE(PG8_SA(1, 1), a1 + hstep, voffA);
            PG8_WAIT_L(8); PG8_BAR; PG8_WAIT_L(0); PG8_MMA(0, 0, At, B0); PG8_BAR; PG8_SCHED;
            PG8_LDB(B1, 0, 1); PG8_STAGE(PG8_SB(0, 0), b2, voffB);
            PG8_BAR; PG8_WAIT_L(0); PG8_MMA(0, 1, At, B1); PG8_BAR;
            PG8_LDA(At, 0, 1); PG8_STAGE(PG8_SA(0, 0), a2, voffA);
            PG8_BAR; PG8_WAIT_L(0); PG8_MMA(1, 0, At, B0); PG8_BAR; PG8_SCHED;
            PG8_STAGE(PG8_SB(0, 1), b2 + hstep, voffB);
            PG8_WAIT_V(6); PG8_BAR; PG8_MMA(1, 1, At, B1); PG8_BAR;
            PG8_LDB(B0, 1, 0); PG8_SCHED; PG8_LDA(At, 1, 0); PG8_STAGE(PG8_SA(0, 1), a2 + hstep, voffA);
            PG8_WAIT_L(8); PG8_BAR; PG8_WAIT_L(0); PG8_MMA(0, 0, At, B0); PG8_BAR; PG8_SCHED;
            PG8_LDB(B1, 1, 1); PG8_STAGE(PG8_SB(1, 0), b3, voffB);
            PG8_BAR; PG8_WAIT_L(0); PG8_MMA(0, 1, At, B1); PG8_BAR;
            PG8_LDA(At, 1, 1); PG8_STAGE(PG8_SA(1, 0), a3, voffA);
            PG8_BAR; PG8_WAIT_L(0); PG8_MMA(1, 0, At, B0); PG8_BAR; PG8_SCHED;
            PG8_STAGE(PG8_SB(1, 1), b3 + hstep, voffB);
            PG8_WAIT_V(6); PG8_BAR; PG8_MMA(1, 1, At, B1); PG8_BAR;
            }
        }
        if constexpr (ALIGN_EPI) { if (wr == 0) PG8_BAR; }
        E(acc, cur, wr, wc, fr, fq);
        if (!has_next) break;
#pragma unroll
        for (int a = 0; a < 2; ++a)
#pragma unroll
            for (int b = 0; b < 2; ++b)
#pragma unroll
                for (int m = 0; m < 4; ++m)
#pragma unroll
                    for (int n = 0; n < 2; ++n) acc[a][b][m][n] = (f32x4){0.f, 0.f, 0.f, 0.f};
        cur = nxt; cA = nA; cB = nB; ++ui;
        if constexpr (ALIGN_EPI) { if (wr == 1) PG8_BAR; }
    }
    PG8_WAIT_V(0);
    if constexpr (!ALIGN_EPI) { if (wr == 0) PG8_BAR; }
    PG8_BAR;
#undef PG8_SA
#undef PG8_SB
#undef PG8_STAGE
#undef PG8_LDA
#undef PG8_LDB
#undef PG8_MMA
#undef PG8_WAIT_V
#undef PG8_WAIT_L
#undef PG8_BAR
#undef PG8_SCHED
}
}

struct Args {
    const float* x; const int* pos;
    const float *n_mix_pre, *n_mix_post, *n_ffn_pre, *n_ffn_post, *w_in, *gm_ln_g, *gm_ln_b, *gm_w_s, *gm_b_s, *da_lambda, *da_subln_g, *fa_b_f,
                *pool_w, *pool_scale, *w_branch, *w_out, *w_ffn_up, *w_ffn_down;
    float* out; unsigned char* ws;
};

struct TrDesc { const float* sp; size_t ld; bf16_t* dp; int K; float scale; bool ok; };
__device__ __forceinline__ void tr_load(const TrDesc& d, f32x4 (&v)[16]) {
#pragma unroll
    for (int i = 0; i < 16; ++i) v[i] = d.ok ? __builtin_nontemporal_load((const f32x4*)(d.sp + (size_t)(4 * i) * d.ld)) : (f32x4){0.f, 0.f, 0.f, 0.f};
}
__device__ __forceinline__ void tr_finish(const TrDesc& d, const f32x4 (&v)[16], LAS float* scr, int lane) {
    const int c4 = (lane & 15) * 4, kr = lane >> 4;
#pragma unroll
    for (int i = 0; i < 16; ++i) {
        LAS float* p = scr + (4 * i + kr) * 65 + c4;
        p[0] = v[i][0] * d.scale; p[1] = v[i][1] * d.scale; p[2] = v[i][2] * d.scale; p[3] = v[i][3] * d.scale;
    }
    LDS_WAIT();
    const int c = lane & 7;
#pragma unroll
    for (int j = 0; j < 8; ++j) {
        const int n = (lane >> 3) + 8 * j;
        const LAS float* s = scr + (8 * c) * 65 + n;
        u32x4 o; o.x = pg8::cvt_pk_bf16(s[0], s[65]); o.y = pg8::cvt_pk_bf16(s[2 * 65], s[3 * 65]); o.z = pg8::cvt_pk_bf16(s[4 * 65], s[5 * 65]); o.w = pg8::cvt_pk_bf16(s[6 * 65], s[7 * 65]);
        *(u32x4*)(d.dp + (size_t)n * d.K + 8 * c) = o;
    }
    LDS_WAIT();
}

__device__ __forceinline__ void rms_row_bf16(const float* xrow, const f32x4 (&gv)[8], bf16_t* orow, int lane) {
    f32x4 v[8]; float s = 0.f;
#pragma unroll
    for (int j = 0; j < 8; ++j) { v[j] = *((const f32x4*)xrow + lane + 64 * j); s += (v[j][0] * v[j][0] + v[j][1] * v[j][1]) + (v[j][2] * v[j][2] + v[j][3] * v[j][3]); }
    const float rstd = 1.0f / sqrtf(wave_sum(s) * (1.0f / DM) + NORM_EPS);
#pragma unroll
    for (int j = 0; j < 8; ++j) {
        u32x2 w; w.x = pk2(v[j][0] * rstd * gv[j][0], v[j][1] * rstd * gv[j][1]); w.y = pk2(v[j][2] * rstd * gv[j][2], v[j][3] * rstd * gv[j][3]);
        *((u32x2*)orow + lane + 64 * j) = w;
    }
}

__device__ __forceinline__ void phase0(const Args& a, LAS unsigned char* lds, int gw, int NGW, int wave, int lane) {
    LAS float* scr = (LAS float*)(lds + wave * 16640);
    constexpr int I_IN = 32 * 204, I_BR = 4 * 8 * 32, I_OUT = 32 * 32, I_UP = 32 * 128, I_DN = 128 * 32, I_POOL = 16;
    constexpr int I_LAYER = I_IN + I_BR + I_OUT + I_UP + I_DN + I_POOL, I_ALL = DEPTH * I_LAYER;
    const int c4 = (lane & 15) * 4, kr = lane >> 4;
    auto decode = [&](int it) -> TrDesc {
        const int l = it / I_LAYER; int r = it - l * I_LAYER;
        unsigned char* wl = a.ws + WS_W + (size_t)l * WL_STRIDE;
        const float* src; size_t ld; int sc, nv = 64, k0, n0, K; bf16_t* dst; float scale = 1.0f;
        if (r < I_IN) {
            const int kb = r / 204, nb = r % 204; n0 = nb * 64; k0 = kb * 64;
            if (nb < 64) { sc = n0; } else if (nb < 200) { sc = n0 + 4; } else if (nb == 200) { sc = 4096; nv = 4; } else { sc = 0; nv = 0; }
            src = a.w_in + (size_t)l * DM * INC; ld = INC; dst = (bf16_t*)(wl + WO_IN); K = DM;
            scale = (nb >= 72 && nb < 200) ? -LOG2E : 1.0f;
        } else if ((r -= I_IN) < I_BR) {
            const int n = r / 256, rr = r % 256, kb = rr / 32, nb = rr % 32; n0 = nb * 64; k0 = kb * 64; sc = n0;
            src = a.w_branch + ((size_t)l * 4 + n) * 512 * DM; ld = DM; dst = (bf16_t*)(wl + WO_BR) + n * 512; K = DM;
        } else if ((r -= I_BR) < I_OUT) {
            const int kb = r / 32, nb = r % 32; n0 = nb * 64; k0 = kb * 64; sc = n0;
            src = a.w_out + (size_t)l * DM * DM; ld = DM; dst = (bf16_t*)(wl + WO_OUT); K = DM;
        } else if ((r -= I_OUT) < I_UP) {
            const int kb = r / 128, nb = r % 128; n0 = nb * 64; k0 = kb * 64; sc = n0;
            src = a.w_ffn_up + (size_t)l * DM * FFN; ld = FFN; dst = (bf16_t*)(wl + WO_UP); K = DM;
        } else if ((r -= I_UP) < I_DN) {
            const int kb = r / 32, nb = r % 32; n0 = nb * 64; k0 = kb * 64; sc = n0;
            src = a.w_ffn_down + (size_t)l * FFN * DM; ld = DM; dst = (bf16_t*)(wl + WO_DN); K = FFN;
        } else {
            r -= I_DN;
            const int g = r / 4, rr = r % 4, kb = rr / 2, nb = rr % 2; n0 = nb * 64; k0 = kb * 64; sc = n0;
            src = a.pool_w + ((size_t)l * 4 + g) * 128 * 128; ld = 128; dst = (bf16_t*)(wl + WO_POOL) + (size_t)g * 128 * 128; K = 128;
        }
        TrDesc d; d.sp = src + (size_t)(k0 + kr) * ld + sc + c4; d.ld = ld; d.dp = dst + (size_t)n0 * K + k0; d.K = K; d.scale = scale; d.ok = c4 < nv;
        return d;
    };
    {
        int it = gw; TrDesc dA, dB; f32x4 vA[16], vB[16];
        if (it < I_ALL) { dA = decode(it); tr_load(dA, vA); }
        while (it < I_ALL) {
            const int itB = it + NGW;
            if (itB < I_ALL) { dB = decode(itB); tr_load(dB, vB); }
            tr_finish(dA, vA, scr, lane);
            const int itA = itB + NGW;
            if (itA < I_ALL) { dA = decode(itA); tr_load(dA, vA); }
            if (itB < I_ALL) tr_finish(dB, vB, scr, lane);
            it = itA;
        }
    }
    {
        float* rot = (float*)(a.ws + WS_ROT);
        const float inv[8] = {1.0f, 0.193922758102417f, 0.03760603070259094f, 0.00729266507551074f, 0.001414213445968926f, 0.00027424818836152554f, 5.318296462064609e-05f, 1.0313385246263351e-05f};
        for (int e = gw * 64 + lane; e < MROWS * 8; e += NGW * 64) {
            const int row = e >> 3, i = e & 7;
            float iv = inv[0];
#pragma unroll
            for (int q = 1; q < 8; ++q) iv = (i == q) ? inv[q] : iv;
            const float ang = (float)a.pos[row] * iv;
            const double ad = (double)ang;
            const double kk = __builtin_rint(ad * 0.15915494309189535);
            const float rr = (float)(ad - kk * 6.283185307179586);
            rot[2 * e] = cosf(rr); rot[2 * e + 1] = sinf(rr);
        }
    }
    {
        f32x4 g0[8];
#pragma unroll
        for (int j = 0; j < 8; ++j) g0[j] = *((const f32x4*)a.n_mix_pre + lane + 64 * j);
        for (int m = gw; m < MROWS; m += NGW) rms_row_bf16(a.x + (size_t)m * DM, g0, (bf16_t*)(a.ws + WS_XN) + (size_t)m * DM, lane);
    }
}

template <bool HIN_BF, bool HOUT_BF>
__device__ __forceinline__ void row_phase(const bf16_t* Y, const void* hin, void* hout, const float* gpost, const float* gpre, bf16_t* XN, int gw, int NGW, int lane) {
    f32x4 gpo[8], gpr[8];
#pragma unroll
    for (int j = 0; j < 8; ++j) { gpo[j] = *((const f32x4*)gpost + lane + 64 * j); gpr[j] = gpre ? *((const f32x4*)gpre + lane + 64 * j) : (f32x4){0.f, 0.f, 0.f, 0.f}; }
    u32x2 yw[8]; u32x2 hw[8]; f32x4 hf[8];
    if (gw < MROWS) {
        const int m = gw;
#pragma unroll
        for (int j = 0; j < 8; ++j) yw[j] = *((const u32x2*)(Y + (size_t)m * DM) + lane + 64 * j);
#pragma unroll
        for (int j = 0; j < 8; ++j) {
            if (HIN_BF) hw[j] = *((const u32x2*)((const bf16_t*)hin + (size_t)m * DM) + lane + 64 * j);
            else hf[j] = *((const f32x4*)((const float*)hin + (size_t)m * DM) + lane + 64 * j);
        }
    }
    for (int m = gw; m < MROWS; m += NGW) {
        const int mn = m + NGW;
        u32x2 yw2[8]; u32x2 hw2[8]; f32x4 hf2[8];
        if (mn < MROWS) {
#pragma unroll
            for (int j = 0; j < 8; ++j) yw2[j] = *((const u32x2*)(Y + (size_t)mn * DM) + lane + 64 * j);
#pragma unroll
            for (int j = 0; j < 8; ++j) {
                if (HIN_BF) hw2[j] = *((const u32x2*)((const bf16_t*)hin + (size_t)mn * DM) + lane + 64 * j);
                else hf2[j] = *((const f32x4*)((const float*)hin + (size_t)mn * DM) + lane + 64 * j);
            }
        }
        f32x4 v[8]; float s = 0.f;
#pragma unroll
        for (int j = 0; j < 8; ++j) { v[j] = (f32x4){bflo(yw[j].x), bfhi(yw[j].x), bflo(yw[j].y), bfhi(yw[j].y)}; s += (v[j][0] * v[j][0] + v[j][1] * v[j][1]) + (v[j][2] * v[j][2] + v[j][3] * v[j][3]); }
        const float rstd = 1.0f / sqrtf(wave_sum(s) * (1.0f / DM) + NORM_EPS);
        float s2 = 0.f;
#pragma unroll
        for (int j = 0; j < 8; ++j) {
            f32x4 h;
            if (HIN_BF) h = (f32x4){bflo(hw[j].x), bfhi(hw[j].x), bflo(hw[j].y), bfhi(hw[j].y)}; else h = hf[j];
            v[j] = h + v[j] * rstd * gpo[j];
            if (HOUT_BF) { u32x2 w; w.x = pk2(v[j][0], v[j][1]); w.y = pk2(v[j][2], v[j][3]); *((u32x2*)((bf16_t*)hout + (size_t)m * DM) + lane + 64 * j) = w; }
            else *((f32x4*)((float*)hout + (size_t)m * DM) + lane + 64 * j) = v[j];
            s2 += (v[j][0] * v[j][0] + v[j][1] * v[j][1]) + (v[j][2] * v[j][2] + v[j][3] * v[j][3]);
        }
        if (gpre) {
            const float rstd2 = 1.0f / sqrtf(wave_sum(s2) * (1.0f / DM) + NORM_EPS);
#pragma unroll
            for (int j = 0; j < 8; ++j) {
                const f32x4 gv = gpr[j];
                u32x2 w; w.x = pk2(v[j][0] * rstd2 * gv[0], v[j][1] * rstd2 * gv[1]); w.y = pk2(v[j][2] * rstd2 * gv[2], v[j][3] * rstd2 * gv[3]);
                *((u32x2*)(XN + (size_t)m * DM) + lane + 64 * j) = w;
            }
        }
#pragma unroll
        for (int j = 0; j < 8; ++j) { yw[j] = yw2[j]; if (HIN_BF) hw[j] = hw2[j]; else hf[j] = hf2[j]; }
    }
}

constexpr int KSTR = 272;
constexpr int VSTR = 144;
constexpr int KBUF = 64 * KSTR;
constexpr int VBUF = 128 * VSTR;
constexpr int L_K0 = 0, L_V0 = 2 * KBUF, L_CUM = L_V0 + 2 * VBUF  , L_STAT = L_CUM + 8192  , L_WT = L_STAT + 1024  ;

struct KRegs { u32x4 a, b; };
struct VRegs { u32x4 a, b; };

__device__ __forceinline__ KRegs k_load(const bf16_t* base  , int tid) {
    const bf16_t* p = base + (size_t)(tid >> 3) * NP + (tid & 7) * 16;
    KRegs r; r.a = *(const u32x4*)p; r.b = *(const u32x4*)(p + 8); return r;
}
__device__ __forceinline__ void k_store(LAS unsigned char* buf, const KRegs& r, int tid) {
    LAS unsigned char* d = buf + (tid >> 3) * KSTR + (tid & 7) * 32;
    *(LAS u32x4*)d = r.a; *(LAS u32x4*)(d + 16) = r.b;
}
__device__ __forceinline__ void v_map(int tid, int& chunk, int& pair) { const int w = tid >> 6, l = tid & 63; chunk = 4 * (w & 3) + (l & 3); pair = 16 * (w >> 2) + (l >> 2); }
__device__ __forceinline__ VRegs v_load(const bf16_t* base, int tid) {
    int chunk, pair; v_map(tid, chunk, pair);
    const bf16_t* p = base + (size_t)(2 * pair) * NP + chunk * 8;
    VRegs r; r.a = *(const u32x4*)p; r.b = *(const u32x4*)(p + NP); return r;
}
__device__ __forceinline__ void v_store_words(LAS unsigned char* buf, const unsigned (&wa)[4], const unsigned (&wb)[4], int tid) {
    int chunk, pair; v_map(tid, chunk, pair);
    LAS unsigned char* d = buf + (8 * chunk) * VSTR + pair * 4;
#pragma unroll
    for (int i = 0; i < 4; ++i) {
        *(LAS unsigned*)(d + (2 * i) * VSTR) = (wa[i] & 0xffffu) | (wb[i] << 16);
        *(LAS unsigned*)(d + (2 * i + 1) * VSTR) = (wa[i] >> 16) | (wb[i] & 0xffff0000u);
    }
}
__device__ __forceinline__ void v_store(LAS unsigned char* buf, const VRegs& r, int tid) {
    const unsigned wa[4] = {r.a.x, r.a.y, r.a.z, r.a.w}, wb[4] = {r.b.x, r.b.y, r.b.z, r.b.w};
    v_store_words(buf, wa, wb, tid);
}

__device__ __forceinline__ void pv_mma(f32x4 (&o)[8], const LAS unsigned char* vbuf, const bf16x8 (&pf)[2], int lane) {
    const LAS unsigned char* vp = vbuf + (lane & 15) * VSTR + (lane >> 4) * 16;
#pragma unroll
    for (int mb = 0; mb < 8; ++mb)
#pragma unroll
        for (int pr = 0; pr < 2; ++pr) {
            const bf16x8 vf = *(const LAS bf16x8*)(vp + mb * 16 * VSTR + pr * 64);
            o[mb] = __builtin_amdgcn_mfma_f32_16x16x32_bf16(vf, pf[pr], o[mb], 0, 0, 0);
        }
}

__device__ __forceinline__ void softmax_tile(f32x4 (&s)[4], const f32x4 (&add)[4], float cs, float& lsum, bf16x8 (&pf)[2]) {
    float ps = 0.f;
#pragma unroll
    for (int rb = 0; rb < 4; ++rb)
#pragma unroll
        for (int j = 0; j < 4; ++j) { s[rb][j] = __builtin_amdgcn_exp2f(fminf(fmaf(s[rb][j], cs, add[rb][j]), 126.f)); ps += s[rb][j]; }
    lsum += ps;
#pragma unroll
    for (int pr = 0; pr < 2; ++pr) {
        u32x4 w; w.x = pg8::cvt_pk_bf16(s[2 * pr][0], s[2 * pr][1]); w.y = pg8::cvt_pk_bf16(s[2 * pr][2], s[2 * pr][3]); w.z = pg8::cvt_pk_bf16(s[2 * pr + 1][0], s[2 * pr + 1][1]); w.w = pg8::cvt_pk_bf16(s[2 * pr + 1][2], s[2 * pr + 1][3]);
        pf[pr] = __builtin_bit_cast(bf16x8, w);
    }
}

template <bool DIFF>
__device__ __forceinline__ void attn_unit(const Args& a, int layer, int bh, int qb, LAS unsigned char* lds, int tid) {
    const int wave = tid >> 6, lane = tid & 63, l15 = lane & 15, quad = lane >> 4;
    const int b = bh >> 2, h = bh & 3;
    const bf16_t* proj = (const bf16_t*)(a.ws + WS_PROJ) + (size_t)b * SEQ * NP;
    const bf16_t* Qg = proj + (DIFF ? P_BQ : P_CQ) + h * 128;
    const bf16_t* Kg = proj + (DIFF ? P_BK : P_CK) + h * 128;
    const bf16_t* Vg = proj + (DIFF ? P_BV : P_CV) + h * 128;
    const int q0 = qb * 128, ntiles = 2 * qb + 2;
    __syncthreads();
    { KRegs r0 = k_load(Qg + (size_t)q0 * NP, tid), r1 = k_load(Qg + (size_t)(q0 + 64) * NP, tid);
      k_store(lds + L_K0, r0, tid); k_store(lds + L_K0 + KBUF, r1, tid); }
    if (!DIFF) {
        const float* fl = (const float*)(a.ws + WS_FLOG) + (size_t)b * SEQ * 4 + h;
        const int nk = q0 + 128;
        float v[4];
#pragma unroll
        for (int i = 0; i < 4; ++i) {
            const int k = 4 * tid + i;
            float z = (k < nk) ? fl[(size_t)k * 4] : 0.f;
            float ls = fminf(z, 0.f) - log1pf(expf(-fabsf(z)));
            v[i] = (k < nk) ? ls : 0.f;
        }
        const float s0 = v[0], s1 = s0 + v[1], s2 = s1 + v[2], s3 = s2 + v[3];
        float x = s3;
#pragma unroll
        for (int d = 1; d < 64; d <<= 1) { const float y = __shfl_up(x, d); if (lane >= d) x += y; }
        LAS float* wt = (LAS float*)(lds + L_WT);
        if (lane == 63) wt[wave] = x;
        __syncthreads();
        float off = 0.f;
#pragma unroll
        for (int w = 0; w < 8; ++w) off += (w < wave) ? wt[w] : 0.f;
        const float ex = off + x - s3;
        LAS f32x4* cum = (LAS f32x4*)(lds + L_CUM);
        cum[tid] = (f32x4){(ex + s0) * LOG2E, (ex + s1) * LOG2E, (ex + s2) * LOG2E, (ex + s3) * LOG2E};
    }
    __syncthreads();
    bf16x8 qf[4];
    {
        const LAS unsigned char* qp = lds + L_K0 + (wave * 16 + l15) * KSTR + quad * 16;
#pragma unroll
        for (int ks = 0; ks < 4; ++ks) qf[ks] = *(const LAS bf16x8*)(qp + ks * 64);
    }
    KRegs kr = k_load(Kg, tid); VRegs vr = v_load(Vg, tid);
    __syncthreads();

    constexpr int NMAP = DIFF ? 2 : 1;
    const float cs = (DIFF ? 0.125f : 0.08838834764831845f) * LOG2E;
    f32x4 o[NMAP][8]; float lsum[NMAP];
#pragma unroll
    for (int mp = 0; mp < NMAP; ++mp) { lsum[mp] = 0.f;
#pragma unroll
        for (int mb = 0; mb < 8; ++mb) o[mp][mb] = (f32x4){0.f, 0.f, 0.f, 0.f}; }
    const int qi = q0 + wave * 16 + l15;
    float cumq = 0.f; if (!DIFF) cumq = *(const LAS float*)(lds + L_CUM + qi * 4);

    for (int jt = 0; jt < ntiles; ++jt) {
        LAS unsigned char* kb = lds + L_K0 + (jt & 1) * KBUF;
        LAS unsigned char* vb = lds + L_V0 + (jt & 1) * VBUF;
        k_store(kb, kr, tid); v_store(vb, vr, tid);
        __syncthreads();
        if (jt + 1 < ntiles) { kr = k_load(Kg + (size_t)(jt + 1) * 64 * NP, tid); vr = v_load(Vg + (size_t)(jt + 1) * 64 * NP, tid); }
        f32x4 s[NMAP][4];
        {
            bf16x8 kf[4][4];
#pragma unroll
            for (int rb = 0; rb < 4; ++rb) {
                const int trow = 32 * (rb >> 1) + 8 * (l15 >> 2) + 4 * (rb & 1) + (l15 & 3);
                const LAS unsigned char* kp = kb + trow * KSTR + quad * 16;
#pragma unroll
                for (int ks = 0; ks < 4; ++ks) kf[rb][ks] = *(const LAS bf16x8*)(kp + ks * 64);
            }
            __builtin_amdgcn_sched_barrier(0);
#pragma unroll
            for (int rb = 0; rb < 4; ++rb) {
                if (DIFF) {
                    f32x4 c0 = (f32x4){0.f, 0.f, 0.f, 0.f}, c1 = c0;
                    c0 = __builtin_amdgcn_mfma_f32_16x16x32_bf16(kf[rb][0], qf[0], c0, 0, 0, 0);
                    c0 = __builtin_amdgcn_mfma_f32_16x16x32_bf16(kf[rb][1], qf[1], c0, 0, 0, 0);
                    c1 = __builtin_amdgcn_mfma_f32_16x16x32_bf16(kf[rb][2], qf[2], c1, 0, 0, 0);
                    c1 = __builtin_amdgcn_mfma_f32_16x16x32_bf16(kf[rb][3], qf[3], c1, 0, 0, 0);
                    s[0][rb] = c0; s[NMAP - 1][rb] = c1;
                } else {
                    f32x4 c0 = (f32x4){0.f, 0.f, 0.f, 0.f};
#pragma unroll
                    for (int ks = 0; ks < 4; ++ks) c0 = __builtin_amdgcn_mfma_f32_16x16x32_bf16(kf[rb][ks], qf[ks], c0, 0, 0, 0);
                    s[0][rb] = c0;
                }
            }
        }
        bf16x8 vf[8][2];
        {
            const LAS unsigned char* vp = vb + l15 * VSTR + quad * 16;
#pragma unroll
            for (int mb = 0; mb < 8; ++mb)
#pragma unroll
                for (int pr = 0; pr < 2; ++pr) vf[mb][pr] = *(const LAS bf16x8*)(vp + mb * 16 * VSTR + pr * 64);
        }
        __builtin_amdgcn_sched_barrier(0);
        f32x4 addv[4];
#pragma unroll
        for (int rb = 0; rb < 4; ++rb) {
            const int key0 = jt * 64 + 32 * (rb >> 1) + 8 * quad + 4 * (rb & 1);
            if (!DIFF) addv[rb] = cumq - *(const LAS f32x4*)(lds + L_CUM + key0 * 4);
            else addv[rb] = (f32x4){0.f, 0.f, 0.f, 0.f};
        }
        if (jt >= 2 * qb) {
#pragma unroll
            for (int rb = 0; rb < 4; ++rb) {
                const int key0 = jt * 64 + 32 * (rb >> 1) + 8 * quad + 4 * (rb & 1);
#pragma unroll
                for (int mp = 0; mp < NMAP; ++mp)
#pragma unroll
                    for (int j = 0; j < 4; ++j) s[mp][rb][j] = (key0 + j > qi) ? -INFINITY : s[mp][rb][j];
            }
        }
        bf16x8 pf[NMAP][2];
#pragma unroll
        for (int mp = 0; mp < NMAP; ++mp) softmax_tile(s[mp], addv, cs, lsum[mp], pf[mp]);
#pragma unroll
        for (int mb = 0; mb < 8; ++mb)
#pragma unroll
            for (int pr = 0; pr < 2; ++pr)
#pragma unroll
                for (int mp = 0; mp < NMAP; ++mp) o[mp][mb] = __builtin_amdgcn_mfma_f32_16x16x32_bf16(vf[mb][pr], pf[mp][pr], o[mp][mb], 0, 0, 0);
    }
    float inv[NMAP];
#pragma unroll
    for (int mp = 0; mp < NMAP; ++mp) { float l = lsum[mp]; l += __shfl_xor(l, 16); l += __shfl_xor(l, 32); inv[mp] = 1.0f / l; }
    const size_t orow = (size_t)b * SEQ + qi;
    if (DIFF) {
        const float li = 0.8f - 0.6f * expf(-0.3f * (float)layer);
        const float* lp = a.da_lambda + (size_t)layer * 256;
        float d1 = lp[lane] * lp[64 + lane], d2 = lp[128 + lane] * lp[192 + lane];
        d1 = wave_sum(d1); d2 = wave_sum(d2);
        const float lam = expf(d1) - expf(d2) + li;
        const float c1 = inv[0], c2 = lam * inv[NMAP - 1];
        float ss = 0.f;
#pragma unroll
        for (int mb = 0; mb < 8; ++mb) { o[0][mb] = o[0][mb] * c1 - o[NMAP - 1][mb] * c2; ss += (o[0][mb][0] * o[0][mb][0] + o[0][mb][1] * o[0][mb][1]) + (o[0][mb][2] * o[0][mb][2] + o[0][mb][3] * o[0][mb][3]); }
        ss += __shfl_xor(ss, 16); ss += __shfl_xor(ss, 32);
        const float rstd = (1.0f / sqrtf(ss * (1.0f / 128.0f) + NORM_EPS)) * (1.0f - li);
        const float* sg = a.da_subln_g + (size_t)layer * 128;
        bf16_t* op = (bf16_t*)(a.ws + WS_BR) + orow * DM + 1 * 512 + h * 128 + quad * 4;
        f32x4 sgv[8];
#pragma unroll
        for (int mb = 0; mb < 8; ++mb) sgv[mb] = *(const f32x4*)(sg + mb * 16 + quad * 4);
#pragma unroll
        for (int mb = 0; mb < 8; ++mb) {
            const f32x4 gv = sgv[mb];
            u32x2 w; w.x = pk2(o[0][mb][0] * rstd * gv[0], o[0][mb][1] * rstd * gv[1]); w.y = pk2(o[0][mb][2] * rstd * gv[2], o[0][mb][3] * rstd * gv[3]);
            *(u32x2*)(op + mb * 16) = w;
        }
    } else {
        bf16_t* op = (bf16_t*)(a.ws + WS_BR) + orow * DM + 2 * 512 + h * 128 + quad * 4;
#pragma unroll
        for (int mb = 0; mb < 8; ++mb) {
            const f32x4 v = o[0][mb] * inv[0];
            u32x2 w; w.x = pk2(v[0], v[1]); w.y = pk2(v[2], v[3]);
            *(u32x2*)(op + mb * 16) = w;
        }
    }
}

__device__ __forceinline__ void gmlp_unit(const Args& a, int layer, int unit, LAS unsigned char* lds, int tid) {
    const int wave = tid >> 6, lane = tid & 63, l15 = lane & 15, quad = lane >> 4;
    const int g = unit & 3, bn = unit >> 2;
    const size_t r0 = (size_t)bn * 128;
    const bf16_t* proj = (const bf16_t*)(a.ws + WS_PROJ) + r0 * NP;
    __syncthreads();
    LAS float* stat = (LAS float*)(lds + L_STAT);
    {
        const int t = wave * 16 + (lane >> 2), part = lane & 3;
        const bf16_t* vp = proj + (size_t)t * NP + P_AV + part * 128;
        u32x4 w[16];
#pragma unroll
        for (int j = 0; j < 16; ++j) w[j] = *(const u32x4*)(vp + j * 8);
        float s1 = 0.f, s2 = 0.f;
#pragma unroll
        for (int j = 0; j < 16; ++j) {
            const float f[8] = {bflo(w[j].x), bfhi(w[j].x), bflo(w[j].y), bfhi(w[j].y), bflo(w[j].z), bfhi(w[j].z), bflo(w[j].w), bfhi(w[j].w)};
#pragma unroll
            for (int e = 0; e < 8; ++e) { s1 += f[e]; s2 += f[e] * f[e]; }
        }
        s1 += __shfl_xor(s1, 1); s1 += __shfl_xor(s1, 2); s2 += __shfl_xor(s2, 1); s2 += __shfl_xor(s2, 2);
        const float mu = s1 * (1.0f / 512.0f), var = fmaxf(s2 * (1.0f / 512.0f) - mu * mu, 0.f);
        if (part == 0) { stat[2 * t] = mu; stat[2 * t + 1] = 1.0f / sqrtf(var + NORM_EPS); }
    }
    __syncthreads();
    {
        int chunk, pair; v_map(tid, chunk, pair);
        const float* lg = a.gm_ln_g + (size_t)layer * 512 + g * 128 + chunk * 8;
        const float* lb = a.gm_ln_b + (size_t)layer * 512 + g * 128 + chunk * 8;
        const f32x4 g0 = *(const f32x4*)lg, g1 = *(const f32x4*)(lg + 4), b0 = *(const f32x4*)lb, b1 = *(const f32x4*)(lb + 4);
        const float gg[8] = {g0[0], g0[1], g0[2], g0[3], g1[0], g1[1], g1[2], g1[3]};
        const float bb[8] = {b0[0], b0[1], b0[2], b0[3], b1[0], b1[1], b1[2], b1[3]};
#pragma unroll
        for (int half = 0; half < 2; ++half) {
            const VRegs r = v_load(proj + (size_t)(half * 64) * NP + P_AV + g * 128, tid);
            const int sA = half * 64 + 2 * pair, sB = sA + 1;
            const float muA = stat[2 * sA], rsA = stat[2 * sA + 1], muB = stat[2 * sB], rsB = stat[2 * sB + 1];
            const unsigned ra[4] = {r.a.x, r.a.y, r.a.z, r.a.w}, rb[4] = {r.b.x, r.b.y, r.b.z, r.b.w};
            unsigned wa[4], wb[4];
#pragma unroll
            for (int i = 0; i < 4; ++i) {
                wa[i] = pk2((bflo(ra[i]) - muA) * rsA * gg[2 * i] + bb[2 * i], (bfhi(ra[i]) - muA) * rsA * gg[2 * i + 1] + bb[2 * i + 1]);
                wb[i] = pk2((bflo(rb[i]) - muB) * rsB * gg[2 * i] + bb[2 * i], (bfhi(rb[i]) - muB) * rsB * gg[2 * i + 1] + bb[2 * i + 1]);
            }
            v_store_words(lds + L_V0 + half * VBUF, wa, wb, tid);
        }
    }
    __syncthreads();
    const int t = wave * 16 + l15;
    const float* W = a.gm_w_s + ((size_t)layer * 4 + g) * 128 * 128 + (size_t)t * 128;
    f32x4 o[8];
#pragma unroll
    for (int mb = 0; mb < 8; ++mb) o[mb] = (f32x4){0.f, 0.f, 0.f, 0.f};
#pragma unroll
    for (int st = 0; st < 2; ++st) {
        if (st * 64 <= wave * 16 + 15) {
            bf16x8 pf[2];
#pragma unroll
            for (int pr = 0; pr < 2; ++pr) {
                const int sbase = st * 64 + pr * 32 + quad * 8;
                const f32x4 w0 = *(const f32x4*)(W + sbase), w1 = *(const f32x4*)(W + sbase + 4);
                float f[8] = {w0[0], w0[1], w0[2], w0[3], w1[0], w1[1], w1[2], w1[3]};
#pragma unroll
                for (int j = 0; j < 8; ++j) f[j] = (sbase + j <= t) ? f[j] : 0.f;
                u32x4 w; w.x = pk2(f[0], f[1]); w.y = pk2(f[2], f[3]); w.z = pk2(f[4], f[5]); w.w = pk2(f[6], f[7]);
                pf[pr] = __builtin_bit_cast(bf16x8, w);
            }
            pv_mma(o, lds + L_V0 + st * VBUF, pf, lane);
        }
    }
    const float bs = a.gm_b_s[((size_t)layer * 4 + g) * 128 + t];
    const bf16_t* up = proj + (size_t)t * NP + P_AU + g * 128 + quad * 4;
    bf16_t* op = (bf16_t*)(a.ws + WS_BR) + (r0 + t) * DM + g * 128 + quad * 4;
    u32x2 uwv[8];
#pragma unroll
    for (int mb = 0; mb < 8; ++mb) uwv[mb] = *(const u32x2*)(up + mb * 16);
#pragma unroll
    for (int mb = 0; mb < 8; ++mb) {
        const u32x2 uw = uwv[mb];
        u32x2 w; w.x = pk2(bflo(uw.x) * (o[mb][0] + bs), bfhi(uw.x) * (o[mb][1] + bs)); w.y = pk2(bflo(uw.y) * (o[mb][2] + bs), bfhi(uw.y) * (o[mb][3] + bs));
        *(u32x2*)(op + mb * 16) = w;
    }
}

template <int G_>
__device__ __forceinline__ void pool_unit_t(const Args& a, int layer, int unit, int tid) {
    const int wave = tid >> 6, lane = tid & 63, l15 = lane & 15, quad = lane >> 4;
    constexpr int g = G_; const int tile = unit >> 2;
    const int t = wave * 16 + l15;
    const size_t row = (size_t)tile * 128 + t;
    const int tseq = (int)(row & (SEQ - 1));
    constexpr int win = 2 << g;
    const int cnt = (tseq + 1 < win) ? (tseq + 1) : win;
    const float rc = 1.0f / (float)cnt;
    const bf16_t* hp = (const bf16_t*)(a.ws + WS_PROJ) + row * NP + P_DH + g * 128 + quad * 8;
    const bf16_t* wp = (const bf16_t*)(a.ws + WS_W + (size_t)layer * WL_STRIDE + WO_POOL) + (size_t)g * 128 * 128 + (size_t)l15 * 128 + quad * 8;
    f32x4 o[8];
#pragma unroll
    for (int mb = 0; mb < 8; ++mb) o[mb] = (f32x4){0.f, 0.f, 0.f, 0.f};
#pragma unroll
    for (int ks = 0; ks < 4; ++ks) {
        float acc[8] = {0.f, 0.f, 0.f, 0.f, 0.f, 0.f, 0.f, 0.f};
        float self[8];
        u32x4 wv[win];
#pragma unroll
        for (int i = 0; i < win; ++i) wv[i] = (i < cnt) ? *(const u32x4*)(hp - (size_t)i * NP + ks * 32) : (u32x4){0u, 0u, 0u, 0u};
#pragma unroll
        for (int i = 0; i < win; ++i) {
            const u32x4 w = wv[i];
            const float f[8] = {bflo(w.x), bfhi(w.x), bflo(w.y), bfhi(w.y), bflo(w.z), bfhi(w.z), bflo(w.w), bfhi(w.w)};
#pragma unroll
            for (int j = 0; j < 8; ++j) { acc[j] += f[j]; if (i == 0) self[j] = f[j]; }
        }
        asm volatile("" ::: "memory");
        u32x4 pw; pw.x = pk2(acc[0] * rc - self[0], acc[1] * rc - self[1]); pw.y = pk2(acc[2] * rc - self[2], acc[3] * rc - self[3]);
        pw.z = pk2(acc[4] * rc - self[4], acc[5] * rc - self[5]); pw.w = pk2(acc[6] * rc - self[6], acc[7] * rc - self[7]);
        const bf16x8 pf = __builtin_bit_cast(bf16x8, pw);
#pragma unroll
        for (int mb = 0; mb < 8; ++mb) {
            const bf16x8 wf = *(const bf16x8*)(wp + (size_t)mb * 16 * 128 + ks * 32);
            o[mb] = __builtin_amdgcn_mfma_f32_16x16x32_bf16(wf, pf, o[mb], 0, 0, 0);
        }
    }
    const float* sc = a.pool_scale + (size_t)layer * 512 + g * 128 + quad * 4;
    bf16_t* op = (bf16_t*)(a.ws + WS_BR) + row * DM + 3 * 512 + g * 128 + quad * 4;
    f32x4 svv[8];
#pragma unroll
    for (int mb = 0; mb < 8; ++mb) svv[mb] = *(const f32x4*)(sc + mb * 16);
#pragma unroll
    for (int mb = 0; mb < 8; ++mb) {
        const f32x4 sv = svv[mb];
        u32x2 w; w.x = pk2(o[mb][0] * sv[0], o[mb][1] * sv[1]); w.y = pk2(o[mb][2] * sv[2], o[mb][3] * sv[3]);
        *(u32x2*)(op + mb * 16) = w;
    }
}

__device__ __forceinline__ void mixer_phase(const Args& a, int cidx, int layer, LAS unsigned char* lds, int tid_) {
    int tid = tid_; asm volatile("" : "+v"(tid));
    unsigned* ctr = (unsigned*)(a.ws + WS_CTL) + 64 * cidx;
    LAS unsigned* slot = (LAS unsigned*)(lds + LDS_MISC);
    {
        const unsigned char* wl = a.ws + WS_W + (size_t)layer * WL_STRIDE;
        pg8::Gemm g{(const bf16_t*)(a.ws + WS_XN), (const bf16_t*)(wl + WO_IN), MROWS, NIN, DM};
        pg8::InOrder S; S.init(MROWS, NIN, (int)gridDim.x, (int)blockIdx.x, gridDim.x == 256 ? 6 : (1 << 30), 1 << 30);
        pg8::EpiIn E{(bf16_t*)(a.ws + WS_PROJ), (float*)(a.ws + WS_FLOG), (const float*)(a.ws + WS_ROT), a.fa_b_f + layer * 4};
        pg8::gemm_phase<pg8::EpiIn, pg8::InOrder>(lds, g, S, E);
    }
    for (;;) {
        __syncthreads();
        if (tid == 0) slot[0] = atomicAdd(ctr, 1u);
        __syncthreads();
        const int idx = (int)slot[0];
        if (idx >= 1024) break;
        int tu = tid; asm volatile("" : "+v"(tu));
        if (idx < 512) {
            const int qb = 15 - (idx >> 5), r = idx & 31, bh = r & 15;
            if (r < 16) attn_unit<true>(a, layer, bh, qb, lds, tu); else attn_unit<false>(a, layer, bh, qb, lds, tu);
        } else if (idx < 768) gmlp_unit(a, layer, idx - 512, lds, tu);
        else { const int pu = idx - 768; switch (pu & 3) { case 0: pool_unit_t<0>(a, layer, pu, tu); break; case 1: pool_unit_t<1>(a, layer, pu, tu); break; case 2: pool_unit_t<2>(a, layer, pu, tu); break; default: pool_unit_t<3>(a, layer, pu, tu); break; } }
    }
}

#define XB_TMO      128
#define XB_XCNT(j)  (256  + 64 * (j))
#define XB_XSUB(j)  (1280 + 64 * (j))
#define XB_XGEN(j)  (2304 + 64 * (j))
#define XB_TOP      3328
#define XB_TOPGEN   3392
#define XCD_BAR_WORDS 3456
#define XB_SPIN_CAP (1u << 22)
__device__ __forceinline__ unsigned xb_ld(unsigned* p)              { return __hip_atomic_load(p, __ATOMIC_RELAXED, __HIP_MEMORY_SCOPE_AGENT); }
__device__ __forceinline__ unsigned xb_add(unsigned* p, unsigned v) { return __hip_atomic_fetch_add(p, v, __ATOMIC_RELAXED, __HIP_MEMORY_SCOPE_AGENT); }
__device__ __forceinline__ unsigned xb_xcc_id() { return (unsigned)__builtin_amdgcn_s_getreg((3 << 11) | 20) & 0xFu; }
#define XB_SPIN(cond, bar) do { unsigned _sp = 0; while (cond) { __builtin_amdgcn_s_sleep(1); \
    if ((++_sp & 255u) == 0u) { if (xb_ld(&(bar)[XB_TMO])) break; if (_sp > XB_SPIN_CAP) { atomicAdd(&(bar)[XB_TMO], 1u); break; } } } } while (0)
struct XcdBarrier { unsigned* bar; unsigned x; volatile LAS unsigned* st; };
__device__ __forceinline__ XcdBarrier xcd_barrier_post(unsigned* bar, volatile LAS unsigned* st) {
    XcdBarrier b; b.bar = bar; b.x = xb_xcc_id(); b.st = st;
    if (threadIdx.x == 0) (void)xb_add(&bar[XB_XCNT(b.x)], 1u);
    return b;
}
__device__ __forceinline__ void xcd_barrier_complete(unsigned* bar, unsigned x, unsigned& nloc, unsigned& nx) {
    const unsigned G = gridDim.x * gridDim.y * gridDim.z;
    unsigned sum, cnt, mine, sp = 0u;
    for (;;) {
        sum = 0u; cnt = 0u; mine = 0u;
#pragma unroll
        for (unsigned j = 0; j < 16; ++j) { const unsigned c = xb_ld(&bar[XB_XCNT(j)]); sum += c; cnt += (c > 0u) ? 1u : 0u; mine = (j == x) ? c : mine; }
        if (sum == G) break;
        __builtin_amdgcn_s_sleep(1);
        if ((++sp & 255u) == 0u) { if (xb_ld(&bar[XB_TMO])) break; if (sp > XB_SPIN_CAP) { atomicAdd(&bar[XB_TMO], 1u); break; } }
    }
    nloc = mine > 0u ? mine : 1u; nx = cnt > 0u ? cnt : 1u;
}
__device__ __forceinline__ void xcd_barrier(const XcdBarrier& b) {
    asm volatile("s_waitcnt vmcnt(0)" ::: "memory");
    __syncthreads();
    if (threadIdx.x == 0) {
        unsigned* bar = b.bar;
        __builtin_amdgcn_s_waitcnt(0);
        unsigned nloc = b.st[0], nx = b.st[1];
        if (nloc == 0u) { xcd_barrier_complete(bar, b.x, nloc, nx); b.st[0] = nloc; b.st[1] = nx; }
        const unsigned old = xb_add(&bar[XB_XSUB(b.x)], 1u);
        const unsigned gen = old / nloc;
        if (old + 1u == (gen + 1u) * nloc) {
            __builtin_amdgcn_fence(__ATOMIC_RELEASE, "agent");
            asm volatile("s_waitcnt vmcnt(0)" ::: "memory");
            const unsigned og = xb_add(&bar[XB_TOP], 1u);
            const unsigned tg = og / nx;
            if (og + 1u == (tg + 1u) * nx) xb_add(&bar[XB_TOPGEN], 1u);
            else XB_SPIN(xb_ld(&bar[XB_TOPGEN]) == tg, bar);
            __builtin_amdgcn_fence(__ATOMIC_ACQUIRE, "agent");
            xb_add(&bar[XB_XGEN(b.x)], 1u);
            asm volatile("s_waitcnt vmcnt(0)" ::: "memory");
        } else {
            XB_SPIN(xb_ld(&bar[XB_XGEN(b.x)]) == gen, bar);
            __builtin_amdgcn_fence(__ATOMIC_ACQUIRE, "agent");
            asm volatile("s_waitcnt vmcnt(0)" ::: "memory");
        }
    }
    __syncthreads();
}

typedef const __attribute__((address_space(4))) Args* CArgsPtr;
__device__ __forceinline__ Args load_args() {
#if defined(__HIP_DEVICE_COMPILE__)
    CArgsPtr p = (CArgsPtr)__builtin_amdgcn_kernarg_segment_ptr(); asm volatile("" : "+s"(p)); return *p;
#else
    return Args{};
#endif
}

__global__ void __launch_bounds__(512, 2) fwd_kernel(Args a_in) {
    extern __shared__ __attribute__((aligned(16))) unsigned char lds_raw[];
    LAS unsigned char* lds = (LAS unsigned char*)lds_raw;
    cg::grid_group grid = cg::this_grid();
    const int G = gridDim.x;
    unsigned* xbar_words; unsigned xbar_x;
    {
        const Args a = load_args();
        xbar_words = (unsigned*)(a.ws + WS_CTL) + CW_BAR;
        if (threadIdx.x < 2) ((LAS unsigned*)(lds + LDS_MISC + 32))[threadIdx.x] = 0u;
        __syncthreads();
        const XcdBarrier b0 = xcd_barrier_post(xbar_words, (volatile LAS unsigned*)(lds + LDS_MISC + 32));
        xbar_x = b0.x;
    }
#define TIDS() int tid = threadIdx.x; asm volatile("" : "+v"(tid)); const int lane = tid & 63, wave = __builtin_amdgcn_readfirstlane(tid >> 6), gw = blockIdx.x * 8 + wave, NGW = G * 8; (void)lane; (void)gw; (void)NGW
    for (int rep = 0; rep < REP_P0; ++rep) {
        const Args a = load_args(); TIDS();
        phase0(a, lds, gw, NGW, wave, lane);
    }
    grid.sync();
    for (int _r = 1; _r < REP_SYNC; ++_r) grid.sync();

    for (int l = 0; l < DEPTH; ++l) {
        {
            const Args a = load_args();
            const unsigned char* wl = a.ws + WS_W + (size_t)l * WL_STRIDE;
            pg8::Gemm g{(const bf16_t*)(a.ws + WS_XN), (const bf16_t*)(wl + WO_IN), MROWS, NIN, DM}; pg8::InOrder S; S.init(MROWS, NIN, G, (int)blockIdx.x, 0, G == 256 ? 6 : (1 << 30));
            pg8::EpiIn E{(bf16_t*)(a.ws + WS_PROJ), (float*)(a.ws + WS_FLOG), (const float*)(a.ws + WS_ROT), a.fa_b_f + l * 4};
            pg8::gemm_phase<pg8::EpiIn, pg8::InOrder>(lds, g, S, E);
        }
        GSYNC();
        for (int rep = 0; rep < REP_MIX; ++rep) {
            const Args a = load_args();
            mixer_phase(a, l + 2 * rep, l, lds, threadIdx.x);
        }
        GSYNC();
        for (int rep = 0; rep < REP_MERGE; ++rep) {
            const Args a = load_args();
            const unsigned char* wl = a.ws + WS_W + (size_t)l * WL_STRIDE;
            pg8::Gemm g{(const bf16_t*)(a.ws + WS_BR), (const bf16_t*)(wl + WO_BR), MROWS, DM, DM}; pg8::StaticOrder S; S.init(MROWS, DM, G, (int)blockIdx.x);
            pg8::EpiMergeFold E{(const bf16_t*)(a.ws + WS_PROJ) + P_GATE, (bf16_t*)(a.ws + WS_MB)};
            pg8::gemm_phase<pg8::EpiMergeFold, pg8::StaticOrder>(lds, g, S, E);
        }
        GSYNC();
        for (int rep = 0; rep < REP_OUT; ++rep) {
            const Args a = load_args();
            const unsigned char* wl = a.ws + WS_W + (size_t)l * WL_STRIDE;
            pg8::Gemm g{(const bf16_t*)(a.ws + WS_MB), (const bf16_t*)(wl + WO_OUT), MROWS, DM, DM}; pg8::StaticOrder S; S.init(MROWS, DM, G, (int)blockIdx.x);
            pg8::EpiBf<0> E{(bf16_t*)(a.ws + WS_Y), DM};
            pg8::gemm_phase<pg8::EpiBf<0>, pg8::StaticOrder>(lds, g, S, E);
        }
        GSYNC();
        {
            const Args a = load_args(); TIDS();
            if (l == 0) row_phase<false, true>((const bf16_t*)(a.ws + WS_Y), a.x, a.ws + WS_HB, a.n_mix_post + (size_t)l * DM, a.n_ffn_pre + (size_t)l * DM, (bf16_t*)(a.ws + WS_XN), gw, NGW, lane);
            else row_phase<true, true>((const bf16_t*)(a.ws + WS_Y), a.ws + WS_HB, a.ws + WS_HB, a.n_mix_post + (size_t)l * DM, a.n_ffn_pre + (size_t)l * DM, (bf16_t*)(a.ws + WS_XN), gw, NGW, lane);
        }
        GSYNC();
        {
            const Args a = load_args();
            const unsigned char* wl = a.ws + WS_W + (size_t)l * WL_STRIDE;
            pg8::Gemm g{(const bf16_t*)(a.ws + WS_XN), (const bf16_t*)(wl + WO_UP), MROWS, FFN, DM}; pg8::StaticOrder S; S.init(MROWS, FFN, G, (int)blockIdx.x, REP_UP);
            pg8::EpiBf<1> E{(bf16_t*)(a.ws + WS_PROJ), FFN};
            pg8::gemm_phase<pg8::EpiBf<1>, pg8::StaticOrder>(lds, g, S, E);
        }
        GSYNC();
        for (int rep = 0; rep < REP_DN; ++rep) {
            const Args a = load_args();
            const unsigned char* wl = a.ws + WS_W + (size_t)l * WL_STRIDE;
            pg8::Gemm g{(const bf16_t*)(a.ws + WS_PROJ), (const bf16_t*)(wl + WO_DN), MROWS, DM, FFN}; pg8::StaticOrder S; S.init(MROWS, DM, G, (int)blockIdx.x);
            pg8::EpiBf<0> E{(bf16_t*)(a.ws + WS_Y), DM};
            pg8::gemm_phase<pg8::EpiBf<0>, pg8::StaticOrder>(lds, g, S, E);
        }
        GSYNC();
        {
            const Args a = load_args(); TIDS();
            if (l + 1 < DEPTH) row_phase<true, true>((const bf16_t*)(a.ws + WS_Y), a.ws + WS_HB, a.ws + WS_HB, a.n_ffn_post + (size_t)l * DM, a.n_mix_pre + (size_t)(l + 1) * DM, (bf16_t*)(a.ws + WS_XN), gw, NGW, lane);
            else row_phase<true, false>((const bf16_t*)(a.ws + WS_Y), a.ws + WS_HB, a.out, a.n_ffn_post + (size_t)l * DM, nullptr, (bf16_t*)(a.ws + WS_XN), gw, NGW, lane);
        }
        if (l + 1 < DEPTH) GSYNC();
    }
#undef TIDS
}

extern "C" void kernel_launch(void* const* d_in, const int* in_sizes, int n_in, void* d_out, int out_size, void* d_ws, size_t ws_size, hipStream_t stream) {
    static int grid = 0;
    if (grid == 0) {
        if (n_in != 20 || out_size != MROWS * DM || ws_size < WS_END) { fprintf(stderr, "kernel_launch: unexpected shapes (n_in %d out %d ws %zu)\n", n_in, out_size, ws_size); grid = -1; return; }
        int dev = 0, cus = 0, per_cu = 0;
        (void)hipGetDevice(&dev);
        (void)hipDeviceGetAttribute(&cus, hipDeviceAttributeMultiprocessorCount, dev);
        if (hipFuncSetAttribute((const void*)fwd_kernel, hipFuncAttributeMaxDynamicSharedMemorySize, LDS_BYTES) != hipSuccess) { fprintf(stderr, "kernel_launch: hipFuncSetAttribute failed\n"); grid = -1; return; }
        (void)hipOccupancyMaxActiveBlocksPerMultiprocessor(&per_cu, (const void*)fwd_kernel, 512, LDS_BYTES);
        if (per_cu < 1) { fprintf(stderr, "kernel_launch: occupancy query says %d\n", per_cu); per_cu = 1; }
        (void)hipGetLastError();
        grid = cus;
        if (grid > 256) grid = 256;
    }
    if (grid < 0) return;
    (void)hipMemsetAsync((char*)d_ws + WS_CTL, 0, CTL_BYTES, stream);
    Args a{};
    a.x = (const float*)d_in[0]; a.pos = (const int*)d_in[1];
    a.n_mix_pre = (const float*)d_in[2]; a.n_mix_post = (const float*)d_in[3]; a.n_ffn_pre = (const float*)d_in[4]; a.n_ffn_post = (const float*)d_in[5];
    a.w_in = (const float*)d_in[6]; a.gm_ln_g = (const float*)d_in[7]; a.gm_ln_b = (const float*)d_in[8]; a.gm_w_s = (const float*)d_in[9]; a.gm_b_s = (const float*)d_in[10];
    a.da_lambda = (const float*)d_in[11]; a.da_subln_g = (const float*)d_in[12]; a.fa_b_f = (const float*)d_in[13]; a.pool_w = (const float*)d_in[14]; a.pool_scale = (const float*)d_in[15];
    a.w_branch = (const float*)d_in[16]; a.w_out = (const float*)d_in[17]; a.w_ffn_up = (const float*)d_in[18]; a.w_ffn_down = (const float*)d_in[19];
    a.out = (float*)d_out; a.ws = (unsigned char*)d_ws;
    void* args[] = {&a};
    hipError_t e = hipLaunchCooperativeKernel((const void*)fwd_kernel, dim3(grid), dim3(512), args, LDS_BYTES, stream);
    if (e != hipSuccess) fprintf(stderr, "cooperative launch failed: %s (grid %d)\n", hipGetErrorString(e), grid);
}
```

```cpp
#include <hip/hip_runtime.h>
#include <hip/hip_cooperative_groups.h>
#include <cstdio>
#include <cstdint>
namespace cg = cooperative_groups;
#ifndef REP_P0
#define REP_P0 1
#endif
#ifndef REP_IN
#define REP_IN 1
#endif
#ifndef REP_MIX
#define REP_MIX 1
#endif
#ifndef REP_MERGE
#define REP_MERGE 1
#endif
#ifndef REP_OUT
#define REP_OUT 1
#endif
#ifndef REP_UP
#define REP_UP 1
#endif
#ifndef REP_DN
#define REP_DN 1
#endif
#ifndef REP_ROW
#define REP_ROW 1
#endif
#ifndef REP_SYNC
#define REP_SYNC 1
#endif
#ifndef USE_CG_SYNC
#define USE_CG_SYNC 0
#endif
#define GSYNC() do { for (int _r = 0; _r < REP_SYNC; ++_r) { if (USE_CG_SYNC) grid.sync(); else { XcdBarrier _b; _b.bar = xbar_words; _b.x = xbar_x; _b.st = (volatile LAS unsigned*)(lds + LDS_MISC + 32); xcd_barrier(_b); } } } while (0)

#define LAS __attribute__((address_space(3)))
typedef unsigned short bf16_t;
typedef short bf16x8 __attribute__((ext_vector_type(8)));
typedef float f32x4 __attribute__((ext_vector_type(4)));
typedef unsigned u32x4 __attribute__((ext_vector_type(4)));
typedef unsigned u32x2 __attribute__((ext_vector_type(2)));

constexpr int DM = 2048, NBATCH = 4, SEQ = 2048, MROWS = NBATCH * SEQ, DEPTH = 2;
constexpr int INC = 12804;
constexpr int NP = 12800;
constexpr int NIN = 13056;
constexpr int FFN = 8192;
constexpr int P_AU = 0, P_AV = 512, P_BQ = 1024, P_BK = 1536, P_BV = 2048, P_CQ = 2560, P_CK = 3072, P_CV = 3584, P_DH = 4096, P_GATE = 4608;
constexpr float NORM_EPS = 1e-6f;
constexpr float LOG2E = 1.4426950408889634f;

constexpr size_t MiB = 1u << 20;
constexpr size_t WS_CTL = 0, CTL_BYTES = 65536;
constexpr int CW_BAR = 4096;
constexpr size_t WS_W = 1 * MiB, WL_STRIDE = 132 * MiB;
constexpr size_t WO_IN = 0, WO_BR = 51 * MiB, WO_OUT = 59 * MiB, WO_UP = 67 * MiB, WO_DN = 99 * MiB, WO_POOL = 131 * MiB;
constexpr size_t WS_PROJ = 266 * MiB;
constexpr size_t WS_XN = 466 * MiB;
constexpr size_t WS_BR = 498 * MiB;
constexpr size_t WS_MB = 530 * MiB;
constexpr size_t WS_Y = 562 * MiB;
constexpr size_t WS_FLOG = 626 * MiB;
constexpr size_t WS_ROT = 627 * MiB;
constexpr size_t WS_HB = 628 * MiB;
constexpr size_t WS_END = 660 * MiB;

constexpr int LDS_BYTES = 139264;
constexpr int LDS_MISC = 135168;

__device__ __forceinline__ unsigned f2bf(float f) { unsigned u = __builtin_bit_cast(unsigned, f); return (u + 0x7fffu + ((u >> 16) & 1u)) >> 16; }
__device__ __forceinline__ unsigned pk2(float lo, float hi) { return f2bf(lo) | (f2bf(hi) << 16); }
__device__ __forceinline__ float bflo(unsigned w) { return __builtin_bit_cast(float, w << 16); }
__device__ __forceinline__ float bfhi(unsigned w) { return __builtin_bit_cast(float, w & 0xffff0000u); }
__device__ __forceinline__ float wave_sum(float v) {
#pragma unroll
    for (int o = 1; o < 64; o <<= 1) v += __shfl_xor(v, o);
    return v;
}
#define LDS_WAIT() asm volatile("s_waitcnt lgkmcnt(0)" ::: "memory")

namespace pg8 {
constexpr int BM = 256, BK = 64, HALF = 128, HTB = HALF * BK * 2, STAGE_BYTES = 8 * HTB, NXCD = 8, WGM = 8;
__host__ __device__ __forceinline__ int lds_byte(int r, int c) { const int st = (r >> 4) * 2 + (c >> 5), rr = r & 15, cc = c & 31, ob = rr * 64 + cc * 2; return st * 1024 + (ob ^ (((ob >> 9) & 1) << 5)); }
__host__ __device__ __forceinline__ void stage_rc(int b, int& R, int& C) { const int st = b / 1024, sb = b % 1024, swz = sb ^ (((sb >> 9) & 1) << 5); R = (st >> 1) * 16 + swz / 64; C = (st & 1) * 32 + (swz % 64) / 2; }
__host__ __device__ __forceinline__ int perm32(int rho) { const int n = rho >> 4, i = rho & 15; return 8 * (i >> 2) + 4 * n + (i & 3); }

struct Unit { int pm, pn; };
struct Gemm { const bf16_t* A; const bf16_t* Bt; int M, N, K; };

struct StaticOrder {
    int nM, nN, nwg, G, c, nrep;
    __device__ void init(int M, int N, int G_, int c_, int nrep_ = 1) { nM = M / BM; nN = N / BM; nwg = nM * nN; G = G_; c = c_; nrep = nrep_; asm volatile("" : "+s"(c), "+s"(G)); }
    __device__ bool next(int i, Unit& u) const {
        long L = (long)i * G + c; if (L >= (long)nwg * nrep) return false;
        if (nrep > 1) L %= nwg;
        int wgid = (int)L; { const int q = nwg / NXCD, r = nwg % NXCD, xcd = wgid % NXCD, off = wgid / NXCD; wgid = (xcd < r ? xcd * (q + 1) : r * (q + 1) + (xcd - r) * q) + off; }
        const int nig = WGM * nN, gid = wgid / nig, fm = gid * WGM, gsz = (nM - fm) < WGM ? (nM - fm) : WGM;
        u.pm = fm + ((wgid % nig) % gsz); u.pn = (wgid % nig) / gsz; return true;
    }
};

struct InOrder : StaticOrder {
    int i0, i1;
    __device__ void init(int M, int N, int G_, int c_, int i0_, int i1_) { StaticOrder::init(M, N, G_, c_, 1); i0 = i0_; i1 = i1_; }
    __device__ bool next(int i, Unit& u) const {
        if (i + i0 >= i1) return false;
        const bool ok = StaticOrder::next(i + i0, u);
        if (ok) u.pn = (u.pn == 0) ? 50 : u.pn - 1;
        return ok;
    }
};
__device__ __forceinline__ unsigned cvt_pk_bf16(float lo, float hi) { unsigned r; asm volatile("v_cvt_pk_bf16_f32 %0, %1, %2" : "=v"(r) : "v"(lo), "v"(hi)); return r; }


struct EpiIn {
    static constexpr bool PERM = true, FOLD = false;
    bf16_t* O; float* flog; const float* rot; const float* bfv;
    __device__ __forceinline__ void operator()(const f32x4 (&acc)[2][2][4][2], const Unit& u, int wr, int wc, int fr, int fq) const {
        const int row0 = u.pm * BM + wr * 64 + fr;
        if (u.pn == 50) {
            if (wc == 0 && fq == 0) {
                const f32x4 b = *(const f32x4*)bfv;
#pragma unroll
                for (int ai = 0; ai < 2; ++ai)
#pragma unroll
                    for (int m = 0; m < 4; ++m) *(f32x4*)(flog + (size_t)(row0 + ai * HALF + m * 16) * 4) = acc[ai][0][m][0] + b;
            }
            return;
        }
        const int col0 = u.pn * BM + wc * 32 + 8 * fq;
        const bool sig = u.pn >= 18;
        const bool rotary = (u.pn >= 4) && (u.pn < 8) && ((wc & 1) == 0);
        const float sg = (fq == 0) ? -1.f : 1.f;
#pragma unroll
        for (int ai = 0; ai < 2; ++ai)
#pragma unroll
            for (int m = 0; m < 4; ++m) {
                const int row = row0 + ai * HALF + m * 16;
                bf16_t* rowp = O + (size_t)row * NP + col0;
                f32x4 v[2][2];
#pragma unroll
                for (int bj = 0; bj < 2; ++bj) { v[bj][0] = acc[ai][bj][m][0]; v[bj][1] = acc[ai][bj][m][1]; }
                if (rotary) {
                    const f32x4* rp = (const f32x4*)(rot + (size_t)row * 16);
#pragma unroll
                    for (int n = 0; n < 2; ++n) {
                        const f32x4 ca = rp[2 * n], cb = rp[2 * n + 1];
                        const float cc[4] = {ca[0], ca[2], cb[0], cb[2]};
                        const float ss[4] = {ca[1] * sg, ca[3] * sg, cb[1] * sg, cb[3] * sg};
#pragma unroll
                        for (int bj = 0; bj < 2; ++bj)
#pragma unroll
                            for (int j = 0; j < 4; ++j) {
                                const float own = v[bj][n][j];
                                const float par = __shfl_xor(own, 16);
                                const float nv = own * cc[j] + par * ss[j];
                                v[bj][n][j] = (fq < 2) ? nv : own;
                            }
                    }
                    asm volatile("" ::: "memory");
                }
#pragma unroll
                for (int bj = 0; bj < 2; ++bj) {
                    f32x4 v0 = v[bj][0], v1 = v[bj][1];
                    if (sig) {
#pragma unroll
                        for (int j = 0; j < 4; ++j) {
                            v0[j] = __builtin_amdgcn_rcpf(1.0f + __builtin_amdgcn_exp2f(v0[j]));
                            v1[j] = __builtin_amdgcn_rcpf(1.0f + __builtin_amdgcn_exp2f(v1[j]));
                        }
                    }
                    u32x4 w; w.x = cvt_pk_bf16(v0[0], v0[1]); w.y = cvt_pk_bf16(v0[2], v0[3]); w.z = cvt_pk_bf16(v1[0], v1[1]); w.w = cvt_pk_bf16(v1[2], v1[3]);
                    *(u32x4*)(rowp + bj * HALF) = w;
                }
            }
    }
};
template <int ACT> struct EpiBf {
    static constexpr bool PERM = true, FOLD = false;
    bf16_t* O; int ldc;
    __device__ __forceinline__ void operator()(const f32x4 (&acc)[2][2][4][2], const Unit& u, int wr, int wc, int fr, int fq) const {
        const int row0 = u.pm * BM + wr * 64 + fr, col0 = u.pn * BM + wc * 32 + 8 * fq;
#pragma unroll
        for (int ai = 0; ai < 2; ++ai)
#pragma unroll
            for (int m = 0; m < 4; ++m) {
                bf16_t* rowp = O + (size_t)(row0 + ai * HALF + m * 16) * ldc + col0;
#pragma unroll
                for (int bj = 0; bj < 2; ++bj) {
                    f32x4 v0 = acc[ai][bj][m][0], v1 = acc[ai][bj][m][1];
#pragma unroll
                    for (int j = 0; j < 4; ++j) { if (ACT == 1) { const float a = fmaxf(v0[j], 0.f), b = fmaxf(v1[j], 0.f); v0[j] = a * a; v1[j] = b * b; } }
                    u32x4 w; w.x = cvt_pk_bf16(v0[0], v0[1]); w.y = cvt_pk_bf16(v0[2], v0[3]); w.z = cvt_pk_bf16(v1[0], v1[1]); w.w = cvt_pk_bf16(v1[2], v1[3]);
                    *(u32x4*)(rowp + bj * HALF) = w;
                }
            }
    }
};
struct EpiF32 {
    static constexpr bool PERM = false, FOLD = false;
    float* C; int ldc;
    __device__ __forceinline__ void operator()(const f32x4 (&acc)[2][2][4][2], const Unit& u, int wr, int wc, int fr, int fq) const {
        const int row0 = u.pm * BM + wr * 64 + fr, col0 = u.pn * BM + wc * 32 + 4 * fq;
#pragma unroll
        for (int ai = 0; ai < 2; ++ai)
#pragma unroll
            for (int m = 0; m < 4; ++m) {
                float* rowp = C + (size_t)(row0 + ai * HALF + m * 16) * ldc + col0;
#pragma unroll
                for (int bj = 0; bj < 2; ++bj)
#pragma unroll
                    for (int n = 0; n < 2; ++n) *(f32x4*)(rowp + bj * HALF + n * 16) = acc[ai][bj][m][n];
            }
    }
};
struct EpiMergeFold {
    static constexpr bool PERM = true, FOLD = true;
    const bf16_t* gate;
    bf16_t* MBo;
    static __device__ __forceinline__ void unpack8(const u32x4 w, float (&f)[8]) {
        f[0] = bflo(w.x); f[1] = bfhi(w.x); f[2] = bflo(w.y); f[3] = bfhi(w.y); f[4] = bflo(w.z); f[5] = bfhi(w.z); f[6] = bflo(w.w); f[7] = bfhi(w.w);
#pragma unroll
        for (int j = 0; j < 8; ++j) f[j] = fmaxf(f[j], 1e-30f);
    }
    static __device__ __forceinline__ float ratio(float n, float d) { return fmaxf(n, 1e-30f) * __builtin_amdgcn_rcpf(fmaxf(d, 1e-30f)); }
    __device__ __forceinline__ void fold(f32x4 (&acc)[2][2][4][2], const Unit& u, int nb, int wr, int wc, int fr, int fq) const {
        const bf16_t* gbase = gate + (size_t)(u.pm * BM + wr * 64 + fr) * NP + (size_t)nb * DM + (u.pn * BM + wc * 32 + 8 * fq);
#pragma unroll
        for (int ai = 0; ai < 2; ++ai) {
            u32x4 wn[4][2], wd[4][2];
#pragma unroll
            for (int m = 0; m < 4; ++m)
#pragma unroll
                for (int bj = 0; bj < 2; ++bj) {
                    const bf16_t* gp = gbase + (size_t)(ai * HALF + m * 16) * NP + bj * HALF;
                    wn[m][bj] = *(const u32x4*)(gp - DM);
                    wd[m][bj] = *(const u32x4*)gp;
                }
#pragma unroll
            for (int m = 0; m < 4; ++m)
#pragma unroll
                for (int bj = 0; bj < 2; ++bj) {
                    const u32x4 a = wn[m][bj], d = wd[m][bj];
                    f32x4 r0, r1;
                    r0[0] = ratio(bflo(a.x), bflo(d.x)); r0[1] = ratio(bfhi(a.x), bfhi(d.x)); r0[2] = ratio(bflo(a.y), bflo(d.y)); r0[3] = ratio(bfhi(a.y), bfhi(d.y));
                    r1[0] = ratio(bflo(a.z), bflo(d.z)); r1[1] = ratio(bfhi(a.z), bfhi(d.z)); r1[2] = ratio(bflo(a.w), bflo(d.w)); r1[3] = ratio(bfhi(a.w), bfhi(d.w));
                    acc[ai][bj][m][0] *= r0; acc[ai][bj][m][1] *= r1;
                }
            asm volatile("" ::: "memory");
        }
    }
    __device__ __forceinline__ void operator()(const f32x4 (&acc)[2][2][4][2], const Unit& u, int wr, int wc, int fr, int fq) const {
        const int row0 = u.pm * BM + wr * 64 + fr, col0 = u.pn * BM + wc * 32 + 8 * fq;
        u32x4 gw[2][4][2];
#pragma unroll
        for (int ai = 0; ai < 2; ++ai)
#pragma unroll
            for (int m = 0; m < 4; ++m)
#pragma unroll
                for (int bj = 0; bj < 2; ++bj) gw[ai][m][bj] = *(const u32x4*)(gate + (size_t)(row0 + ai * HALF + m * 16) * NP + (size_t)3 * DM + col0 + bj * HALF);
#pragma unroll
        for (int ai = 0; ai < 2; ++ai)
#pragma unroll
            for (int m = 0; m < 4; ++m) {
                bf16_t* rowp = MBo + (size_t)(row0 + ai * HALF + m * 16) * DM + col0;
#pragma unroll
                for (int bj = 0; bj < 2; ++bj) {
                    float g[8]; unpack8(gw[ai][m][bj], g);
                    const f32x4 v0 = acc[ai][bj][m][0], v1 = acc[ai][bj][m][1];
                    u32x4 w; w.x = cvt_pk_bf16(v0[0] * g[0], v0[1] * g[1]); w.y = cvt_pk_bf16(v0[2] * g[2], v0[3] * g[3]); w.z = cvt_pk_bf16(v1[0] * g[4], v1[1] * g[5]); w.w = cvt_pk_bf16(v1[2] * g[6], v1[3] * g[7]);
                    *(u32x4*)(rowp + bj * HALF) = w;
                }
            }
    }
};

template <class Epi, class Sched, bool ALIGN_EPI = true, bool SP2 = true>
__device__ __forceinline__ void gemm_phase(LAS unsigned char* lds, const Gemm g, const Sched& S, const Epi& E) {
    int tid = threadIdx.x; asm volatile("" : "+v"(tid));
    const int wid = __builtin_amdgcn_readfirstlane(tid >> 6), lane = tid & 63, wr = wid >> 2, wc = wid & 3, fr = lane & 15, fq = lane >> 4;
    const int K = g.K, nt = K / BK;
    unsigned voffA[2], voffB[2];
#pragma unroll
    for (int i = 0; i < 2; ++i) { int R, C; stage_rc(tid * 16 + i * 8192, R, C); const int Rb = Epi::PERM ? ((R & ~31) + perm32(R & 31)) : R;
        voffA[i] = (unsigned)(R * K + C) * 2u; voffB[i] = (unsigned)(Rb * K + C) * 2u; }
    const size_t kstep = (size_t)(BK * 2);
    const size_t hstep = (size_t)HALF * K * 2;
    const size_t tstep = 2 * hstep;
    const unsigned ldsw = (unsigned)wid * 1024u;
    const int aoff = lds_byte(wr * 64 + fr, fq * 8), boff = lds_byte(wc * 32 + fr, fq * 8);
#define PG8_SA(b, h) (((b) * 2 + (h)) * HTB)
#define PG8_SB(b, h) ((4 + (b) * 2 + (h)) * HTB)
#define PG8_STAGE(bufoff, gbase, voff) do { _Pragma("unroll") for (int _i = 0; _i < 2; ++_i) \
        __builtin_amdgcn_global_load_lds((const unsigned*)((const char*)(gbase) + (voff)[_i]), (LAS unsigned*)(lds + (bufoff) + ldsw + _i * 8192), 16, 0, 0); } while (0)
#define PG8_LDA(dst, b, h) do { _Pragma("unroll") for (int m = 0; m < 4; ++m) _Pragma("unroll") for (int k = 0; k < 2; ++k) dst[m][k] = *(const LAS bf16x8*)(lds + PG8_SA(b, h) + aoff + m * 2048 + k * 1024); } while (0)
#define PG8_LDB(dst, b, h) do { _Pragma("unroll") for (int n = 0; n < 2; ++n) _Pragma("unroll") for (int k = 0; k < 2; ++k) dst[n][k] = *(const LAS bf16x8*)(lds + PG8_SB(b, h) + boff + n * 2048 + k * 1024); } while (0)
#define PG8_MMA(ai, bj, At, Bt) do { __builtin_amdgcn_s_setprio(1); _Pragma("unroll") for (int m = 0; m < 4; ++m) _Pragma("unroll") for (int n = 0; n < 2; ++n) _Pragma("unroll") for (int k = 0; k < 2; ++k) \
        acc[ai][bj][m][n] = __builtin_amdgcn_mfma_f32_16x16x32_bf16(Bt[n][k], At[m][k], acc[ai][bj][m][n], 0, 0, 0); __builtin_amdgcn_s_setprio(0); } while (0)
#define PG8_WAIT_V(n) asm volatile("s_waitcnt vmcnt(" #n ")" ::: "memory")
#define PG8_WAIT_L(n) asm volatile("s_waitcnt lgkmcnt(" #n ")" ::: "memory")
#define PG8_BAR __builtin_amdgcn_s_barrier()
#define PG8_SCHED __builtin_amdgcn_sched_barrier(0)
    Unit cur, nxt; int ui = 0;
    if (!S.next(0, cur)) return;
    f32x4 acc[2][2][4][2];
#pragma unroll
    for (int a = 0; a < 2; ++a)
#pragma unroll
        for (int b = 0; b < 2; ++b)
#pragma unroll
            for (int m = 0; m < 4; ++m)
#pragma unroll
                for (int n = 0; n < 2; ++n) acc[a][b][m][n] = (f32x4){0.f, 0.f, 0.f, 0.f};
    bf16x8 At[4][2], B0[2][2], B1[2][2];
    const char* cA = (const char*)g.A + (size_t)cur.pm * tstep; const char* cB = (const char*)g.Bt + (size_t)cur.pn * tstep;
    if constexpr (SP2) {
        PG8_STAGE(PG8_SB(0, 0), cB, voffB); PG8_STAGE(PG8_SB(0, 1), cB + hstep, voffB); PG8_STAGE(PG8_SA(0, 0), cA, voffA); PG8_STAGE(PG8_SA(0, 1), cA + hstep, voffA);
        if (wr == 1) PG8_BAR;
        PG8_WAIT_V(2); PG8_BAR;
        PG8_STAGE(PG8_SB(1, 0), cB + kstep, voffB); PG8_STAGE(PG8_SA(1, 0), cA + kstep, voffA); PG8_STAGE(PG8_SB(1, 1), cB + hstep + kstep, voffB);
        PG8_WAIT_V(6); PG8_BAR;
    } else {
        PG8_STAGE(PG8_SB(0, 0), cB, voffB); PG8_STAGE(PG8_SA(0, 0), cA, voffA); PG8_STAGE(PG8_SB(0, 1), cB + hstep, voffB); PG8_STAGE(PG8_SA(0, 1), cA + hstep, voffA);
        if (wr == 1) PG8_BAR;
        PG8_WAIT_V(4); PG8_BAR;
        PG8_STAGE(PG8_SB(1, 0), cB + kstep, voffB); PG8_STAGE(PG8_SA(1, 0), cA + kstep, voffA); PG8_STAGE(PG8_SB(1, 1), cB + hstep + kstep, voffB);
        PG8_WAIT_V(6); PG8_BAR;
    }
    for (;;) {
        const bool has_next = S.next(ui + 1, nxt);
        const char* nA = has_next ? (const char*)g.A + (size_t)nxt.pm * tstep : cA; const char* nB = has_next ? (const char*)g.Bt + (size_t)nxt.pn * tstep : cB;
        for (int t = 0; t < nt; t += 2) {
            const bool last = (t == nt - 2);
            const char* a1 = cA + (size_t)(t + 1) * kstep;
            const char* a2 = last ? nA : cA + (size_t)(t + 2) * kstep; const char* b2 = last ? nB : cB + (size_t)(t + 2) * kstep;
            const char* a3 = a2 + kstep; const char* b3 = b2 + kstep;
            if constexpr (Epi::FOLD) { if (t > 0 && (t & 7) == 0) E.fold(acc, cur, t >> 3, wr, wc, fr, fq); }
            if constexpr (SP2) {
            PG8_LDB(B0, 0, 0); PG8_LDB(B1, 0, 1); PG8_SCHED; PG8_LDA(At, 0, 0); PG8_STAGE(PG8_SA(1, 1), a1 + hstep, voffA);
            PG8_WAIT_V(8); PG8_WAIT_L(0); PG8_BAR; PG8_MMA(0, 0, At, B0); PG8_MMA(0, 1, At, B1); PG8_BAR; PG8_SCHED;
            PG8_LDA(At, 0, 1); PG8_STAGE(PG8_SB(0, 0), b2, voffB); PG8_STAGE(PG8_SB(0, 1), b2 + hstep, voffB); PG8_STAGE(PG8_SA(0, 0), a2, voffA);
            PG8_WAIT_V(8); PG8_WAIT_L(0); PG8_BAR; PG8_MMA(1, 0, At, B0); PG8_MMA(1, 1, At, B1); PG8_BAR; PG8_SCHED;
            PG8_LDB(B0, 1, 0); PG8_LDB(B1, 1, 1); PG8_SCHED; PG8_LDA(At, 1, 0); PG8_STAGE(PG8_SA(0, 1), a2 + hstep, voffA);
            PG8_WAIT_V(8); PG8_WAIT_L(0); PG8_BAR; PG8_MMA(0, 0, At, B0); PG8_MMA(0, 1, At, B1); PG8_BAR; PG8_SCHED;
            PG8_LDA(At, 1, 1); PG8_STAGE(PG8_SB(1, 0), b3, voffB); PG8_STAGE(PG8_SB(1, 1), b3 + hstep, voffB); PG8_STAGE(PG8_SA(1, 0), a3, voffA);
            PG8_WAIT_V(8); PG8_WAIT_L(0); PG8_BAR; PG8_MMA(1, 0, At, B0); PG8_MMA(1, 1, At, B1); PG8_BAR; PG8_SCHED;
            } else {
            PG8_LDB(B0, 0, 0); PG8_SCHED; PG8_LDA(At, 0, 0); PG8_STAGE(PG8_SA(1, 1), a1 + hstep, voffA);
            PG8_WAIT_L(8); PG8_BAR; PG8_WAIT_L(0); PG8_MMA(0, 0, At, B0); PG8_BAR; PG8_SCHED;
            PG8_LDB(B1, 0, 1); PG8_STAGE(PG8_SB(0, 0), b2, voffB);
            PG8_BAR; PG8_WAIT_L(0); PG8_MMA(0, 1, At, B1); PG8_BAR;
            PG8_LDA(At, 0, 1); PG8_STAGE(PG8_SA(0, 0), a2, voffA);
            PG8_BAR; PG8_WAIT_L(0); PG8_MMA(1, 0, At, B0); PG8_BAR; PG8_SCHED;
            PG8_STAGE(PG8_SB(0, 1), b2 + hstep, voffB);
            PG8_WAIT_V(6); PG8_BAR; PG8_MMA(1, 1, At, B1); PG8_BAR;
            PG8_LDB(B0, 1, 0); PG8_SCHED; PG8_LDA(At, 1, 0); PG8_STAGE(PG8_SA(0, 1), a2 + hstep, voffA);
            PG8_WAIT_L(8); PG8_BAR; PG8_WAIT_L(0); PG8_MMA(0, 0, At, B0); PG8_BAR; PG8_SCHED;
            PG8_LDB(B1, 1, 1); PG8_STAGE(PG8_SB(1, 0), b3, voffB);
            PG8_BAR; PG8_WAIT_L(0); PG8_MMA(0, 1, At, B1); PG8_BAR;
            PG8_LDA(At, 1, 1); PG8_STAGE(PG8_SA(1, 0), a3, voffA);
            PG8_BAR; PG8_WAIT_L(0); PG8_MMA(1, 0, At, B0); PG8_BAR; PG8_SCHED;
            PG8_STAGE(PG8_SB(1, 1), b3 + hstep, voffB);
            PG8_WAIT_V(6); PG8_BAR; PG8_MMA(1, 1, At, B1); PG8_BAR;
            }
        }
        if constexpr (ALIGN_EPI) { if (wr == 0) PG8_BAR; }
        E(acc, cur, wr, wc, fr, fq);
        if (!has_next) break;
#pragma unroll
        for (int a = 0; a < 2; ++a)
#pragma unroll
            for (int b = 0; b < 2; ++b)
#pragma unroll
                for (int m = 0; m < 4; ++m)
#pragma unroll
                    for (int n = 0; n < 2; ++n) acc[a][b][m][n] = (f32x4){0.f, 0.f, 0.f, 0.f};
        cur = nxt; cA = nA; cB = nB; ++ui;
        if constexpr (ALIGN_EPI) { if (wr == 1) PG8_BAR; }
    }
    PG8_WAIT_V(0);
    if constexpr (!ALIGN_EPI) { if (wr == 0) PG8_BAR; }
    PG8_BAR;
#undef PG8_SA
#undef PG8_SB
#undef PG8_STAGE
#undef PG8_LDA
#undef PG8_LDB
#undef PG8_MMA
#undef PG8_WAIT_V
#undef PG8_WAIT_L
#undef PG8_BAR
#undef PG8_SCHED
}
}

struct Args {
    const float* x; const int* pos;
    const float *n_mix_pre, *n_mix_post, *n_ffn_pre, *n_ffn_post, *w_in, *gm_ln_g, *gm_ln_b, *gm_w_s, *gm_b_s, *da_lambda, *da_subln_g, *fa_b_f,
                *pool_w, *pool_scale, *w_branch, *w_out, *w_ffn_up, *w_ffn_down;
    float* out; unsigned char* ws;
};

struct TrDesc { const float* sp; size_t ld; bf16_t* dp; int K; float scale; bool ok; };
__device__ __forceinline__ void tr_load(const TrDesc& d, f32x4 (&v)[16]) {
#pragma unroll
    for (int i = 0; i < 16; ++i) v[i] = d.ok ? __builtin_nontemporal_load((const f32x4*)(d.sp + (size_t)(4 * i) * d.ld)) : (f32x4){0.f, 0.f, 0.f, 0.f};
}
__device__ __forceinline__ void tr_finish(const TrDesc& d, const f32x4 (&v)[16], LAS float* scr, int lane) {
    const int c4 = (lane & 15) * 4, kr = lane >> 4;
#pragma unroll
    for (int i = 0; i < 16; ++i) {
        LAS float* p = scr + (4 * i + kr) * 65 + c4;
        p[0] = v[i][0] * d.scale; p[1] = v[i][1] * d.scale; p[2] = v[i][2] * d.scale; p[3] = v[i][3] * d.scale;
    }
    LDS_WAIT();
    const int c = lane & 7;
#pragma unroll
    for (int j = 0; j < 8; ++j) {
        const int n = (lane >> 3) + 8 * j;
        const LAS float* s = scr + (8 * c) * 65 + n;
        u32x4 o; o.x = pg8::cvt_pk_bf16(s[0], s[65]); o.y = pg8::cvt_pk_bf16(s[2 * 65], s[3 * 65]); o.z = pg8::cvt_pk_bf16(s[4 * 65], s[5 * 65]); o.w = pg8::cvt_pk_bf16(s[6 * 65], s[7 * 65]);
        *(u32x4*)(d.dp + (size_t)n * d.K + 8 * c) = o;
    }
    LDS_WAIT();
}

__device__ __forceinline__ void rms_row_bf16(const float* xrow, const f32x4 (&gv)[8], bf16_t* orow, int lane) {
    f32x4 v[8]; float s = 0.f;
#pragma unroll
    for (int j = 0; j < 8; ++j) { v[j] = *((const f32x4*)xrow + lane + 64 * j); s += (v[j][0] * v[j][0] + v[j][1] * v[j][1]) + (v[j][2] * v[j][2] + v[j][3] * v[j][3]); }
    const float rstd = 1.0f / sqrtf(wave_sum(s) * (1.0f / DM) + NORM_EPS);
#pragma unroll
    for (int j = 0; j < 8; ++j) {
        u32x2 w; w.x = pk2(v[j][0] * rstd * gv[j][0], v[j][1] * rstd * gv[j][1]); w.y = pk2(v[j][2] * rstd * gv[j][2], v[j][3] * rstd * gv[j][3]);
        *((u32x2*)orow + lane + 64 * j) = w;
    }
}

__device__ __forceinline__ void phase0(const Args& a, LAS unsigned char* lds, int gw, int NGW, int wave, int lane) {
    LAS float* scr = (LAS float*)(lds + wave * 16640);
    constexpr int I_IN = 32 * 204, I_BR = 4 * 8 * 32, I_OUT = 32 * 32, I_UP = 32 * 128, I_DN = 128 * 32, I_POOL = 16;
    constexpr int I_LAYER = I_IN + I_BR + I_OUT + I_UP + I_DN + I_POOL, I_ALL = DEPTH * I_LAYER;
    const int c4 = (lane & 15) * 4, kr = lane >> 4;
    auto decode = [&](int it) -> TrDesc {
        const int l = it / I_LAYER; int r = it - l * I_LAYER;
        unsigned char* wl = a.ws + WS_W + (size_t)l * WL_STRIDE;
        const float* src; size_t ld; int sc, nv = 64, k0, n0, K; bf16_t* dst; float scale = 1.0f;
        if (r < I_IN) {
            const int kb = r / 204, nb = r % 204; n0 = nb * 64; k0 = kb * 64;
            if (nb < 64) { sc = n0; } else if (nb < 200) { sc = n0 + 4; } else if (nb == 200) { sc = 4096; nv = 4; } else { sc = 0; nv = 0; }
            src = a.w_in + (size_t)l * DM * INC; ld = INC; dst = (bf16_t*)(wl + WO_IN); K = DM;
            scale = (nb >= 72 && nb < 200) ? -LOG2E : 1.0f;
        } else if ((r -= I_IN) < I_BR) {
            const int n = r / 256, rr = r % 256, kb = rr / 32, nb = rr % 32; n0 = nb * 64; k0 = kb * 64; sc = n0;
            src = a.w_branch + ((size_t)l * 4 + n) * 512 * DM; ld = DM; dst = (bf16_t*)(wl + WO_BR) + n * 512; K = DM;
        } else if ((r -= I_BR) < I_OUT) {
            const int kb = r / 32, nb = r % 32; n0 = nb * 64; k0 = kb * 64; sc = n0;
            src = a.w_out + (size_t)l * DM * DM; ld = DM; dst = (bf16_t*)(wl + WO_OUT); K = DM;
        } else if ((r -= I_OUT) < I_UP) {
            const int kb = r / 128, nb = r % 128; n0 = nb * 64; k0 = kb * 64; sc = n0;
            src = a.w_ffn_up + (size_t)l * DM * FFN; ld = FFN; dst = (bf16_t*)(wl + WO_UP); K = DM;
        } else if ((r -= I_UP) < I_DN) {
            const int kb = r / 32, nb = r % 32; n0 = nb * 64; k0 = kb * 64; sc = n0;
            src = a.w_ffn_down + (size_t)l * FFN * DM; ld = DM; dst = (bf16_t*)(wl + WO_DN); K = FFN;
        } else {
            r -= I_DN;
            const int g = r / 4, rr = r % 4, kb = rr / 2, nb = rr % 2; n0 = nb * 64; k0 = kb * 64; sc = n0;
            src = a.pool_w + ((size_t)l * 4 + g) * 128 * 128; ld = 128; dst = (bf16_t*)(wl + WO_POOL) + (size_t)g * 128 * 128; K = 128;
        }
        TrDesc d; d.sp = src + (size_t)(k0 + kr) * ld + sc + c4; d.ld = ld; d.dp = dst + (size_t)n0 * K + k0; d.K = K; d.scale = scale; d.ok = c4 < nv;
        return d;
    };
    {
        int it = gw; TrDesc dA, dB; f32x4 vA[16], vB[16];
        if (it < I_ALL) { dA = decode(it); tr_load(dA, vA); }
        while (it < I_ALL) {
            const int itB = it + NGW;
            if (itB < I_ALL) { dB = decode(itB); tr_load(dB, vB); }
            tr_finish(dA, vA, scr, lane);
            const int itA = itB + NGW;
            if (itA < I_ALL) { dA = decode(itA); tr_load(dA, vA); }
            if (itB < I_ALL) tr_finish(dB, vB, scr, lane);
            it = itA;
        }
    }
    {
        float* rot = (float*)(a.ws + WS_ROT);
        const float inv[8] = {1.0f, 0.193922758102417f, 0.03760603070259094f, 0.00729266507551074f, 0.001414213445968926f, 0.00027424818836152554f, 5.318296462064609e-05f, 1.0313385246263351e-05f};
        for (int e = gw * 64 + lane; e < MROWS * 8; e += NGW * 64) {
            const int row = e >> 3, i = e & 7;
            float iv = inv[0];
#pragma unroll
            for (int q = 1; q < 8; ++q) iv = (i == q) ? inv[q] : iv;
            const float ang = (float)a.pos[row] * iv;
            const double ad = (double)ang;
            const double kk = __builtin_rint(ad * 0.15915494309189535);
            const float rr = (float)(ad - kk * 6.283185307179586);
            rot[2 * e] = cosf(rr); rot[2 * e + 1] = sinf(rr);
        }
    }
    {
        f32x4 g0[8];
#pragma unroll
        for (int j = 0; j < 8; ++j) g0[j] = *((const f32x4*)a.n_mix_pre + lane + 64 * j);
        for (int m = gw; m < MROWS; m += NGW) rms_row_bf16(a.x + (size_t)m * DM, g0, (bf16_t*)(a.ws + WS_XN) + (size_t)m * DM, lane);
    }
}

template <bool HIN_BF, bool HOUT_BF>
__device__ __forceinline__ void row_phase(const bf16_t* Y, const void* hin, void* hout, const float* gpost, const float* gpre, bf16_t* XN, int gw, int NGW, int lane) {
    f32x4 gpo[8], gpr[8];
#pragma unroll
    for (int j = 0; j < 8; ++j) { gpo[j] = *((const f32x4*)gpost + lane + 64 * j); gpr[j] = gpre ? *((const f32x4*)gpre + lane + 64 * j) : (f32x4){0.f, 0.f, 0.f, 0.f}; }
    for (int m = gw; m < MROWS; m += NGW) {
        const u32x2* yr = (const u32x2*)(Y + (size_t)m * DM);
        u32x2 yw[8]; u32x2 hw[8]; f32x4 hf[8];
#pragma unroll
        for (int j = 0; j < 8; ++j) yw[j] = yr[lane + 64 * j];
#pragma unroll
        for (int j = 0; j < 8; ++j) {
            if (HIN_BF) hw[j] = *((const u32x2*)((const bf16_t*)hin + (size_t)m * DM) + lane + 64 * j);
            else hf[j] = *((const f32x4*)((const float*)hin + (size_t)m * DM) + lane + 64 * j);
        }
        f32x4 v[8]; float s = 0.f;
#pragma unroll
        for (int j = 0; j < 8; ++j) { v[j] = (f32x4){bflo(yw[j].x), bfhi(yw[j].x), bflo(yw[j].y), bfhi(yw[j].y)}; s += (v[j][0] * v[j][0] + v[j][1] * v[j][1]) + (v[j][2] * v[j][2] + v[j][3] * v[j][3]); }
        const float rstd = 1.0f / sqrtf(wave_sum(s) * (1.0f / DM) + NORM_EPS);
        float s2 = 0.f;
#pragma unroll
        for (int j = 0; j < 8; ++j) {
            f32x4 h;
            if (HIN_BF) h = (f32x4){bflo(hw[j].x), bfhi(hw[j].x), bflo(hw[j].y), bfhi(hw[j].y)}; else h = hf[j];
            v[j] = h + v[j] * rstd * gpo[j];
            if (HOUT_BF) { u32x2 w; w.x = pk2(v[j][0], v[j][1]); w.y = pk2(v[j][2], v[j][3]); *((u32x2*)((bf16_t*)hout + (size_t)m * DM) + lane + 64 * j) = w; }
            else *((f32x4*)((float*)hout + (size_t)m * DM) + lane + 64 * j) = v[j];
            s2 += (v[j][0] * v[j][0] + v[j][1] * v[j][1]) + (v[j][2] * v[j][2] + v[j][3] * v[j][3]);
        }
        if (gpre) {
            const float rstd2 = 1.0f / sqrtf(wave_sum(s2) * (1.0f / DM) + NORM_EPS);
#pragma unroll
            for (int j = 0; j < 8; ++j) {
                const f32x4 gv = gpr[j];
                u32x2 w; w.x = pk2(v[j][0] * rstd2 * gv[0], v[j][1] * rstd2 * gv[1]); w.y = pk2(v[j][2] * rstd2 * gv[2], v[j][3] * rstd2 * gv[3]);
                *((u32x2*)(XN + (size_t)m * DM) + lane + 64 * j) = w;
            }
        }
    }
}

constexpr int KSTR = 272;
constexpr int VSTR = 144;
constexpr int KBUF = 64 * KSTR;
constexpr int VBUF = 128 * VSTR;
constexpr int L_K0 = 0, L_V0 = 2 * KBUF, L_CUM = L_V0 + 2 * VBUF  , L_STAT = L_CUM + 8192  , L_WT = L_STAT + 1024  ;

struct KRegs { u32x4 a, b; };
struct VRegs { u32x4 a, b; };

__device__ __forceinline__ KRegs k_load(const bf16_t* base  , int tid) {
    const bf16_t* p = base + (size_t)(tid >> 3) * NP + (tid & 7) * 16;
    KRegs r; r.a = *(const u32x4*)p; r.b = *(const u32x4*)(p + 8); return r;
}
__device__ __forceinline__ void k_store(LAS unsigned char* buf, const KRegs& r, int tid) {
    LAS unsigned char* d = buf + (tid >> 3) * KSTR + (tid & 7) * 32;
    *(LAS u32x4*)d = r.a; *(LAS u32x4*)(d + 16) = r.b;
}
__device__ __forceinline__ void v_map(int tid, int& chunk, int& pair) { const int w = tid >> 6, l = tid & 63; chunk = 4 * (w & 3) + (l & 3); pair = 16 * (w >> 2) + (l >> 2); }
__device__ __forceinline__ VRegs v_load(const bf16_t* base, int tid) {
    int chunk, pair; v_map(tid, chunk, pair);
    const bf16_t* p = base + (size_t)(2 * pair) * NP + chunk * 8;
    VRegs r; r.a = *(const u32x4*)p; r.b = *(const u32x4*)(p + NP); return r;
}
__device__ __forceinline__ void v_store_words(LAS unsigned char* buf, const unsigned (&wa)[4], const unsigned (&wb)[4], int tid) {
    int chunk, pair; v_map(tid, chunk, pair);
    LAS unsigned char* d = buf + (8 * chunk) * VSTR + pair * 4;
#pragma unroll
    for (int i = 0; i < 4; ++i) {
        *(LAS unsigned*)(d + (2 * i) * VSTR) = (wa[i] & 0xffffu) | (wb[i] << 16);
        *(LAS unsigned*)(d + (2 * i + 1) * VSTR) = (wa[i] >> 16) | (wb[i] & 0xffff0000u);
    }
}
__device__ __forceinline__ void v_store(LAS unsigned char* buf, const VRegs& r, int tid) {
    const unsigned wa[4] = {r.a.x, r.a.y, r.a.z, r.a.w}, wb[4] = {r.b.x, r.b.y, r.b.z, r.b.w};
    v_store_words(buf, wa, wb, tid);
}

__device__ __forceinline__ void pv_mma(f32x4 (&o)[8], const LAS unsigned char* vbuf, const bf16x8 (&pf)[2], int lane) {
    const LAS unsigned char* vp = vbuf + (lane & 15) * VSTR + (lane >> 4) * 16;
#pragma unroll
    for (int mb = 0; mb < 8; ++mb)
#pragma unroll
        for (int pr = 0; pr < 2; ++pr) {
            const bf16x8 vf = *(const LAS bf16x8*)(vp + mb * 16 * VSTR + pr * 64);
            o[mb] = __builtin_amdgcn_mfma_f32_16x16x32_bf16(vf, pf[pr], o[mb], 0, 0, 0);
        }
}

__device__ __forceinline__ void softmax_tile(f32x4 (&s)[4], const f32x4 (&add)[4], float cs, float& lsum, bf16x8 (&pf)[2]) {
    float ps = 0.f;
#pragma unroll
    for (int rb = 0; rb < 4; ++rb)
#pragma unroll
        for (int j = 0; j < 4; ++j) { s[rb][j] = __builtin_amdgcn_exp2f(fminf(fmaf(s[rb][j], cs, add[rb][j]), 126.f)); ps += s[rb][j]; }
    lsum += ps;
#pragma unroll
    for (int pr = 0; pr < 2; ++pr) {
        u32x4 w; w.x = pg8::cvt_pk_bf16(s[2 * pr][0], s[2 * pr][1]); w.y = pg8::cvt_pk_bf16(s[2 * pr][2], s[2 * pr][3]); w.z = pg8::cvt_pk_bf16(s[2 * pr + 1][0], s[2 * pr + 1][1]); w.w = pg8::cvt_pk_bf16(s[2 * pr + 1][2], s[2 * pr + 1][3]);
        pf[pr] = __builtin_bit_cast(bf16x8, w);
    }
}

template <bool DIFF>
__device__ __forceinline__ void attn_unit(const Args& a, int layer, int bh, int qb, LAS unsigned char* lds, int tid) {
    const int wave = tid >> 6, lane = tid & 63, l15 = lane & 15, quad = lane >> 4;
    const int b = bh >> 2, h = bh & 3;
    const bf16_t* proj = (const bf16_t*)(a.ws + WS_PROJ) + (size_t)b * SEQ * NP;
    const bf16_t* Qg = proj + (DIFF ? P_BQ : P_CQ) + h * 128;
    const bf16_t* Kg = proj + (DIFF ? P_BK : P_CK) + h * 128;
    const bf16_t* Vg = proj + (DIFF ? P_BV : P_CV) + h * 128;
    const int q0 = qb * 128, ntiles = 2 * qb + 2;
    __syncthreads();
    KRegs kr = k_load(Kg, tid); VRegs vr = v_load(Vg, tid);
    { KRegs r0 = k_load(Qg + (size_t)q0 * NP, tid), r1 = k_load(Qg + (size_t)(q0 + 64) * NP, tid);
      k_store(lds + L_K0, r0, tid); k_store(lds + L_K0 + KBUF, r1, tid); }
    if (!DIFF) {
        const float* fl = (const float*)(a.ws + WS_FLOG) + (size_t)b * SEQ * 4 + h;
        const int nk = q0 + 128;
        float v[4];
#pragma unroll
        for (int i = 0; i < 4; ++i) {
            const int k = 4 * tid + i;
            float z = (k < nk) ? fl[(size_t)k * 4] : 0.f;
            float ls = fminf(z, 0.f) - log1pf(expf(-fabsf(z)));
            v[i] = (k < nk) ? ls : 0.f;
        }
        const float s0 = v[0], s1 = s0 + v[1], s2 = s1 + v[2], s3 = s2 + v[3];
        float x = s3;
#pragma unroll
        for (int d = 1; d < 64; d <<= 1) { const float y = __shfl_up(x, d); if (lane >= d) x += y; }
        LAS float* wt = (LAS float*)(lds + L_WT);
        if (lane == 63) wt[wave] = x;
        __syncthreads();
        float off = 0.f;
#pragma unroll
        for (int w = 0; w < 8; ++w) off += (w < wave) ? wt[w] : 0.f;
        const float ex = off + x - s3;
        LAS f32x4* cum = (LAS f32x4*)(lds + L_CUM);
        cum[tid] = (f32x4){(ex + s0) * LOG2E, (ex + s1) * LOG2E, (ex + s2) * LOG2E, (ex + s3) * LOG2E};
    }
    __syncthreads();
    bf16x8 qf[4];
    {
        const LAS unsigned char* qp = lds + L_K0 + (wave * 16 + l15) * KSTR + quad * 16;
#pragma unroll
        for (int ks = 0; ks < 4; ++ks) qf[ks] = *(const LAS bf16x8*)(qp + ks * 64);
    }
    __syncthreads();

    constexpr int NMAP = DIFF ? 2 : 1;
    const float cs = (DIFF ? 0.125f : 0.08838834764831845f) * LOG2E;
    f32x4 o[NMAP][8]; float lsum[NMAP];
#pragma unroll
    for (int mp = 0; mp < NMAP; ++mp) { lsum[mp] = 0.f;
#pragma unroll
        for (int mb = 0; mb < 8; ++mb) o[mp][mb] = (f32x4){0.f, 0.f, 0.f, 0.f}; }
    const int qi = q0 + wave * 16 + l15;
    float cumq = 0.f; if (!DIFF) cumq = *(const LAS float*)(lds + L_CUM + qi * 4);

    for (int jt = 0; jt < ntiles; ++jt) {
        LAS unsigned char* kb = lds + L_K0 + (jt & 1) * KBUF;
        LAS unsigned char* vb = lds + L_V0 + (jt & 1) * VBUF;
        k_store(kb, kr, tid); v_store(vb, vr, tid);
        __syncthreads();
        if (jt + 1 < ntiles) { kr = k_load(Kg + (size_t)(jt + 1) * 64 * NP, tid); vr = v_load(Vg + (size_t)(jt + 1) * 64 * NP, tid); }
        f32x4 s[NMAP][4];
        {
            bf16x8 kf[4][4];
#pragma unroll
            for (int rb = 0; rb < 4; ++rb) {
                const int trow = 32 * (rb >> 1) + 8 * (l15 >> 2) + 4 * (rb & 1) + (l15 & 3);
                const LAS unsigned char* kp = kb + trow * KSTR + quad * 16;
#pragma unroll
                for (int ks = 0; ks < 4; ++ks) kf[rb][ks] = *(const LAS bf16x8*)(kp + ks * 64);
            }
            __builtin_amdgcn_sched_barrier(0);
#pragma unroll
            for (int rb = 0; rb < 4; ++rb) {
                if (DIFF) {
                    f32x4 c0 = (f32x4){0.f, 0.f, 0.f, 0.f}, c1 = c0;
                    c0 = __builtin_amdgcn_mfma_f32_16x16x32_bf16(kf[rb][0], qf[0], c0, 0, 0, 0);
                    c0 = __builtin_amdgcn_mfma_f32_16x16x32_bf16(kf[rb][1], qf[1], c0, 0, 0, 0);
                    c1 = __builtin_amdgcn_mfma_f32_16x16x32_bf16(kf[rb][2], qf[2], c1, 0, 0, 0);
                    c1 = __builtin_amdgcn_mfma_f32_16x16x32_bf16(kf[rb][3], qf[3], c1, 0, 0, 0);
                    s[0][rb] = c0; s[NMAP - 1][rb] = c1;
                } else {
                    f32x4 c0 = (f32x4){0.f, 0.f, 0.f, 0.f};
#pragma unroll
                    for (int ks = 0; ks < 4; ++ks) c0 = __builtin_amdgcn_mfma_f32_16x16x32_bf16(kf[rb][ks], qf[ks], c0, 0, 0, 0);
                    s[0][rb] = c0;
                }
            }
        }
        bf16x8 vf[8][2];
        {
            const LAS unsigned char* vp = vb + l15 * VSTR + quad * 16;
#pragma unroll
            for (int mb = 0; mb < 8; ++mb)
#pragma unroll
                for (int pr = 0; pr < 2; ++pr) vf[mb][pr] = *(const LAS bf16x8*)(vp + mb * 16 * VSTR + pr * 64);
        }
        __builtin_amdgcn_sched_barrier(0);
        f32x4 addv[4];
#pragma unroll
        for (int rb = 0; rb < 4; ++rb) {
            const int key0 = jt * 64 + 32 * (rb >> 1) + 8 * quad + 4 * (rb & 1);
            if (!DIFF) addv[rb] = cumq - *(const LAS f32x4*)(lds + L_CUM + key0 * 4);
            else addv[rb] = (f32x4){0.f, 0.f, 0.f, 0.f};
        }
        if (jt >= 2 * qb) {
#pragma unroll
            for (int rb = 0; rb < 4; ++rb) {
                const int key0 = jt * 64 + 32 * (rb >> 1) + 8 * quad + 4 * (rb & 1);
#pragma unroll
                for (int mp = 0; mp < NMAP; ++mp)
#pragma unroll
                    for (int j = 0; j < 4; ++j) s[mp][rb][j] = (key0 + j > qi) ? -INFINITY : s[mp][rb][j];
            }
        }
        bf16x8 pf[NMAP][2];
#pragma unroll
        for (int mp = 0; mp < NMAP; ++mp) softmax_tile(s[mp], addv, cs, lsum[mp], pf[mp]);
#pragma unroll
        for (int mb = 0; mb < 8; ++mb)
#pragma unroll
            for (int pr = 0; pr < 2; ++pr)
#pragma unroll
                for (int mp = 0; mp < NMAP; ++mp) o[mp][mb] = __builtin_amdgcn_mfma_f32_16x16x32_bf16(vf[mb][pr], pf[mp][pr], o[mp][mb], 0, 0, 0);
    }
    float inv[NMAP];
#pragma unroll
    for (int mp = 0; mp < NMAP; ++mp) { float l = lsum[mp]; l += __shfl_xor(l, 16); l += __shfl_xor(l, 32); inv[mp] = 1.0f / l; }
    const size_t orow = (size_t)b * SEQ + qi;
    if (DIFF) {
        const float li = 0.8f - 0.6f * expf(-0.3f * (float)layer);
        const float* lp = a.da_lambda + (size_t)layer * 256;
        float d1 = lp[lane] * lp[64 + lane], d2 = lp[128 + lane] * lp[192 + lane];
        d1 = wave_sum(d1); d2 = wave_sum(d2);
        const float lam = expf(d1) - expf(d2) + li;
        const float c1 = inv[0], c2 = lam * inv[NMAP - 1];
        float ss = 0.f;
#pragma unroll
        for (int mb = 0; mb < 8; ++mb) { o[0][mb] = o[0][mb] * c1 - o[NMAP - 1][mb] * c2; ss += (o[0][mb][0] * o[0][mb][0] + o[0][mb][1] * o[0][mb][1]) + (o[0][mb][2] * o[0][mb][2] + o[0][mb][3] * o[0][mb][3]); }
        ss += __shfl_xor(ss, 16); ss += __shfl_xor(ss, 32);
        const float rstd = (1.0f / sqrtf(ss * (1.0f / 128.0f) + NORM_EPS)) * (1.0f - li);
        const float* sg = a.da_subln_g + (size_t)layer * 128;
        bf16_t* op = (bf16_t*)(a.ws + WS_BR) + orow * DM + 1 * 512 + h * 128 + quad * 4;
        f32x4 sgv[8];
#pragma unroll
        for (int mb = 0; mb < 8; ++mb) sgv[mb] = *(const f32x4*)(sg + mb * 16 + quad * 4);
#pragma unroll
        for (int mb = 0; mb < 8; ++mb) {
            const f32x4 gv = sgv[mb];
            u32x2 w; w.x = pk2(o[0][mb][0] * rstd * gv[0], o[0][mb][1] * rstd * gv[1]); w.y = pk2(o[0][mb][2] * rstd * gv[2], o[0][mb][3] * rstd * gv[3]);
            *(u32x2*)(op + mb * 16) = w;
        }
    } else {
        bf16_t* op = (bf16_t*)(a.ws + WS_BR) + orow * DM + 2 * 512 + h * 128 + quad * 4;
#pragma unroll
        for (int mb = 0; mb < 8; ++mb) {
            const f32x4 v = o[0][mb] * inv[0];
            u32x2 w; w.x = pk2(v[0], v[1]); w.y = pk2(v[2], v[3]);
            *(u32x2*)(op + mb * 16) = w;
        }
    }
}

__device__ __forceinline__ void gmlp_unit(const Args& a, int layer, int unit, LAS unsigned char* lds, int tid) {
    const int wave = tid >> 6, lane = tid & 63, l15 = lane & 15, quad = lane >> 4;
    const int g = unit & 3, bn = unit >> 2;
    const size_t r0 = (size_t)bn * 128;
    const bf16_t* proj = (const bf16_t*)(a.ws + WS_PROJ) + r0 * NP;
    __syncthreads();
    LAS float* stat = (LAS float*)(lds + L_STAT);
    {
        const int t = wave * 16 + (lane >> 2), part = lane & 3;
        const bf16_t* vp = proj + (size_t)t * NP + P_AV + part * 128;
        u32x4 w[16];
#pragma unroll
        for (int j = 0; j < 16; ++j) w[j] = *(const u32x4*)(vp + j * 8);
        float s1 = 0.f, s2 = 0.f;
#pragma unroll
        for (int j = 0; j < 16; ++j) {
            const float f[8] = {bflo(w[j].x), bfhi(w[j].x), bflo(w[j].y), bfhi(w[j].y), bflo(w[j].z), bfhi(w[j].z), bflo(w[j].w), bfhi(w[j].w)};
#pragma unroll
            for (int e = 0; e < 8; ++e) { s1 += f[e]; s2 += f[e] * f[e]; }
        }
        s1 += __shfl_xor(s1, 1); s1 += __shfl_xor(s1, 2); s2 += __shfl_xor(s2, 1); s2 += __shfl_xor(s2, 2);
        const float mu = s1 * (1.0f / 512.0f), var = fmaxf(s2 * (1.0f / 512.0f) - mu * mu, 0.f);
        if (part == 0) { stat[2 * t] = mu; stat[2 * t + 1] = 1.0f / sqrtf(var + NORM_EPS); }
    }
    __syncthreads();
    {
        int chunk, pair; v_map(tid, chunk, pair);
        const float* lg = a.gm_ln_g + (size_t)layer * 512 + g * 128 + chunk * 8;
        const float* lb = a.gm_ln_b + (size_t)layer * 512 + g * 128 + chunk * 8;
        const f32x4 g0 = *(const f32x4*)lg, g1 = *(const f32x4*)(lg + 4), b0 = *(const f32x4*)lb, b1 = *(const f32x4*)(lb + 4);
        const float gg[8] = {g0[0], g0[1], g0[2], g0[3], g1[0], g1[1], g1[2], g1[3]};
        const float bb[8] = {b0[0], b0[1], b0[2], b0[3], b1[0], b1[1], b1[2], b1[3]};
#pragma unroll
        for (int half = 0; half < 2; ++half) {
            const VRegs r = v_load(proj + (size_t)(half * 64) * NP + P_AV + g * 128, tid);
            const int sA = half * 64 + 2 * pair, sB = sA + 1;
            const float muA = stat[2 * sA], rsA = stat[2 * sA + 1], muB = stat[2 * sB], rsB = stat[2 * sB + 1];
            const unsigned ra[4] = {r.a.x, r.a.y, r.a.z, r.a.w}, rb[4] = {r.b.x, r.b.y, r.b.z, r.b.w};
            unsigned wa[4], wb[4];
#pragma unroll
            for (int i = 0; i < 4; ++i) {
                wa[i] = pk2((bflo(ra[i]) - muA) * rsA * gg[2 * i] + bb[2 * i], (bfhi(ra[i]) - muA) * rsA * gg[2 * i + 1] + bb[2 * i + 1]);
                wb[i] = pk2((bflo(rb[i]) - muB) * rsB * gg[2 * i] + bb[2 * i], (bfhi(rb[i]) - muB) * rsB * gg[2 * i + 1] + bb[2 * i + 1]);
            }
            v_store_words(lds + L_V0 + half * VBUF, wa, wb, tid);
        }
    }
    __syncthreads();
    const int t = wave * 16 + l15;
    const float* W = a.gm_w_s + ((size_t)layer * 4 + g) * 128 * 128 + (size_t)t * 128;
    f32x4 o[8];
#pragma unroll
    for (int mb = 0; mb < 8; ++mb) o[mb] = (f32x4){0.f, 0.f, 0.f, 0.f};
#pragma unroll
    for (int st = 0; st < 2; ++st) {
        if (st * 64 <= wave * 16 + 15) {
            bf16x8 pf[2];
#pragma unroll
            for (int pr = 0; pr < 2; ++pr) {
                const int sbase = st * 64 + pr * 32 + quad * 8;
                const f32x4 w0 = *(const f32x4*)(W + sbase), w1 = *(const f32x4*)(W + sbase + 4);
                float f[8] = {w0[0], w0[1], w0[2], w0[3], w1[0], w1[1], w1[2], w1[3]};
#pragma unroll
                for (int j = 0; j < 8; ++j) f[j] = (sbase + j <= t) ? f[j] : 0.f;
                u32x4 w; w.x = pk2(f[0], f[1]); w.y = pk2(f[2], f[3]); w.z = pk2(f[4], f[5]); w.w = pk2(f[6], f[7]);
                pf[pr] = __builtin_bit_cast(bf16x8, w);
            }
            pv_mma(o, lds + L_V0 + st * VBUF, pf, lane);
        }
    }
    const float bs = a.gm_b_s[((size_t)layer * 4 + g) * 128 + t];
    const bf16_t* up = proj + (size_t)t * NP + P_AU + g * 128 + quad * 4;
    bf16_t* op = (bf16_t*)(a.ws + WS_BR) + (r0 + t) * DM + g * 128 + quad * 4;
    u32x2 uwv[8];
#pragma unroll
    for (int mb = 0; mb < 8; ++mb) uwv[mb] = *(const u32x2*)(up + mb * 16);
#pragma unroll
    for (int mb = 0; mb < 8; ++mb) {
        const u32x2 uw = uwv[mb];
        u32x2 w; w.x = pk2(bflo(uw.x) * (o[mb][0] + bs), bfhi(uw.x) * (o[mb][1] + bs)); w.y = pk2(bflo(uw.y) * (o[mb][2] + bs), bfhi(uw.y) * (o[mb][3] + bs));
        *(u32x2*)(op + mb * 16) = w;
    }
}

template <int G_>
__device__ __forceinline__ void pool_unit_t(const Args& a, int layer, int unit, int tid) {
    const int wave = tid >> 6, lane = tid & 63, l15 = lane & 15, quad = lane >> 4;
    constexpr int g = G_; const int tile = unit >> 2;
    const int t = wave * 16 + l15;
    const size_t row = (size_t)tile * 128 + t;
    const int tseq = (int)(row & (SEQ - 1));
    constexpr int win = 2 << g;
    const int cnt = (tseq + 1 < win) ? (tseq + 1) : win;
    const float rc = 1.0f / (float)cnt;
    const bf16_t* hp = (const bf16_t*)(a.ws + WS_PROJ) + row * NP + P_DH + g * 128 + quad * 8;
    const bf16_t* wp = (const bf16_t*)(a.ws + WS_W + (size_t)layer * WL_STRIDE + WO_POOL) + (size_t)g * 128 * 128 + (size_t)l15 * 128 + quad * 8;
    f32x4 o[8];
#pragma unroll
    for (int mb = 0; mb < 8; ++mb) o[mb] = (f32x4){0.f, 0.f, 0.f, 0.f};
#pragma unroll
    for (int ks = 0; ks < 4; ++ks) {
        float acc[8] = {0.f, 0.f, 0.f, 0.f, 0.f, 0.f, 0.f, 0.f};
        float self[8];
        u32x4 wv[win];
#pragma unroll
        for (int i = 0; i < win; ++i) wv[i] = (i < cnt) ? *(const u32x4*)(hp - (size_t)i * NP + ks * 32) : (u32x4){0u, 0u, 0u, 0u};
#pragma unroll
        for (int i = 0; i < win; ++i) {
            const u32x4 w = wv[i];
            const float f[8] = {bflo(w.x), bfhi(w.x), bflo(w.y), bfhi(w.y), bflo(w.z), bfhi(w.z), bflo(w.w), bfhi(w.w)};
#pragma unroll
            for (int j = 0; j < 8; ++j) { acc[j] += f[j]; if (i == 0) self[j] = f[j]; }
        }
        asm volatile("" ::: "memory");
        u32x4 pw; pw.x = pk2(acc[0] * rc - self[0], acc[1] * rc - self[1]); pw.y = pk2(acc[2] * rc - self[2], acc[3] * rc - self[3]);
        pw.z = pk2(acc[4] * rc - self[4], acc[5] * rc - self[5]); pw.w = pk2(acc[6] * rc - self[6], acc[7] * rc - self[7]);
        const bf16x8 pf = __builtin_bit_cast(bf16x8, pw);
#pragma unroll
        for (int mb = 0; mb < 8; ++mb) {
            const bf16x8 wf = *(const bf16x8*)(wp + (size_t)mb * 16 * 128 + ks * 32);
            o[mb] = __builtin_amdgcn_mfma_f32_16x16x32_bf16(wf, pf, o[mb], 0, 0, 0);
        }
    }
    const float* sc = a.pool_scale + (size_t)layer * 512 + g * 128 + quad * 4;
    bf16_t* op = (bf16_t*)(a.ws + WS_BR) + row * DM + 3 * 512 + g * 128 + quad * 4;
    f32x4 svv[8];
#pragma unroll
    for (int mb = 0; mb < 8; ++mb) svv[mb] = *(const f32x4*)(sc + mb * 16);
#pragma unroll
    for (int mb = 0; mb < 8; ++mb) {
        const f32x4 sv = svv[mb];
        u32x2 w; w.x = pk2(o[mb][0] * sv[0], o[mb][1] * sv[1]); w.y = pk2(o[mb][2] * sv[2], o[mb][3] * sv[3]);
        *(u32x2*)(op + mb * 16) = w;
    }
}

__device__ __forceinline__ void mixer_phase(const Args& a, int cidx, int layer, LAS unsigned char* lds, int tid_) {
    int tid = tid_; asm volatile("" : "+v"(tid));
    unsigned* ctr = (unsigned*)(a.ws + WS_CTL) + 64 * cidx;
    LAS unsigned* slot = (LAS unsigned*)(lds + LDS_MISC);
    {
        const unsigned char* wl = a.ws + WS_W + (size_t)layer * WL_STRIDE;
        pg8::Gemm g{(const bf16_t*)(a.ws + WS_XN), (const bf16_t*)(wl + WO_IN), MROWS, NIN, DM};
        pg8::InOrder S; S.init(MROWS, NIN, (int)gridDim.x, (int)blockIdx.x, gridDim.x == 256 ? 6 : (1 << 30), 1 << 30);
        pg8::EpiIn E{(bf16_t*)(a.ws + WS_PROJ), (float*)(a.ws + WS_FLOG), (const float*)(a.ws + WS_ROT), a.fa_b_f + layer * 4};
        pg8::gemm_phase<pg8::EpiIn, pg8::InOrder>(lds, g, S, E);
    }
    if (tid == 0) slot[0] = atomicAdd(ctr, 1u);
    for (;;) {
        __syncthreads();
        const int idx = (int)slot[0];
        if (idx >= 1024) break;
        unsigned nxt_idx = 0u;
        if (tid == 0) nxt_idx = atomicAdd(ctr, 1u);
        int tu = tid; asm volatile("" : "+v"(tu));
        if (idx < 512) {
            const int qb = 15 - (idx >> 5), r = idx & 31, bh = r & 15;
            if (r < 16) attn_unit<true>(a, layer, bh, qb, lds, tu); else attn_unit<false>(a, layer, bh, qb, lds, tu);
        } else if (idx < 768) gmlp_unit(a, layer, idx - 512, lds, tu);
        else { const int pu = idx - 768; switch (pu & 3) { case 0: pool_unit_t<0>(a, layer, pu, tu); break; case 1: pool_unit_t<1>(a, layer, pu, tu); break; case 2: pool_unit_t<2>(a, layer, pu, tu); break; default: pool_unit_t<3>(a, layer, pu, tu); break; } }
        __syncthreads();
        if (tid == 0) slot[0] = nxt_idx;
    }
}

#define XB_TMO      128
#define XB_XCNT(j)  (256  + 64 * (j))
#define XB_XSUB(j)  (1280 + 64 * (j))
#define XB_XGEN(j)  (2304 + 64 * (j))
#define XB_TOP      3328
#define XB_TOPGEN   3392
#define XCD_BAR_WORDS 3456
#define XB_SPIN_CAP (1u << 22)
__device__ __forceinline__ unsigned xb_ld(unsigned* p)              { return __hip_atomic_load(p, __ATOMIC_RELAXED, __HIP_MEMORY_SCOPE_AGENT); }
__device__ __forceinline__ unsigned xb_add(unsigned* p, unsigned v) { return __hip_atomic_fetch_add(p, v, __ATOMIC_RELAXED, __HIP_MEMORY_SCOPE_AGENT); }
__device__ __forceinline__ unsigned xb_xcc_id() { return (unsigned)__builtin_amdgcn_s_getreg((3 << 11) | 20) & 0xFu; }
#define XB_SPIN(cond, bar) do { unsigned _sp = 0; while (cond) { __builtin_amdgcn_s_sleep(1); \
    if ((++_sp & 255u) == 0u) { if (xb_ld(&(bar)[XB_TMO])) break; if (_sp > XB_SPIN_CAP) { atomicAdd(&(bar)[XB_TMO], 1u); break; } } } } while (0)
struct XcdBarrier { unsigned* bar; unsigned x; volatile LAS unsigned* st; };
__device__ __forceinline__ XcdBarrier xcd_barrier_post(unsigned* bar, volatile LAS unsigned* st) {
    XcdBarrier b; b.bar = bar; b.x = xb_xcc_id(); b.st = st;
    if (threadIdx.x == 0) (void)xb_add(&bar[XB_XCNT(b.x)], 1u);
    return b;
}
__device__ __forceinline__ void xcd_barrier_complete(unsigned* bar, unsigned x, unsigned& nloc, unsigned& nx) {
    const unsigned G = gridDim.x * gridDim.y * gridDim.z;
    unsigned sum, cnt, mine, sp = 0u;
    for (;;) {
        sum = 0u; cnt = 0u; mine = 0u;
#pragma unroll
        for (unsigned j = 0; j < 16; ++j) { const unsigned c = xb_ld(&bar[XB_XCNT(j)]); sum += c; cnt += (c > 0u) ? 1u : 0u; mine = (j == x) ? c : mine; }
        if (sum == G) break;
        __builtin_amdgcn_s_sleep(1);
        if ((++sp & 255u) == 0u) { if (xb_ld(&bar[XB_TMO])) break; if (sp > XB_SPIN_CAP) { atomicAdd(&bar[XB_TMO], 1u); break; } }
    }
    nloc = mine > 0u ? mine : 1u; nx = cnt > 0u ? cnt : 1u;
}
__device__ __forceinline__ void xcd_barrier(const XcdBarrier& b) {
    asm volatile("s_waitcnt vmcnt(0)" ::: "memory");
    __syncthreads();
    if (threadIdx.x == 0) {
        unsigned* bar = b.bar;
        __builtin_amdgcn_s_waitcnt(0);
        unsigned nloc = b.st[0], nx = b.st[1];
        if (nloc == 0u) { xcd_barrier_complete(bar, b.x, nloc, nx); b.st[0] = nloc; b.st[1] = nx; }
        const unsigned old = xb_add(&bar[XB_XSUB(b.x)], 1u);
        const unsigned gen = old / nloc;
        if (old + 1u == (gen + 1u) * nloc) {
            __builtin_amdgcn_fence(__ATOMIC_RELEASE, "agent");
            asm volatile("s_waitcnt vmcnt(0)" ::: "memory");
            const unsigned og = xb_add(&bar[XB_TOP], 1u);
            const unsigned tg = og / nx;
            if (og + 1u == (tg + 1u) * nx) xb_add(&bar[XB_TOPGEN], 1u);
            else XB_SPIN(xb_ld(&bar[XB_TOPGEN]) == tg, bar);
            __builtin_amdgcn_fence(__ATOMIC_ACQUIRE, "agent");
            xb_add(&bar[XB_XGEN(b.x)], 1u);
            asm volatile("s_waitcnt vmcnt(0)" ::: "memory");
        } else {
            XB_SPIN(xb_ld(&bar[XB_XGEN(b.x)]) == gen, bar);
            __builtin_amdgcn_fence(__ATOMIC_ACQUIRE, "agent");
            asm volatile("s_waitcnt vmcnt(0)" ::: "memory");
        }
    }
    __syncthreads();
}

typedef const __attribute__((address_space(4))) Args* CArgsPtr;
__device__ __forceinline__ Args load_args() {
#if defined(__HIP_DEVICE_COMPILE__)
    CArgsPtr p = (CArgsPtr)__builtin_amdgcn_kernarg_segment_ptr(); asm volatile("" : "+s"(p)); return *p;
#else
    return Args{};
#endif
}

__global__ void __launch_bounds__(512, 2) fwd_kernel(Args a_in) {
    extern __shared__ __attribute__((aligned(16))) unsigned char lds_raw[];
    LAS unsigned char* lds = (LAS unsigned char*)lds_raw;
    cg::grid_group grid = cg::this_grid();
    const int G = gridDim.x;
    unsigned* xbar_words; unsigned xbar_x;
    {
        const Args a = load_args();
        xbar_words = (unsigned*)(a.ws + WS_CTL) + CW_BAR;
        if (threadIdx.x < 2) ((LAS unsigned*)(lds + LDS_MISC + 32))[threadIdx.x] = 0u;
        __syncthreads();
        const XcdBarrier b0 = xcd_barrier_post(xbar_words, (volatile LAS unsigned*)(lds + LDS_MISC + 32));
        xbar_x = b0.x;
    }
#define TIDS() int tid = threadIdx.x; asm volatile("" : "+v"(tid)); const int lane = tid & 63, wave = __builtin_amdgcn_readfirstlane(tid >> 6), gw = blockIdx.x * 8 + wave, NGW = G * 8; (void)lane; (void)gw; (void)NGW
    for (int rep = 0; rep < REP_P0; ++rep) {
        const Args a = load_args(); TIDS();
        phase0(a, lds, gw, NGW, wave, lane);
    }
    grid.sync();
    for (int _r = 1; _r < REP_SYNC; ++_r) grid.sync();

    for (int l = 0; l < DEPTH; ++l) {
        {
            const Args a = load_args();
            const unsigned char* wl = a.ws + WS_W + (size_t)l * WL_STRIDE;
            pg8::Gemm g{(const bf16_t*)(a.ws + WS_XN), (const bf16_t*)(wl + WO_IN), MROWS, NIN, DM}; pg8::InOrder S; S.init(MROWS, NIN, G, (int)blockIdx.x, 0, G == 256 ? 6 : (1 << 30));
            pg8::EpiIn E{(bf16_t*)(a.ws + WS_PROJ), (float*)(a.ws + WS_FLOG), (const float*)(a.ws + WS_ROT), a.fa_b_f + l * 4};
            pg8::gemm_phase<pg8::EpiIn, pg8::InOrder>(lds, g, S, E);
        }
        GSYNC();
        for (int rep = 0; rep < REP_MIX; ++rep) {
            const Args a = load_args();
            mixer_phase(a, l + 2 * rep, l, lds, threadIdx.x);
        }
        GSYNC();
        for (int rep = 0; rep < REP_MERGE; ++rep) {
            const Args a = load_args();
            const unsigned char* wl = a.ws + WS_W + (size_t)l * WL_STRIDE;
            pg8::Gemm g{(const bf16_t*)(a.ws + WS_BR), (const bf16_t*)(wl + WO_BR), MROWS, DM, DM}; pg8::StaticOrder S; S.init(MROWS, DM, G, (int)blockIdx.x);
            pg8::EpiMergeFold E{(const bf16_t*)(a.ws + WS_PROJ) + P_GATE, (bf16_t*)(a.ws + WS_MB)};
            pg8::gemm_phase<pg8::EpiMergeFold, pg8::StaticOrder>(lds, g, S, E);
        }
        GSYNC();
        for (int rep = 0; rep < REP_OUT; ++rep) {
            const Args a = load_args();
            const unsigned char* wl = a.ws + WS_W + (size_t)l * WL_STRIDE;
            pg8::Gemm g{(const bf16_t*)(a.ws + WS_MB), (const bf16_t*)(wl + WO_OUT), MROWS, DM, DM}; pg8::StaticOrder S; S.init(MROWS, DM, G, (int)blockIdx.x);
            pg8::EpiBf<0> E{(bf16_t*)(a.ws + WS_Y), DM};
            pg8::gemm_phase<pg8::EpiBf<0>, pg8::StaticOrder>(lds, g, S, E);
        }
        GSYNC();
        {
            const Args a = load_args(); TIDS();
            if (l == 0) row_phase<false, true>((const bf16_t*)(a.ws + WS_Y), a.x, a.ws + WS_HB, a.n_mix_post + (size_t)l * DM, a.n_ffn_pre + (size_t)l * DM, (bf16_t*)(a.ws + WS_XN), gw, NGW, lane);
            else row_phase<true, true>((const bf16_t*)(a.ws + WS_Y), a.ws + WS_HB, a.ws + WS_HB, a.n_mix_post + (size_t)l * DM, a.n_ffn_pre + (size_t)l * DM, (bf16_t*)(a.ws + WS_XN), gw, NGW, lane);
        }
        GSYNC();
        {
            const Args a = load_args();
            const unsigned char* wl = a.ws + WS_W + (size_t)l * WL_STRIDE;
            pg8::Gemm g{(const bf16_t*)(a.ws + WS_XN), (const bf16_t*)(wl + WO_UP), MROWS, FFN, DM}; pg8::StaticOrder S; S.init(MROWS, FFN, G, (int)blockIdx.x, REP_UP);
            pg8::EpiBf<1> E{(bf16_t*)(a.ws + WS_PROJ), FFN};
            pg8::gemm_phase<pg8::EpiBf<1>, pg8::StaticOrder>(lds, g, S, E);
        }
        GSYNC();
        for (int rep = 0; rep < REP_DN; ++rep) {
            const Args a = load_args();
            const unsigned char* wl = a.ws + WS_W + (size_t)l * WL_STRIDE;
            pg8::Gemm g{(const bf16_t*)(a.ws + WS_PROJ), (const bf16_t*)(wl + WO_DN), MROWS, DM, FFN}; pg8::StaticOrder S; S.init(MROWS, DM, G, (int)blockIdx.x);
            pg8::EpiBf<0> E{(bf16_t*)(a.ws + WS_Y), DM};
            pg8::gemm_phase<pg8::EpiBf<0>, pg8::StaticOrder>(lds, g, S, E);
        }
        GSYNC();
        {
            const Args a = load_args(); TIDS();
            if (l + 1 < DEPTH) row_phase<true, true>((const bf16_t*)(a.ws + WS_Y), a.ws + WS_HB, a.ws + WS_HB, a.n_ffn_post + (size_t)l * DM, a.n_mix_pre + (size_t)(l + 1) * DM, (bf16_t*)(a.ws + WS_XN), gw, NGW, lane);
            else row_phase<true, false>((const bf16_t*)(a.ws + WS_Y), a.ws + WS_HB, a.out, a.n_ffn_post + (size_t)l * DM, nullptr, (bf16_t*)(a.ws + WS_XN), gw, NGW, lane);
        }
        if (l + 1 < DEPTH) GSYNC();
    }
#undef TIDS
}

extern "C" void kernel_launch(void* const* d_in, const int* in_sizes, int n_in, void* d_out, int out_size, void* d_ws, size_t ws_size, hipStream_t stream) {
    static int grid = 0;
    if (grid == 0) {
        if (n_in != 20 || out_size != MROWS * DM || ws_size < WS_END) { fprintf(stderr, "kernel_launch: unexpected shapes (n_in %d out %d ws %zu)\n", n_in, out_size, ws_size); grid = -1; return; }
        int dev = 0, cus = 0, per_cu = 0;
        (void)hipGetDevice(&dev);
        (void)hipDeviceGetAttribute(&cus, hipDeviceAttributeMultiprocessorCount, dev);
        if (hipFuncSetAttribute((const void*)fwd_kernel, hipFuncAttributeMaxDynamicSharedMemorySize, LDS_BYTES) != hipSuccess) { fprintf(stderr, "kernel_launch: hipFuncSetAttribute failed\n"); grid = -1; return; }
        (void)hipOccupancyMaxActiveBlocksPerMultiprocessor(&per_cu, (const void*)fwd_kernel, 512, LDS_BYTES);
        if (per_cu < 1) { fprintf(stderr, "kernel_launch: occupancy query says %d\n", per_cu); per_cu = 1; }
        (void)hipGetLastError();
        grid = cus;
        if (grid > 256) grid = 256;
    }
    if (grid < 0) return;
    (void)hipMemsetAsync((char*)d_ws + WS_CTL, 0, CTL_BYTES, stream);
    Args a{};
    a.x = (const float*)d_in[0]; a.pos = (const int*)d_in[1];
    a.n_mix_pre = (const float*)d_in[2]; a.n_mix_post = (const float*)d_in[3]; a.n_ffn_pre = (const float*)d_in[4]; a.n_ffn_post = (const float*)d_in[5];
    a.w_in = (const float*)d_in[6]; a.gm_ln_g = (const float*)d_in[7]; a.gm_ln_b = (const float*)d_in[8]; a.gm_w_s = (const float*)d_in[9]; a.gm_b_s = (const float*)d_in[10];
    a.da_lambda = (const float*)d_in[11]; a.da_subln_g = (const float*)d_in[12]; a.fa_b_f = (const float*)d_in[13]; a.pool_w = (const float*)d_in[14]; a.pool_scale = (const float*)d_in[15];
    a.w_branch = (const float*)d_in[16]; a.w_out = (const float*)d_in[17]; a.w_ffn_up = (const float*)d_in[18]; a.w_ffn_down = (const float*)d_in[19];
    a.out = (float*)d_out; a.ws = (unsigned char*)d_ws;
    void* args[] = {&a};
    hipError_t e = hipLaunchCooperativeKernel((const void*)fwd_kernel, dim3(grid), dim3(512), args, LDS_BYTES, stream);
    if (e != hipSuccess) fprintf(stderr, "cooperative launch failed: %s (grid %d)\n", hipGetErrorString(e), grid);
}
```

```cpp
#include <hip/hip_runtime.h>
#include <hip/hip_cooperative_groups.h>
#include <cstdio>
#include <cstdint>
namespace cg = cooperative_groups;
#ifndef REP_P0
#define REP_P0 1
#endif
#ifndef REP_IN
#define REP_IN 1
#endif
#ifndef REP_MIX
#define REP_MIX 1
#endif
#ifndef REP_MERGE
#define REP_MERGE 1
#endif
#ifndef REP_OUT
#define REP_OUT 1
#endif
#ifndef REP_UP
#define REP_UP 1
#endif
#ifndef REP_DN
#define REP_DN 1
#endif
#ifndef REP_ROW
#define REP_ROW 1
#endif
#ifndef REP_SYNC
#define REP_SYNC 1
#endif
#ifndef USE_CG_SYNC
#define USE_CG_SYNC 0
#endif
#define GSYNC() do { for (int _r = 0; _r < REP_SYNC; ++_r) { if (USE_CG_SYNC) grid.sync(); else { XcdBarrier _b; _b.bar = xbar_words; _b.x = xbar_x; _b.st = (volatile LAS unsigned*)(lds + LDS_MISC + 32); xcd_barrier(_b); } } } while (0)

#define LAS __attribute__((address_space(3)))
typedef unsigned short bf16_t;
typedef short bf16x8 __attribute__((ext_vector_type(8)));
typedef float f32x4 __attribute__((ext_vector_type(4)));
typedef unsigned u32x4 __attribute__((ext_vector_type(4)));
typedef unsigned u32x2 __attribute__((ext_vector_type(2)));

constexpr int DM = 2048, NBATCH = 4, SEQ = 2048, MROWS = NBATCH * SEQ, DEPTH = 2;
constexpr int INC = 12804;
constexpr int NP = 12800;
constexpr int NIN = 13056;
constexpr int FFN = 8192;
constexpr int P_AU = 0, P_AV = 512, P_BQ = 1024, P_BK = 1536, P_BV = 2048, P_CQ = 2560, P_CK = 3072, P_CV = 3584, P_DH = 4096, P_GATE = 4608;
constexpr float NORM_EPS = 1e-6f;
constexpr float LOG2E = 1.4426950408889634f;

constexpr size_t MiB = 1u << 20;
constexpr size_t WS_CTL = 0, CTL_BYTES = 65536;
constexpr int CW_BAR = 4096;
constexpr size_t WS_W = 1 * MiB, WL_STRIDE = 132 * MiB;
constexpr size_t WO_IN = 0, WO_BR = 51 * MiB, WO_OUT = 59 * MiB, WO_UP = 67 * MiB, WO_DN = 99 * MiB, WO_POOL = 131 * MiB;
constexpr size_t WS_PROJ = 266 * MiB;
constexpr size_t WS_XN = 466 * MiB;
constexpr size_t WS_BR = 498 * MiB;
constexpr size_t WS_MB = 530 * MiB;
constexpr size_t WS_Y = 562 * MiB;
constexpr size_t WS_FLOG = 626 * MiB;
constexpr size_t WS_ROT = 627 * MiB;
constexpr size_t WS_HB = 628 * MiB;
constexpr size_t WS_END = 660 * MiB;

constexpr int LDS_BYTES = 139264;
constexpr int LDS_MISC = 135168;

__device__ __forceinline__ unsigned f2bf(float f) { unsigned u = __builtin_bit_cast(unsigned, f); return (u + 0x7fffu + ((u >> 16) & 1u)) >> 16; }
__device__ __forceinline__ unsigned pk2(float lo, float hi) { return f2bf(lo) | (f2bf(hi) << 16); }
__device__ __forceinline__ float bflo(unsigned w) { return __builtin_bit_cast(float, w << 16); }
__device__ __forceinline__ float bfhi(unsigned w) { return __builtin_bit_cast(float, w & 0xffff0000u); }
__device__ __forceinline__ float wave_sum(float v) {
#pragma unroll
    for (int o = 1; o < 64; o <<= 1) v += __shfl_xor(v, o);
    return v;
}
#define LDS_WAIT() asm volatile("s_waitcnt lgkmcnt(0)" ::: "memory")

namespace pg8 {
constexpr int BM = 256, BK = 64, HALF = 128, HTB = HALF * BK * 2, STAGE_BYTES = 8 * HTB, NXCD = 8, WGM = 8;
__host__ __device__ __forceinline__ int lds_byte(int r, int c) { const int st = (r >> 4) * 2 + (c >> 5), rr = r & 15, cc = c & 31, ob = rr * 64 + cc * 2; return st * 1024 + (ob ^ (((ob >> 9) & 1) << 5)); }
__host__ __device__ __forceinline__ void stage_rc(int b, int& R, int& C) { const int st = b / 1024, sb = b % 1024, swz = sb ^ (((sb >> 9) & 1) << 5); R = (st >> 1) * 16 + swz / 64; C = (st & 1) * 32 + (swz % 64) / 2; }
__host__ __device__ __forceinline__ int perm32(int rho) { const int n = rho >> 4, i = rho & 15; return 8 * (i >> 2) + 4 * n + (i & 3); }

struct Unit { int pm, pn; };
struct Gemm { const bf16_t* A; const bf16_t* Bt; int M, N, K; };

struct StaticOrder {
    int nM, nN, nwg, G, c, nrep;
    __device__ void init(int M, int N, int G_, int c_, int nrep_ = 1) { nM = M / BM; nN = N / BM; nwg = nM * nN; G = G_; c = c_; nrep = nrep_; asm volatile("" : "+s"(c), "+s"(G)); }
    __device__ bool next(int i, Unit& u) const {
        long L = (long)i * G + c; if (L >= (long)nwg * nrep) return false;
        if (nrep > 1) L %= nwg;
        int wgid = (int)L; { const int q = nwg / NXCD, r = nwg % NXCD, xcd = wgid % NXCD, off = wgid / NXCD; wgid = (xcd < r ? xcd * (q + 1) : r * (q + 1) + (xcd - r) * q) + off; }
        const int nig = WGM * nN, gid = wgid / nig, fm = gid * WGM, gsz = (nM - fm) < WGM ? (nM - fm) : WGM;
        u.pm = fm + ((wgid % nig) % gsz); u.pn = (wgid % nig) / gsz; return true;
    }
};

struct InOrder : StaticOrder {
    int i0, i1;
    __device__ void init(int M, int N, int G_, int c_, int i0_, int i1_) { StaticOrder::init(M, N, G_, c_, 1); i0 = i0_; i1 = i1_; }
    __device__ bool next(int i, Unit& u) const {
        if (i + i0 >= i1) return false;
        const bool ok = StaticOrder::next(i + i0, u);
        if (ok) u.pn = (u.pn == 0) ? 50 : u.pn - 1;
        return ok;
    }
};
__device__ __forceinline__ unsigned cvt_pk_bf16(float lo, float hi) { unsigned r; asm volatile("v_cvt_pk_bf16_f32 %0, %1, %2" : "=v"(r) : "v"(lo), "v"(hi)); return r; }


struct EpiIn {
    static constexpr bool PERM = true, FOLD = false;
    bf16_t* O; float* flog; const float* rot; const float* bfv;
    __device__ __forceinline__ void operator()(const f32x4 (&acc)[2][2][4][2], const Unit& u, int wr, int wc, int fr, int fq) const {
        const int row0 = u.pm * BM + wr * 64 + fr;
        if (u.pn == 50) {
            if (wc == 0 && fq == 0) {
                const f32x4 b = *(const f32x4*)bfv;
#pragma unroll
                for (int ai = 0; ai < 2; ++ai)
#pragma unroll
                    for (int m = 0; m < 4; ++m) *(f32x4*)(flog + (size_t)(row0 + ai * HALF + m * 16) * 4) = acc[ai][0][m][0] + b;
            }
            return;
        }
        const int col0 = u.pn * BM + wc * 32 + 8 * fq;
        const bool sig = u.pn >= 18;
        const bool rotary = (u.pn >= 4) && (u.pn < 8) && ((wc & 1) == 0);
        const float sg = (fq == 0) ? -1.f : 1.f;
#pragma unroll
        for (int ai = 0; ai < 2; ++ai)
#pragma unroll
            for (int m = 0; m < 4; ++m) {
                const int row = row0 + ai * HALF + m * 16;
                bf16_t* rowp = O + (size_t)row * NP + col0;
                f32x4 v[2][2];
#pragma unroll
                for (int bj = 0; bj < 2; ++bj) { v[bj][0] = acc[ai][bj][m][0]; v[bj][1] = acc[ai][bj][m][1]; }
                if (rotary) {
                    const f32x4* rp = (const f32x4*)(rot + (size_t)row * 16);
#pragma unroll
                    for (int n = 0; n < 2; ++n) {
                        const f32x4 ca = rp[2 * n], cb = rp[2 * n + 1];
                        const float cc[4] = {ca[0], ca[2], cb[0], cb[2]};
                        const float ss[4] = {ca[1] * sg, ca[3] * sg, cb[1] * sg, cb[3] * sg};
#pragma unroll
                        for (int bj = 0; bj < 2; ++bj)
#pragma unroll
                            for (int j = 0; j < 4; ++j) {
                                const float own = v[bj][n][j];
                                const float par = __shfl_xor(own, 16);
                                const float nv = own * cc[j] + par * ss[j];
                                v[bj][n][j] = (fq < 2) ? nv : own;
                            }
                    }
                    asm volatile("" ::: "memory");
                }
#pragma unroll
                for (int bj = 0; bj < 2; ++bj) {
                    f32x4 v0 = v[bj][0], v1 = v[bj][1];
                    if (sig) {
#pragma unroll
                        for (int j = 0; j < 4; ++j) {
                            v0[j] = __builtin_amdgcn_rcpf(1.0f + __builtin_amdgcn_exp2f(v0[j]));
                            v1[j] = __builtin_amdgcn_rcpf(1.0f + __builtin_amdgcn_exp2f(v1[j]));
                        }
                    }
                    u32x4 w; w.x = cvt_pk_bf16(v0[0], v0[1]); w.y = cvt_pk_bf16(v0[2], v0[3]); w.z = cvt_pk_bf16(v1[0], v1[1]); w.w = cvt_pk_bf16(v1[2], v1[3]);
                    *(u32x4*)(rowp + bj * HALF) = w;
                }
            }
    }
};
template <int ACT> struct EpiBf {
    static constexpr bool PERM = true, FOLD = false;
    bf16_t* O; int ldc;
    __device__ __forceinline__ void operator()(const f32x4 (&acc)[2][2][4][2], const Unit& u, int wr, int wc, int fr, int fq) const {
        const int row0 = u.pm * BM + wr * 64 + fr, col0 = u.pn * BM + wc * 32 + 8 * fq;
#pragma unroll
        for (int ai = 0; ai < 2; ++ai)
#pragma unroll
            for (int m = 0; m < 4; ++m) {
                bf16_t* rowp = O + (size_t)(row0 + ai * HALF + m * 16) * ldc + col0;
#pragma unroll
                for (int bj = 0; bj < 2; ++bj) {
                    f32x4 v0 = acc[ai][bj][m][0], v1 = acc[ai][bj][m][1];
#pragma unroll
                    for (int j = 0; j < 4; ++j) { if (ACT == 1) { const float a = fmaxf(v0[j], 0.f), b = fmaxf(v1[j], 0.f); v0[j] = a * a; v1[j] = b * b; } }
                    u32x4 w; w.x = cvt_pk_bf16(v0[0], v0[1]); w.y = cvt_pk_bf16(v0[2], v0[3]); w.z = cvt_pk_bf16(v1[0], v1[1]); w.w = cvt_pk_bf16(v1[2], v1[3]);
                    *(u32x4*)(rowp + bj * HALF) = w;
                }
            }
    }
};
struct EpiF32 {
    static constexpr bool PERM = false, FOLD = false;
    float* C; int ldc;
    __device__ __forceinline__ void operator()(const f32x4 (&acc)[2][2][4][2], const Unit& u, int wr, int wc, int fr, int fq) const {
        const int row0 = u.pm * BM + wr * 64 + fr, col0 = u.pn * BM + wc * 32 + 4 * fq;
#pragma unroll
        for (int ai = 0; ai < 2; ++ai)
#pragma unroll
            for (int m = 0; m < 4; ++m) {
                float* rowp = C + (size_t)(row0 + ai * HALF + m * 16) * ldc + col0;
#pragma unroll
                for (int bj = 0; bj < 2; ++bj)
#pragma unroll
                    for (int n = 0; n < 2; ++n) *(f32x4*)(rowp + bj * HALF + n * 16) = acc[ai][bj][m][n];
            }
    }
};
struct EpiMergeFold {
    static constexpr bool PERM = true, FOLD = true;
    const bf16_t* gate;
    bf16_t* MBo;
    static __device__ __forceinline__ void unpack8(const u32x4 w, float (&f)[8]) {
        f[0] = bflo(w.x); f[1] = bfhi(w.x); f[2] = bflo(w.y); f[3] = bfhi(w.y); f[4] = bflo(w.z); f[5] = bfhi(w.z); f[6] = bflo(w.w); f[7] = bfhi(w.w);
#pragma unroll
        for (int j = 0; j < 8; ++j) f[j] = fmaxf(f[j], 1e-30f);
    }
    static __device__ __forceinline__ float ratio(float n, float d) { return fmaxf(n, 1e-30f) * __builtin_amdgcn_rcpf(fmaxf(d, 1e-30f)); }
    __device__ __forceinline__ void fold(f32x4 (&acc)[2][2][4][2], const Unit& u, int nb, int wr, int wc, int fr, int fq) const {
        const bf16_t* gbase = gate + (size_t)(u.pm * BM + wr * 64 + fr) * NP + (size_t)nb * DM + (u.pn * BM + wc * 32 + 8 * fq);
#pragma unroll
        for (int ai = 0; ai < 2; ++ai) {
            u32x4 wn[4][2], wd[4][2];
#pragma unroll
            for (int m = 0; m < 4; ++m)
#pragma unroll
                for (int bj = 0; bj < 2; ++bj) {
                    const bf16_t* gp = gbase + (size_t)(ai * HALF + m * 16) * NP + bj * HALF;
                    wn[m][bj] = *(const u32x4*)(gp - DM);
                    wd[m][bj] = *(const u32x4*)gp;
                }
#pragma unroll
            for (int m = 0; m < 4; ++m)
#pragma unroll
                for (int bj = 0; bj < 2; ++bj) {
                    const u32x4 a = wn[m][bj], d = wd[m][bj];
                    f32x4 r0, r1;
                    r0[0] = ratio(bflo(a.x), bflo(d.x)); r0[1] = ratio(bfhi(a.x), bfhi(d.x)); r0[2] = ratio(bflo(a.y), bflo(d.y)); r0[3] = ratio(bfhi(a.y), bfhi(d.y));
                    r1[0] = ratio(bflo(a.z), bflo(d.z)); r1[1] = ratio(bfhi(a.z), bfhi(d.z)); r1[2] = ratio(bflo(a.w), bflo(d.w)); r1[3] = ratio(bfhi(a.w), bfhi(d.w));
                    acc[ai][bj][m][0] *= r0; acc[ai][bj][m][1] *= r1;
                }
            asm volatile("" ::: "memory");
        }
    }
    __device__ __forceinline__ void operator()(const f32x4 (&acc)[2][2][4][2], const Unit& u, int wr, int wc, int fr, int fq) const {
        const int row0 = u.pm * BM + wr * 64 + fr, col0 = u.pn * BM + wc * 32 + 8 * fq;
        u32x4 gw[2][4][2];
#pragma unroll
        for (int ai = 0; ai < 2; ++ai)
#pragma unroll
            for (int m = 0; m < 4; ++m)
#pragma unroll
                for (int bj = 0; bj < 2; ++bj) gw[ai][m][bj] = *(const u32x4*)(gate + (size_t)(row0 + ai * HALF + m * 16) * NP + (size_t)3 * DM + col0 + bj * HALF);
#pragma unroll
        for (int ai = 0; ai < 2; ++ai)
#pragma unroll
            for (int m = 0; m < 4; ++m) {
                bf16_t* rowp = MBo + (size_t)(row0 + ai * HALF + m * 16) * DM + col0;
#pragma unroll
                for (int bj = 0; bj < 2; ++bj) {
                    float g[8]; unpack8(gw[ai][m][bj], g);
                    const f32x4 v0 = acc[ai][bj][m][0], v1 = acc[ai][bj][m][1];
                    u32x4 w; w.x = cvt_pk_bf16(v0[0] * g[0], v0[1] * g[1]); w.y = cvt_pk_bf16(v0[2] * g[2], v0[3] * g[3]); w.z = cvt_pk_bf16(v1[0] * g[4], v1[1] * g[5]); w.w = cvt_pk_bf16(v1[2] * g[6], v1[3] * g[7]);
                    *(u32x4*)(rowp + bj * HALF) = w;
                }
            }
    }
};

template <class Epi, class Sched, bool ALIGN_EPI = true, bool SP2 = true>
__device__ __forceinline__ void gemm_phase(LAS unsigned char* lds, const Gemm g, const Sched& S, const Epi& E) {
    int tid = threadIdx.x; asm volatile("" : "+v"(tid));
    const int wid = __builtin_amdgcn_readfirstlane(tid >> 6), lane = tid & 63, wr = wid >> 2, wc = wid & 3, fr = lane & 15, fq = lane >> 4;
    const int K = g.K, nt = K / BK;
    unsigned voffA[2], voffB[2];
#pragma unroll
    for (int i = 0; i < 2; ++i) { int R, C; stage_rc(tid * 16 + i * 8192, R, C); const int Rb = Epi::PERM ? ((R & ~31) + perm32(R & 31)) : R;
        voffA[i] = (unsigned)(R * K + C) * 2u; voffB[i] = (unsigned)(Rb * K + C) * 2u; }
    const size_t kstep = (size_t)(BK * 2);
    const size_t hstep = (size_t)HALF * K * 2;
    const size_t tstep = 2 * hstep;
    const unsigned ldsw = (unsigned)wid * 1024u;
    const int aoff = lds_byte(wr * 64 + fr, fq * 8), boff = lds_byte(wc * 32 + fr, fq * 8);
#define PG8_SA(b, h) (((b) * 2 + (h)) * HTB)
#define PG8_SB(b, h) ((4 + (b) * 2 + (h)) * HTB)
#define PG8_STAGE(bufoff, gbase, voff) do { _Pragma("unroll") for (int _i = 0; _i < 2; ++_i) \
        __builtin_amdgcn_global_load_lds((const unsigned*)((const char*)(gbase) + (voff)[_i]), (LAS unsigned*)(lds + (bufoff) + ldsw + _i * 8192), 16, 0, 0); } while (0)
#define PG8_LDA(dst, b, h) do { _Pragma("unroll") for (int m = 0; m < 4; ++m) _Pragma("unroll") for (int k = 0; k < 2; ++k) dst[m][k] = *(const LAS bf16x8*)(lds + PG8_SA(b, h) + aoff + m * 2048 + k * 1024); } while (0)
#define PG8_LDB(dst, b, h) do { _Pragma("unroll") for (int n = 0; n < 2; ++n) _Pragma("unroll") for (int k = 0; k < 2; ++k) dst[n][k] = *(const LAS bf16x8*)(lds + PG8_SB(b, h) + boff + n * 2048 + k * 1024); } while (0)
#define PG8_MMA(ai, bj, At, Bt) do { __builtin_amdgcn_s_setprio(1); _Pragma("unroll") for (int m = 0; m < 4; ++m) _Pragma("unroll") for (int n = 0; n < 2; ++n) _Pragma("unroll") for (int k = 0; k < 2; ++k) \
        acc[ai][bj][m][n] = __builtin_amdgcn_mfma_f32_16x16x32_bf16(Bt[n][k], At[m][k], acc[ai][bj][m][n], 0, 0, 0); __builtin_amdgcn_s_setprio(0); } while (0)
#define PG8_WAIT_V(n) asm volatile("s_waitcnt vmcnt(" #n ")" ::: "memory")
#define PG8_WAIT_L(n) asm volatile("s_waitcnt lgkmcnt(" #n ")" ::: "memory")
#define PG8_BAR __builtin_amdgcn_s_barrier()
#define PG8_SCHED __builtin_amdgcn_sched_barrier(0)
    Unit cur, nxt; int ui = 0;
    if (!S.next(0, cur)) return;
    f32x4 acc[2][2][4][2];
#pragma unroll
    for (int a = 0; a < 2; ++a)
#pragma unroll
        for (int b = 0; b < 2; ++b)
#pragma unroll
            for (int m = 0; m < 4; ++m)
#pragma unroll
                for (int n = 0; n < 2; ++n) acc[a][b][m][n] = (f32x4){0.f, 0.f, 0.f, 0.f};
    bf16x8 At[4][2], B0[2][2], B1[2][2];
    const char* cA = (const char*)g.A + (size_t)cur.pm * tstep; const char* cB = (const char*)g.Bt + (size_t)cur.pn * tstep;
    if constexpr (SP2) {
        PG8_STAGE(PG8_SB(0, 0), cB, voffB); PG8_STAGE(PG8_SB(0, 1), cB + hstep, voffB); PG8_STAGE(PG8_SA(0, 0), cA, voffA); PG8_STAGE(PG8_SA(0, 1), cA + hstep, voffA);
        if (wr == 1) PG8_BAR;
        PG8_WAIT_V(2); PG8_BAR;
        PG8_STAGE(PG8_SB(1, 0), cB + kstep, voffB); PG8_STAGE(PG8_SA(1, 0), cA + kstep, voffA); PG8_STAGE(PG8_SB(1, 1), cB + hstep + kstep, voffB);
        PG8_WAIT_V(6); PG8_BAR;
    } else {
        PG8_STAGE(PG8_SB(0, 0), cB, voffB); PG8_STAGE(PG8_SA(0, 0), cA, voffA); PG8_STAGE(PG8_SB(0, 1), cB + hstep, voffB); PG8_STAGE(PG8_SA(0, 1), cA + hstep, voffA);
        if (wr == 1) PG8_BAR;
        PG8_WAIT_V(4); PG8_BAR;
        PG8_STAGE(PG8_SB(1, 0), cB + kstep, voffB); PG8_STAGE(PG8_SA(1, 0), cA + kstep, voffA); PG8_STAGE(PG8_SB(1, 1), cB + hstep + kstep, voffB);
        PG8_WAIT_V(6); PG8_BAR;
    }
    for (;;) {
        const bool has_next = S.next(ui + 1, nxt);
        const char* nA = has_next ? (const char*)g.A + (size_t)nxt.pm * tstep : cA; const char* nB = has_next ? (const char*)g.Bt + (size_t)nxt.pn * tstep : cB;
        for (int t = 0; t < nt; t += 2) {
            const bool last = (t == nt - 2);
            const char* a1 = cA + (size_t)(t + 1) * kstep;
            const char* a2 = last ? nA : cA + (size_t)(t + 2) * kstep; const char* b2 = last ? nB : cB + (size_t)(t + 2) * kstep;
            const char* a3 = a2 + kstep; const char* b3 = b2 + kstep;
            if constexpr (Epi::FOLD) { if (t > 0 && (t & 7) == 0) E.fold(acc, cur, t >> 3, wr, wc, fr, fq); }
            if constexpr (SP2) {
            PG8_LDB(B0, 0, 0); PG8_LDB(B1, 0, 1); PG8_SCHED; PG8_LDA(At, 0, 0); PG8_STAGE(PG8_SA(1, 1), a1 + hstep, voffA);
            PG8_WAIT_V(8); PG8_WAIT_L(0); PG8_BAR; PG8_MMA(0, 0, At, B0); PG8_MMA(0, 1, At, B1); PG8_BAR; PG8_SCHED;
            PG8_LDA(At, 0, 1); PG8_STAGE(PG8_SB(0, 0), b2, voffB); PG8_STAGE(PG8_SB(0, 1), b2 + hstep, voffB); PG8_STAGE(PG8_SA(0, 0), a2, voffA);
            PG8_WAIT_V(8); PG8_WAIT_L(0); PG8_BAR; PG8_MMA(1, 0, At, B0); PG8_MMA(1, 1, At, B1); PG8_BAR; PG8_SCHED;
            PG8_LDB(B0, 1, 0); PG8_LDB(B1, 1, 1); PG8_SCHED; PG8_LDA(At, 1, 0); PG8_STAGE(PG8_SA(0, 1), a2 + hstep, voffA);
            PG8_WAIT_V(8); PG8_WAIT_L(0); PG8_BAR; PG8_MMA(0, 0, At, B0); PG8_MMA(0, 1, At, B1); PG8_BAR; PG8_SCHED;
            PG8_LDA(At, 1, 1); PG8_STAGE(PG8_SB(1, 0), b3, voffB); PG8_STAGE(PG8_SB(1, 1), b3 + hstep, voffB); PG8_STAGE(PG8_SA(1, 0), a3, voffA);
            PG8_WAIT_V(8); PG8_WAIT_L(0); PG8_BAR; PG8_MMA(1, 0, At, B0); PG8_MMA(1, 1, At, B1); PG8_BAR; PG8_SCHED;
            } else {
            PG8_LDB(B0, 0, 0); PG8_SCHED; PG8_LDA(At, 0, 0); PG8_STAGE(PG8_SA(1, 1), a1 + hstep, voffA);
            PG8_WAIT_L(8); PG8_BAR; PG8_WAIT_L(0); PG8_MMA(0, 0, At, B0); PG8_BAR; PG8_SCHED;
            PG8_LDB(B1, 0, 1); PG8_STAGE(PG8_SB(0, 0), b2, voffB);
            PG8_BAR; PG8_WAIT_L(0); PG8_MMA(0, 1, At, B1); PG8_BAR;
            PG8_LDA(At, 0, 1); PG8_STAGE(PG8_SA(0, 0), a2, voffA);
            PG8_BAR; PG8_WAIT_L(0); PG8_MMA(1, 0, At, B0); PG8_BAR; PG8_SCHED;
            PG8_STAGE(PG8_SB(0, 1), b2 + hstep, voffB);
            PG8_WAIT_V(6); PG8_BAR; PG8_MMA(1, 1, At, B1); PG8_BAR;
            PG8_LDB(B0, 1, 0); PG8_SCHED; PG8_LDA(At, 1, 0); PG8_STAGE(PG8_SA(0, 1), a2 + hstep, voffA);
            PG8_WAIT_L(8); PG8_BAR; PG8_WAIT_L(0); PG8_MMA(0, 0, At, B0); PG8_BAR; PG8_SCHED;
            PG8_LDB(B1, 1, 1); PG8_STAGE(PG8_SB(1, 0), b3, voffB);
            PG8_BAR; PG8_WAIT_L(0); PG8_MMA(0, 1, At, B1); PG8_BAR;
            PG8_LDA(At, 1, 1); PG8_STAGE(PG8_SA(1, 0), a3, voffA);
            PG8_BAR; PG8_WAIT_L(0); PG8_MMA(1, 0, At, B0); PG8_BAR; PG8_SCHED;
            PG8_STAGE(PG8_SB(1, 1), b3 + hstep, voffB);
            PG8_WAIT_V(6); PG8_BAR; PG8_MMA(1, 1, At, B1); PG8_BAR;
            }
        }
        if constexpr (ALIGN_EPI) { if (wr == 0) PG8_BAR; }
        E(acc, cur, wr, wc, fr, fq);
        if (!has_next) break;
#pragma unroll
        for (int a = 0; a < 2; ++a)
#pragma unroll
            for (int b = 0; b < 2; ++b)
#pragma unroll
                for (int m = 0; m < 4; ++m)
#pragma unroll
                    for (int n = 0; n < 2; ++n) acc[a][b][m][n] = (f32x4){0.f, 0.f, 0.f, 0.f};
        cur = nxt; cA = nA; cB = nB; ++ui;
        if constexpr (ALIGN_EPI) { if (wr == 1) PG8_BAR; }
    }
    PG8_WAIT_V(0);
    if constexpr (!ALIGN_EPI) { if (wr == 0) PG8_BAR; }
    PG8_BAR;
#undef PG8_SA
#undef PG8_SB
#undef PG8_STAGE
#undef PG8_LDA
#undef PG8_LDB
#undef PG8_MMA
#undef PG8_WAIT_V
#undef PG8_WAIT_L
#undef PG8_BAR
#undef PG8_SCHED
}
}

struct Args {
    const float* x; const int* pos;
    const float *n_mix_pre, *n_mix_post, *n_ffn_pre, *n_ffn_post, *w_in, *gm_ln_g, *gm_ln_b, *gm_w_s, *gm_b_s, *da_lambda, *da_subln_g, *fa_b_f,
                *pool_w, *pool_scale, *w_branch, *w_out, *w_ffn_up, *w_ffn_down;
    float* out; unsigned char* ws;
};

struct TrDesc { const float* sp; size_t ld; bf16_t* dp; int K; float scale; bool ok; };
__device__ __forceinline__ void tr_load(const TrDesc& d, f32x4 (&v)[16]) {
#pragma unroll
    for (int i = 0; i < 16; ++i) v[i] = d.ok ? __builtin_nontemporal_load((const f32x4*)(d.sp + (size_t)(4 * i) * d.ld)) : (f32x4){0.f, 0.f, 0.f, 0.f};
}
__device__ __forceinline__ void tr_finish(const TrDesc& d, const f32x4 (&v)[16], LAS float* scr, int lane) {
    const int c4 = (lane & 15) * 4, kr = lane >> 4;
#pragma unroll
    for (int i = 0; i < 16; ++i) {
        LAS float* p = scr + (4 * i + kr) * 65 + c4;
        p[0] = v[i][0] * d.scale; p[1] = v[i][1] * d.scale; p[2] = v[i][2] * d.scale; p[3] = v[i][3] * d.scale;
    }
    LDS_WAIT();
    const int c = lane & 7;
#pragma unroll
    for (int j = 0; j < 8; ++j) {
        const int n = (lane >> 3) + 8 * j;
        const LAS float* s = scr + (8 * c) * 65 + n;
        u32x4 o; o.x = pg8::cvt_pk_bf16(s[0], s[65]); o.y = pg8::cvt_pk_bf16(s[2 * 65], s[3 * 65]); o.z = pg8::cvt_pk_bf16(s[4 * 65], s[5 * 65]); o.w = pg8::cvt_pk_bf16(s[6 * 65], s[7 * 65]);
        *(u32x4*)(d.dp + (size_t)n * d.K + 8 * c) = o;
    }
    LDS_WAIT();
}

__device__ __forceinline__ void rms_row_bf16(const float* xrow, const f32x4 (&gv)[8], bf16_t* orow, int lane) {
    f32x4 v[8]; float s = 0.f;
#pragma unroll
    for (int j = 0; j < 8; ++j) { v[j] = *((const f32x4*)xrow + lane + 64 * j); s += (v[j][0] * v[j][0] + v[j][1] * v[j][1]) + (v[j][2] * v[j][2] + v[j][3] * v[j][3]); }
    const float rstd = 1.0f / sqrtf(wave_sum(s) * (1.0f / DM) + NORM_EPS);
#pragma unroll
    for (int j = 0; j < 8; ++j) {
        u32x2 w; w.x = pk2(v[j][0] * rstd * gv[j][0], v[j][1] * rstd * gv[j][1]); w.y = pk2(v[j][2] * rstd * gv[j][2], v[j][3] * rstd * gv[j][3]);
        *((u32x2*)orow + lane + 64 * j) = w;
    }
}

__device__ __forceinline__ void phase0(const Args& a, LAS unsigned char* lds, int gw, int NGW, int wave, int lane) {
    LAS float* scr = (LAS float*)(lds + wave * 16640);
    constexpr int I_IN = 32 * 204, I_BR = 4 * 8 * 32, I_OUT = 32 * 32, I_UP = 32 * 128, I_DN = 128 * 32, I_POOL = 16;
    constexpr int I_LAYER = I_IN + I_BR + I_OUT + I_UP + I_DN + I_POOL, I_ALL = DEPTH * I_LAYER;
    const int c4 = (lane & 15) * 4, kr = lane >> 4;
    auto decode = [&](int it) -> TrDesc {
        const int l = it / I_LAYER; int r = it - l * I_LAYER;
        unsigned char* wl = a.ws + WS_W + (size_t)l * WL_STRIDE;
        const float* src; size_t ld; int sc, nv = 64, k0, n0, K; bf16_t* dst; float scale = 1.0f;
        if (r < I_IN) {
            const int kb = r / 204, nb = r % 204; n0 = nb * 64; k0 = kb * 64;
            if (nb < 64) { sc = n0; } else if (nb < 200) { sc = n0 + 4; } else if (nb == 200) { sc = 4096; nv = 4; } else { sc = 0; nv = 0; }
            src = a.w_in + (size_t)l * DM * INC; ld = INC; dst = (bf16_t*)(wl + WO_IN); K = DM;
            scale = (nb >= 72 && nb < 200) ? -LOG2E : 1.0f;
        } else if ((r -= I_IN) < I_BR) {
            const int n = r / 256, rr = r % 256, kb = rr / 32, nb = rr % 32; n0 = nb * 64; k0 = kb * 64; sc = n0;
            src = a.w_branch + ((size_t)l * 4 + n) * 512 * DM; ld = DM; dst = (bf16_t*)(wl + WO_BR) + n * 512; K = DM;
        } else if ((r -= I_BR) < I_OUT) {
            const int kb = r / 32, nb = r % 32; n0 = nb * 64; k0 = kb * 64; sc = n0;
            src = a.w_out + (size_t)l * DM * DM; ld = DM; dst = (bf16_t*)(wl + WO_OUT); K = DM;
        } else if ((r -= I_OUT) < I_UP) {
            const int kb = r / 128, nb = r % 128; n0 = nb * 64; k0 = kb * 64; sc = n0;
            src = a.w_ffn_up + (size_t)l * DM * FFN; ld = FFN; dst = (bf16_t*)(wl + WO_UP); K = DM;
        } else if ((r -= I_UP) < I_DN) {
            const int kb = r / 32, nb = r % 32; n0 = nb * 64; k0 = kb * 64; sc = n0;
            src = a.w_ffn_down + (size_t)l * FFN * DM; ld = DM; dst = (bf16_t*)(wl + WO_DN); K = FFN;
        } else {
            r -= I_DN;
            const int g = r / 4, rr = r % 4, kb = rr / 2, nb = rr % 2; n0 = nb * 64; k0 = kb * 64; sc = n0;
            src = a.pool_w + ((size_t)l * 4 + g) * 128 * 128; ld = 128; dst = (bf16_t*)(wl + WO_POOL) + (size_t)g * 128 * 128; K = 128;
        }
        TrDesc d; d.sp = src + (size_t)(k0 + kr) * ld + sc + c4; d.ld = ld; d.dp = dst + (size_t)n0 * K + k0; d.K = K; d.scale = scale; d.ok = c4 < nv;
        return d;
    };
    {
        int it = gw; TrDesc dA, dB; f32x4 vA[16], vB[16];
        if (it < I_ALL) { dA = decode(it); tr_load(dA, vA); }
        while (it < I_ALL) {
            const int itB = it + NGW;
            if (itB < I_ALL) { dB = decode(itB); tr_load(dB, vB); }
            tr_finish(dA, vA, scr, lane);
            const int itA = itB + NGW;
            if (itA < I_ALL) { dA = decode(itA); tr_load(dA, vA); }
            if (itB < I_ALL) tr_finish(dB, vB, scr, lane);
            it = itA;
        }
    }
    {
        float* rot = (float*)(a.ws + WS_ROT);
        const float inv[8] = {1.0f, 0.193922758102417f, 0.03760603070259094f, 0.00729266507551074f, 0.001414213445968926f, 0.00027424818836152554f, 5.318296462064609e-05f, 1.0313385246263351e-05f};
        for (int e = gw * 64 + lane; e < MROWS * 8; e += NGW * 64) {
            const int row = e >> 3, i = e & 7;
            float iv = inv[0];
#pragma unroll
            for (int q = 1; q < 8; ++q) iv = (i == q) ? inv[q] : iv;
            const float ang = (float)a.pos[row] * iv;
            const double ad = (double)ang;
            const double kk = __builtin_rint(ad * 0.15915494309189535);
            const float rr = (float)(ad - kk * 6.283185307179586);
            rot[2 * e] = cosf(rr); rot[2 * e + 1] = sinf(rr);
        }
    }
    {
        f32x4 g0[8];
#pragma unroll
        for (int j = 0; j < 8; ++j) g0[j] = *((const f32x4*)a.n_mix_pre + lane + 64 * j);
        for (int m = gw; m < MROWS; m += NGW) rms_row_bf16(a.x + (size_t)m * DM, g0, (bf16_t*)(a.ws + WS_XN) + (size_t)m * DM, lane);
    }
}

template <bool HIN_BF, bool HOUT_BF>
__device__ __forceinline__ void row_phase(const bf16_t* Y, const void* hin, void* hout, const float* gpost, const float* gpre, bf16_t* XN, int gw, int NGW, int lane) {
    f32x4 gpo[8], gpr[8];
#pragma unroll
    for (int j = 0; j < 8; ++j) { gpo[j] = *((const f32x4*)gpost + lane + 64 * j); gpr[j] = gpre ? *((const f32x4*)gpre + lane + 64 * j) : (f32x4){0.f, 0.f, 0.f, 0.f}; }
    for (int m = gw; m < MROWS; m += NGW) {
        const u32x2* yr = (const u32x2*)(Y + (size_t)m * DM);
        u32x2 yw[8]; u32x2 hw[8]; f32x4 hf[8];
#pragma unroll
        for (int j = 0; j < 8; ++j) yw[j] = yr[lane + 64 * j];
#pragma unroll
        for (int j = 0; j < 8; ++j) {
            if (HIN_BF) hw[j] = *((const u32x2*)((const bf16_t*)hin + (size_t)m * DM) + lane + 64 * j);
            else hf[j] = *((const f32x4*)((const float*)hin + (size_t)m * DM) + lane + 64 * j);
        }
        f32x4 v[8]; float s = 0.f;
#pragma unroll
        for (int j = 0; j < 8; ++j) { v[j] = (f32x4){bflo(yw[j].x), bfhi(yw[j].x), bflo(yw[j].y), bfhi(yw[j].y)}; s += (v[j][0] * v[j][0] + v[j][1] * v[j][1]) + (v[j][2] * v[j][2] + v[j][3] * v[j][3]); }
        const float rstd = 1.0f / sqrtf(wave_sum(s) * (1.0f / DM) + NORM_EPS);
        float s2 = 0.f;
#pragma unroll
        for (int j = 0; j < 8; ++j) {
            f32x4 h;
            if (HIN_BF) h = (f32x4){bflo(hw[j].x), bfhi(hw[j].x), bflo(hw[j].y), bfhi(hw[j].y)}; else h = hf[j];
            v[j] = h + v[j] * rstd * gpo[j];
            if (HOUT_BF) { u32x2 w; w.x = pk2(v[j][0], v[j][1]); w.y = pk2(v[j][2], v[j][3]); *((u32x2*)((bf16_t*)hout + (size_t)m * DM) + lane + 64 * j) = w; }
            else *((f32x4*)((float*)hout + (size_t)m * DM) + lane + 64 * j) = v[j];
            s2 += (v[j][0] * v[j][0] + v[j][1] * v[j][1]) + (v[j][2] * v[j][2] + v[j][3] * v[j][3]);
        }
        if (gpre) {
            const float rstd2 = 1.0f / sqrtf(wave_sum(s2) * (1.0f / DM) + NORM_EPS);
#pragma unroll
            for (int j = 0; j < 8; ++j) {
                const f32x4 gv = gpr[j];
                u32x2 w; w.x = pk2(v[j][0] * rstd2 * gv[0], v[j][1] * rstd2 * gv[1]); w.y = pk2(v[j][2] * rstd2 * gv[2], v[j][3] * rstd2 * gv[3]);
                *((u32x2*)(XN + (size_t)m * DM) + lane + 64 * j) = w;
            }
        }
    }
}

constexpr int KSTR = 272;
constexpr int VSTR = 144;
constexpr int KBUF = 64 * KSTR;
constexpr int VBUF = 128 * VSTR;
constexpr int L_K0 = 0, L_V0 = 2 * KBUF, L_CUM = L_V0 + 2 * VBUF  , L_STAT = L_CUM + 8192  , L_WT = L_STAT + 1024  ;

struct KRegs { u32x4 a, b; };
struct VRegs { u32x4 a, b; };

__device__ __forceinline__ KRegs k_load(const bf16_t* base  , int tid) {
    const bf16_t* p = base + (size_t)(tid >> 3) * NP + (tid & 7) * 16;
    KRegs r; r.a = *(const u32x4*)p; r.b = *(const u32x4*)(p + 8); return r;
}
__device__ __forceinline__ void k_store(LAS unsigned char* buf, const KRegs& r, int tid) {
    LAS unsigned char* d = buf + (tid >> 3) * KSTR + (tid & 7) * 32;
    *(LAS u32x4*)d = r.a; *(LAS u32x4*)(d + 16) = r.b;
}
__device__ __forceinline__ void v_map(int tid, int& chunk, int& pair) { const int w = tid >> 6, l = tid & 63; chunk = 4 * (w & 3) + (l & 3); pair = 16 * (w >> 2) + (l >> 2); }
__device__ __forceinline__ VRegs v_load(const bf16_t* base, int tid) {
    int chunk, pair; v_map(tid, chunk, pair);
    const bf16_t* p = base + (size_t)(2 * pair) * NP + chunk * 8;
    VRegs r; r.a = *(const u32x4*)p; r.b = *(const u32x4*)(p + NP); return r;
}
__device__ __forceinline__ void v_store_words(LAS unsigned char* buf, const unsigned (&wa)[4], const unsigned (&wb)[4], int tid) {
    int chunk, pair; v_map(tid, chunk, pair);
    LAS unsigned char* d = buf + (8 * chunk) * VSTR + pair * 4;
#pragma unroll
    for (int i = 0; i < 4; ++i) {
        *(LAS unsigned*)(d + (2 * i) * VSTR) = (wa[i] & 0xffffu) | (wb[i] << 16);
        *(LAS unsigned*)(d + (2 * i + 1) * VSTR) = (wa[i] >> 16) | (wb[i] & 0xffff0000u);
    }
}
__device__ __forceinline__ void v_store(LAS unsigned char* buf, const VRegs& r, int tid) {
    const unsigned wa[4] = {r.a.x, r.a.y, r.a.z, r.a.w}, wb[4] = {r.b.x, r.b.y, r.b.z, r.b.w};
    v_store_words(buf, wa, wb, tid);
}

__device__ __forceinline__ void pv_mma(f32x4 (&o)[8], const LAS unsigned char* vbuf, const bf16x8 (&pf)[2], int lane) {
    const LAS unsigned char* vp = vbuf + (lane & 15) * VSTR + (lane >> 4) * 16;
#pragma unroll
    for (int mb = 0; mb < 8; ++mb)
#pragma unroll
        for (int pr = 0; pr < 2; ++pr) {
            const bf16x8 vf = *(const LAS bf16x8*)(vp + mb * 16 * VSTR + pr * 64);
            o[mb] = __builtin_amdgcn_mfma_f32_16x16x32_bf16(vf, pf[pr], o[mb], 0, 0, 0);
        }
}

__device__ __forceinline__ void softmax_tile(f32x4 (&s)[4], const f32x4 (&add)[4], float cs, float& lsum, bf16x8 (&pf)[2]) {
    float ps = 0.f;
#pragma unroll
    for (int rb = 0; rb < 4; ++rb)
#pragma unroll
        for (int j = 0; j < 4; ++j) { s[rb][j] = __builtin_amdgcn_exp2f(fminf(fmaf(s[rb][j], cs, add[rb][j]), 126.f)); ps += s[rb][j]; }
    lsum += ps;
#pragma unroll
    for (int pr = 0; pr < 2; ++pr) {
        u32x4 w; w.x = pg8::cvt_pk_bf16(s[2 * pr][0], s[2 * pr][1]); w.y = pg8::cvt_pk_bf16(s[2 * pr][2], s[2 * pr][3]); w.z = pg8::cvt_pk_bf16(s[2 * pr + 1][0], s[2 * pr + 1][1]); w.w = pg8::cvt_pk_bf16(s[2 * pr + 1][2], s[2 * pr + 1][3]);
        pf[pr] = __builtin_bit_cast(bf16x8, w);
    }
}

template <bool DIFF>
__device__ __forceinline__ void attn_unit(const Args& a, int layer, int bh, int qb, LAS unsigned char* lds, int tid) {
    const int wave = tid >> 6, lane = tid & 63, l15 = lane & 15, quad = lane >> 4;
    const int b = bh >> 2, h = bh & 3;
    const bf16_t* proj = (const bf16_t*)(a.ws + WS_PROJ) + (size_t)b * SEQ * NP;
    const bf16_t* Qg = proj + (DIFF ? P_BQ : P_CQ) + h * 128;
    const bf16_t* Kg = proj + (DIFF ? P_BK : P_CK) + h * 128;
    const bf16_t* Vg = proj + (DIFF ? P_BV : P_CV) + h * 128;
    const int q0 = qb * 128, ntiles = 2 * qb + 2;
    __syncthreads();
    { KRegs r0 = k_load(Qg + (size_t)q0 * NP, tid), r1 = k_load(Qg + (size_t)(q0 + 64) * NP, tid);
      k_store(lds + L_K0, r0, tid); k_store(lds + L_K0 + KBUF, r1, tid); }
    if (!DIFF) {
        const float* fl = (const float*)(a.ws + WS_FLOG) + (size_t)b * SEQ * 4 + h;
        const int nk = q0 + 128;
        float v[4];
#pragma unroll
        for (int i = 0; i < 4; ++i) {
            const int k = 4 * tid + i;
            float z = (k < nk) ? fl[(size_t)k * 4] : 0.f;
            float ls = fminf(z, 0.f) - log1pf(expf(-fabsf(z)));
            v[i] = (k < nk) ? ls : 0.f;
        }
        const float s0 = v[0], s1 = s0 + v[1], s2 = s1 + v[2], s3 = s2 + v[3];
        float x = s3;
#pragma unroll
        for (int d = 1; d < 64; d <<= 1) { const float y = __shfl_up(x, d); if (lane >= d) x += y; }
        LAS float* wt = (LAS float*)(lds + L_WT);
        if (lane == 63) wt[wave] = x;
        __syncthreads();
        float off = 0.f;
#pragma unroll
        for (int w = 0; w < 8; ++w) off += (w < wave) ? wt[w] : 0.f;
        const float ex = off + x - s3;
        LAS f32x4* cum = (LAS f32x4*)(lds + L_CUM);
        cum[tid] = (f32x4){(ex + s0) * LOG2E, (ex + s1) * LOG2E, (ex + s2) * LOG2E, (ex + s3) * LOG2E};
    }
    __syncthreads();
    bf16x8 qf[4];
    {
        const LAS unsigned char* qp = lds + L_K0 + (wave * 16 + l15) * KSTR + quad * 16;
#pragma unroll
        for (int ks = 0; ks < 4; ++ks) qf[ks] = *(const LAS bf16x8*)(qp + ks * 64);
    }
    KRegs kr = k_load(Kg, tid); VRegs vr = v_load(Vg, tid);
    __syncthreads();

    constexpr int NMAP = DIFF ? 2 : 1;
    const float cs = (DIFF ? 0.125f : 0.08838834764831845f) * LOG2E;
    f32x4 o[NMAP][8]; float lsum[NMAP];
#pragma unroll
    for (int mp = 0; mp < NMAP; ++mp) { lsum[mp] = 0.f;
#pragma unroll
        for (int mb = 0; mb < 8; ++mb) o[mp][mb] = (f32x4){0.f, 0.f, 0.f, 0.f}; }
    const int qi = q0 + wave * 16 + l15;
    float cumq = 0.f; if (!DIFF) cumq = *(const LAS float*)(lds + L_CUM + qi * 4);

    for (int jt = 0; jt < ntiles; ++jt) {
        LAS unsigned char* kb = lds + L_K0 + (jt & 1) * KBUF;
        LAS unsigned char* vb = lds + L_V0 + (jt & 1) * VBUF;
        k_store(kb, kr, tid); v_store(vb, vr, tid);
        __syncthreads();
        if (jt + 1 < ntiles) { kr = k_load(Kg + (size_t)(jt + 1) * 64 * NP, tid); vr = v_load(Vg + (size_t)(jt + 1) * 64 * NP, tid); }
        f32x4 s[NMAP][4];
        {
            bf16x8 kf[4][4];
#pragma unroll
            for (int rb = 0; rb < 4; ++rb) {
                const int trow = 32 * (rb >> 1) + 8 * (l15 >> 2) + 4 * (rb & 1) + (l15 & 3);
                const LAS unsigned char* kp = kb + trow * KSTR + quad * 16;
#pragma unroll
                for (int ks = 0; ks < 4; ++ks) kf[rb][ks] = *(const LAS bf16x8*)(kp + ks * 64);
            }
            __builtin_amdgcn_sched_barrier(0);
            __builtin_amdgcn_s_setprio(1);
#pragma unroll
            for (int rb = 0; rb < 4; ++rb) {
                if (DIFF) {
                    f32x4 c0 = (f32x4){0.f, 0.f, 0.f, 0.f}, c1 = c0;
                    c0 = __builtin_amdgcn_mfma_f32_16x16x32_bf16(kf[rb][0], qf[0], c0, 0, 0, 0);
                    c0 = __builtin_amdgcn_mfma_f32_16x16x32_bf16(kf[rb][1], qf[1], c0, 0, 0, 0);
                    c1 = __builtin_amdgcn_mfma_f32_16x16x32_bf16(kf[rb][2], qf[2], c1, 0, 0, 0);
                    c1 = __builtin_amdgcn_mfma_f32_16x16x32_bf16(kf[rb][3], qf[3], c1, 0, 0, 0);
                    s[0][rb] = c0; s[NMAP - 1][rb] = c1;
                } else {
                    f32x4 c0 = (f32x4){0.f, 0.f, 0.f, 0.f};
#pragma unroll
                    for (int ks = 0; ks < 4; ++ks) c0 = __builtin_amdgcn_mfma_f32_16x16x32_bf16(kf[rb][ks], qf[ks], c0, 0, 0, 0);
                    s[0][rb] = c0;
                }
            }
            __builtin_amdgcn_s_setprio(0);
        }
        bf16x8 vf[8][2];
        {
            const LAS unsigned char* vp = vb + l15 * VSTR + quad * 16;
#pragma unroll
            for (int mb = 0; mb < 8; ++mb)
#pragma unroll
                for (int pr = 0; pr < 2; ++pr) vf[mb][pr] = *(const LAS bf16x8*)(vp + mb * 16 * VSTR + pr * 64);
        }
        __builtin_amdgcn_sched_barrier(0);
        f32x4 addv[4];
#pragma unroll
        for (int rb = 0; rb < 4; ++rb) {
            const int key0 = jt * 64 + 32 * (rb >> 1) + 8 * quad + 4 * (rb & 1);
            if (!DIFF) addv[rb] = cumq - *(const LAS f32x4*)(lds + L_CUM + key0 * 4);
            else addv[rb] = (f32x4){0.f, 0.f, 0.f, 0.f};
        }
        if (jt >= 2 * qb) {
#pragma unroll
            for (int rb = 0; rb < 4; ++rb) {
                const int key0 = jt * 64 + 32 * (rb >> 1) + 8 * quad + 4 * (rb & 1);
#pragma unroll
                for (int mp = 0; mp < NMAP; ++mp)
#pragma unroll
                    for (int j = 0; j < 4; ++j) s[mp][rb][j] = (key0 + j > qi) ? -INFINITY : s[mp][rb][j];
            }
        }
        bf16x8 pf[NMAP][2];
#pragma unroll
        for (int mp = 0; mp < NMAP; ++mp) softmax_tile(s[mp], addv, cs, lsum[mp], pf[mp]);
        __builtin_amdgcn_s_setprio(1);
#pragma unroll
        for (int mb = 0; mb < 8; ++mb)
#pragma unroll
            for (int pr = 0; pr < 2; ++pr)
#pragma unroll
                for (int mp = 0; mp < NMAP; ++mp) o[mp][mb] = __builtin_amdgcn_mfma_f32_16x16x32_bf16(vf[mb][pr], pf[mp][pr], o[mp][mb], 0, 0, 0);
        __builtin_amdgcn_s_setprio(0);
    }
    float inv[NMAP];
#pragma unroll
    for (int mp = 0; mp < NMAP; ++mp) { float l = lsum[mp]; l += __shfl_xor(l, 16); l += __shfl_xor(l, 32); inv[mp] = 1.0f / l; }
    const size_t orow = (size_t)b * SEQ + qi;
    if (DIFF) {
        const float li = 0.8f - 0.6f * expf(-0.3f * (float)layer);
        const float* lp = a.da_lambda + (size_t)layer * 256;
        float d1 = lp[lane] * lp[64 + lane], d2 = lp[128 + lane] * lp[192 + lane];
        d1 = wave_sum(d1); d2 = wave_sum(d2);
        const float lam = expf(d1) - expf(d2) + li;
        const float c1 = inv[0], c2 = lam * inv[NMAP - 1];
        float ss = 0.f;
#pragma unroll
        for (int mb = 0; mb < 8; ++mb) { o[0][mb] = o[0][mb] * c1 - o[NMAP - 1][mb] * c2; ss += (o[0][mb][0] * o[0][mb][0] + o[0][mb][1] * o[0][mb][1]) + (o[0][mb][2] * o[0][mb][2] + o[0][mb][3] * o[0][mb][3]); }
        ss += __shfl_xor(ss, 16); ss += __shfl_xor(ss, 32);
        const float rstd = (1.0f / sqrtf(ss * (1.0f / 128.0f) + NORM_EPS)) * (1.0f - li);
        const float* sg = a.da_subln_g + (size_t)layer * 128;
        bf16_t* op = (bf16_t*)(a.ws + WS_BR) + orow * DM + 1 * 512 + h * 128 + quad * 4;
        f32x4 sgv[8];
#pragma unroll
        for (int mb = 0; mb < 8; ++mb) sgv[mb] = *(const f32x4*)(sg + mb * 16 + quad * 4);
#pragma unroll
        for (int mb = 0; mb < 8; ++mb) {
            const f32x4 gv = sgv[mb];
            u32x2 w; w.x = pk2(o[0][mb][0] * rstd * gv[0], o[0][mb][1] * rstd * gv[1]); w.y = pk2(o[0][mb][2] * rstd * gv[2], o[0][mb][3] * rstd * gv[3]);
            *(u32x2*)(op + mb * 16) = w;
        }
    } else {
        bf16_t* op = (bf16_t*)(a.ws + WS_BR) + orow * DM + 2 * 512 + h * 128 + quad * 4;
#pragma unroll
        for (int mb = 0; mb < 8; ++mb) {
            const f32x4 v = o[0][mb] * inv[0];
            u32x2 w; w.x = pk2(v[0], v[1]); w.y = pk2(v[2], v[3]);
            *(u32x2*)(op + mb * 16) = w;
        }
    }
}

__device__ __forceinline__ void gmlp_unit(const Args& a, int layer, int unit, LAS unsigned char* lds, int tid) {
    const int wave = tid >> 6, lane = tid & 63, l15 = lane & 15, quad = lane >> 4;
    const int g = unit & 3, bn = unit >> 2;
    const size_t r0 = (size_t)bn * 128;
    const bf16_t* proj = (const bf16_t*)(a.ws + WS_PROJ) + r0 * NP;
    __syncthreads();
    LAS float* stat = (LAS float*)(lds + L_STAT);
    {
        const int t = wave * 16 + (lane >> 2), part = lane & 3;
        const bf16_t* vp = proj + (size_t)t * NP + P_AV + part * 128;
        u32x4 w[16];
#pragma unroll
        for (int j = 0; j < 16; ++j) w[j] = *(const u32x4*)(vp + j * 8);
        float s1 = 0.f, s2 = 0.f;
#pragma unroll
        for (int j = 0; j < 16; ++j) {
            const float f[8] = {bflo(w[j].x), bfhi(w[j].x), bflo(w[j].y), bfhi(w[j].y), bflo(w[j].z), bfhi(w[j].z), bflo(w[j].w), bfhi(w[j].w)};
#pragma unroll
            for (int e = 0; e < 8; ++e) { s1 += f[e]; s2 += f[e] * f[e]; }
        }
        s1 += __shfl_xor(s1, 1); s1 += __shfl_xor(s1, 2); s2 += __shfl_xor(s2, 1); s2 += __shfl_xor(s2, 2);
        const float mu = s1 * (1.0f / 512.0f), var = fmaxf(s2 * (1.0f / 512.0f) - mu * mu, 0.f);
        if (part == 0) { stat[2 * t] = mu; stat[2 * t + 1] = 1.0f / sqrtf(var + NORM_EPS); }
    }
    __syncthreads();
    {
        int chunk, pair; v_map(tid, chunk, pair);
        const float* lg = a.gm_ln_g + (size_t)layer * 512 + g * 128 + chunk * 8;
        const float* lb = a.gm_ln_b + (size_t)layer * 512 + g * 128 + chunk * 8;
        const f32x4 g0 = *(const f32x4*)lg, g1 = *(const f32x4*)(lg + 4), b0 = *(const f32x4*)lb, b1 = *(const f32x4*)(lb + 4);
        const float gg[8] = {g0[0], g0[1], g0[2], g0[3], g1[0], g1[1], g1[2], g1[3]};
        const float bb[8] = {b0[0], b0[1], b0[2], b0[3], b1[0], b1[1], b1[2], b1[3]};
#pragma unroll
        for (int half = 0; half < 2; ++half) {
            const VRegs r = v_load(proj + (size_t)(half * 64) * NP + P_AV + g * 128, tid);
            const int sA = half * 64 + 2 * pair, sB = sA + 1;
            const float muA = stat[2 * sA], rsA = stat[2 * sA + 1], muB = stat[2 * sB], rsB = stat[2 * sB + 1];
            const unsigned ra[4] = {r.a.x, r.a.y, r.a.z, r.a.w}, rb[4] = {r.b.x, r.b.y, r.b.z, r.b.w};
            unsigned wa[4], wb[4];
#pragma unroll
            for (int i = 0; i < 4; ++i) {
                wa[i] = pk2((bflo(ra[i]) - muA) * rsA * gg[2 * i] + bb[2 * i], (bfhi(ra[i]) - muA) * rsA * gg[2 * i + 1] + bb[2 * i + 1]);
                wb[i] = pk2((bflo(rb[i]) - muB) * rsB * gg[2 * i] + bb[2 * i], (bfhi(rb[i]) - muB) * rsB * gg[2 * i + 1] + bb[2 * i + 1]);
            }
            v_store_words(lds + L_V0 + half * VBUF, wa, wb, tid);
        }
    }
    __syncthreads();
    const int t = wave * 16 + l15;
    const float* W = a.gm_w_s + ((size_t)layer * 4 + g) * 128 * 128 + (size_t)t * 128;
    f32x4 o[8];
#pragma unroll
    for (int mb = 0; mb < 8; ++mb) o[mb] = (f32x4){0.f, 0.f, 0.f, 0.f};
#pragma unroll
    for (int st = 0; st < 2; ++st) {
        if (st * 64 <= wave * 16 + 15) {
            bf16x8 pf[2];
#pragma unroll
            for (int pr = 0; pr < 2; ++pr) {
                const int sbase = st * 64 + pr * 32 + quad * 8;
                const f32x4 w0 = *(const f32x4*)(W + sbase), w1 = *(const f32x4*)(W + sbase + 4);
                float f[8] = {w0[0], w0[1], w0[2], w0[3], w1[0], w1[1], w1[2], w1[3]};
#pragma unroll
                for (int j = 0; j < 8; ++j) f[j] = (sbase + j <= t) ? f[j] : 0.f;
                u32x4 w; w.x = pk2(f[0], f[1]); w.y = pk2(f[2], f[3]); w.z = pk2(f[4], f[5]); w.w = pk2(f[6], f[7]);
                pf[pr] = __builtin_bit_cast(bf16x8, w);
            }
            pv_mma(o, lds + L_V0 + st * VBUF, pf, lane);
        }
    }
    const float bs = a.gm_b_s[((size_t)layer * 4 + g) * 128 + t];
    const bf16_t* up = proj + (size_t)t * NP + P_AU + g * 128 + quad * 4;
    bf16_t* op = (bf16_t*)(a.ws + WS_BR) + (r0 + t) * DM + g * 128 + quad * 4;
    u32x2 uwv[8];
#pragma unroll
    for (int mb = 0; mb < 8; ++mb) uwv[mb] = *(const u32x2*)(up + mb * 16);
#pragma unroll
    for (int mb = 0; mb < 8; ++mb) {
        const u32x2 uw = uwv[mb];
        u32x2 w; w.x = pk2(bflo(uw.x) * (o[mb][0] + bs), bfhi(uw.x) * (o[mb][1] + bs)); w.y = pk2(bflo(uw.y) * (o[mb][2] + bs), bfhi(uw.y) * (o[mb][3] + bs));
        *(u32x2*)(op + mb * 16) = w;
    }
}

template <int G_>
__device__ __forceinline__ void pool_unit_t(const Args& a, int layer, int unit, int tid) {
    const int wave = tid >> 6, lane = tid & 63, l15 = lane & 15, quad = lane >> 4;
    constexpr int g = G_; const int tile = unit >> 2;
    const int t = wave * 16 + l15;
    const size_t row = (size_t)tile * 128 + t;
    const int tseq = (int)(row & (SEQ - 1));
    constexpr int win = 2 << g;
    const int cnt = (tseq + 1 < win) ? (tseq + 1) : win;
    const float rc = 1.0f / (float)cnt;
    const bf16_t* hp = (const bf16_t*)(a.ws + WS_PROJ) + row * NP + P_DH + g * 128 + quad * 8;
    const bf16_t* wp = (const bf16_t*)(a.ws + WS_W + (size_t)layer * WL_STRIDE + WO_POOL) + (size_t)g * 128 * 128 + (size_t)l15 * 128 + quad * 8;
    f32x4 o[8];
#pragma unroll
    for (int mb = 0; mb < 8; ++mb) o[mb] = (f32x4){0.f, 0.f, 0.f, 0.f};
#pragma unroll
    for (int ks = 0; ks < 4; ++ks) {
        float acc[8] = {0.f, 0.f, 0.f, 0.f, 0.f, 0.f, 0.f, 0.f};
        float self[8];
        u32x4 wv[win];
#pragma unroll
        for (int i = 0; i < win; ++i) wv[i] = (i < cnt) ? *(const u32x4*)(hp - (size_t)i * NP + ks * 32) : (u32x4){0u, 0u, 0u, 0u};
#pragma unroll
        for (int i = 0; i < win; ++i) {
            const u32x4 w = wv[i];
            const float f[8] = {bflo(w.x), bfhi(w.x), bflo(w.y), bfhi(w.y), bflo(w.z), bfhi(w.z), bflo(w.w), bfhi(w.w)};
#pragma unroll
            for (int j = 0; j < 8; ++j) { acc[j] += f[j]; if (i == 0) self[j] = f[j]; }
        }
        asm volatile("" ::: "memory");
        u32x4 pw; pw.x = pk2(acc[0] * rc - self[0], acc[1] * rc - self[1]); pw.y = pk2(acc[2] * rc - self[2], acc[3] * rc - self[3]);
        pw.z = pk2(acc[4] * rc - self[4], acc[5] * rc - self[5]); pw.w = pk2(acc[6] * rc - self[6], acc[7] * rc - self[7]);
        const bf16x8 pf = __builtin_bit_cast(bf16x8, pw);
#pragma unroll
        for (int mb = 0; mb < 8; ++mb) {
            const bf16x8 wf = *(const bf16x8*)(wp + (size_t)mb * 16 * 128 + ks * 32);
            o[mb] = __builtin_amdgcn_mfma_f32_16x16x32_bf16(wf, pf, o[mb], 0, 0, 0);
        }
    }
    const float* sc = a.pool_scale + (size_t)layer * 512 + g * 128 + quad * 4;
    bf16_t* op = (bf16_t*)(a.ws + WS_BR) + row * DM + 3 * 512 + g * 128 + quad * 4;
    f32x4 svv[8];
#pragma unroll
    for (int mb = 0; mb < 8; ++mb) svv[mb] = *(const f32x4*)(sc + mb * 16);
#pragma unroll
    for (int mb = 0; mb < 8; ++mb) {
        const f32x4 sv = svv[mb];
        u32x2 w; w.x = pk2(o[mb][0] * sv[0], o[mb][1] * sv[1]); w.y = pk2(o[mb][2] * sv[2], o[mb][3] * sv[3]);
        *(u32x2*)(op + mb * 16) = w;
    }
}

__device__ __forceinline__ void mixer_phase(const Args& a, int cidx, int layer, LAS unsigned char* lds, int tid_) {
    int tid = tid_; asm volatile("" : "+v"(tid));
    unsigned* ctr = (unsigned*)(a.ws + WS_CTL) + 64 * cidx;
    LAS unsigned* slot = (LAS unsigned*)(lds + LDS_MISC);
    {
        const unsigned char* wl = a.ws + WS_W + (size_t)layer * WL_STRIDE;
        pg8::Gemm g{(const bf16_t*)(a.ws + WS_XN), (const bf16_t*)(wl + WO_IN), MROWS, NIN, DM};
        pg8::InOrder S; S.init(MROWS, NIN, (int)gridDim.x, (int)blockIdx.x, gridDim.x == 256 ? 6 : (1 << 30), 1 << 30);
        pg8::EpiIn E{(bf16_t*)(a.ws + WS_PROJ), (float*)(a.ws + WS_FLOG), (const float*)(a.ws + WS_ROT), a.fa_b_f + layer * 4};
        pg8::gemm_phase<pg8::EpiIn, pg8::InOrder>(lds, g, S, E);
    }
    for (;;) {
        __syncthreads();
        if (tid == 0) slot[0] = atomicAdd(ctr, 1u);
        __syncthreads();
        const int idx = (int)slot[0];
        if (idx >= 1024) break;
        int tu = tid; asm volatile("" : "+v"(tu));
        if (idx < 512) {
            const int qb = 15 - (idx >> 5), r = idx & 31, bh = r & 15;
            if (r < 16) attn_unit<true>(a, layer, bh, qb, lds, tu); else attn_unit<false>(a, layer, bh, qb, lds, tu);
        } else if (idx < 768) gmlp_unit(a, layer, idx - 512, lds, tu);
        else { const int pu = idx - 768; switch (pu & 3) { case 0: pool_unit_t<0>(a, layer, pu, tu); break; case 1: pool_unit_t<1>(a, layer, pu, tu); break; case 2: pool_unit_t<2>(a, layer, pu, tu); break; default: pool_unit_t<3>(a, layer, pu, tu); break; } }
    }
}

#define XB_TMO      128
#define XB_XCNT(j)  (256  + 64 * (j))
#define XB_XSUB(j)  (1280 + 64 * (j))
#define XB_XGEN(j)  (2304 + 64 * (j))
#define XB_TOP      3328
#define XB_TOPGEN   3392
#define XCD_BAR_WORDS 3456
#define XB_SPIN_CAP (1u << 22)
__device__ __forceinline__ unsigned xb_ld(unsigned* p)              { return __hip_atomic_load(p, __ATOMIC_RELAXED, __HIP_MEMORY_SCOPE_AGENT); }
__device__ __forceinline__ unsigned xb_add(unsigned* p, unsigned v) { return __hip_atomic_fetch_add(p, v, __ATOMIC_RELAXED, __HIP_MEMORY_SCOPE_AGENT); }
__device__ __forceinline__ unsigned xb_xcc_id() { return (unsigned)__builtin_amdgcn_s_getreg((3 << 11) | 20) & 0xFu; }
#define XB_SPIN(cond, bar) do { unsigned _sp = 0; while (cond) { __builtin_amdgcn_s_sleep(1); \
    if ((++_sp & 255u) == 0u) { if (xb_ld(&(bar)[XB_TMO])) break; if (_sp > XB_SPIN_CAP) { atomicAdd(&(bar)[XB_TMO], 1u); break; } } } } while (0)
struct XcdBarrier { unsigned* bar; unsigned x; volatile LAS unsigned* st; };
__device__ __forceinline__ XcdBarrier xcd_barrier_post(unsigned* bar, volatile LAS unsigned* st) {
    XcdBarrier b; b.bar = bar; b.x = xb_xcc_id(); b.st = st;
    if (threadIdx.x == 0) (void)xb_add(&bar[XB_XCNT(b.x)], 1u);
    return b;
}
__device__ __forceinline__ void xcd_barrier_complete(unsigned* bar, unsigned x, unsigned& nloc, unsigned& nx) {
    const unsigned G = gridDim.x * gridDim.y * gridDim.z;
    unsigned sum, cnt, mine, sp = 0u;
    for (;;) {
        sum = 0u; cnt = 0u; mine = 0u;
#pragma unroll
        for (unsigned j = 0; j < 16; ++j) { const unsigned c = xb_ld(&bar[XB_XCNT(j)]); sum += c; cnt += (c > 0u) ? 1u : 0u; mine = (j == x) ? c : mine; }
        if (sum == G) break;
        __builtin_amdgcn_s_sleep(1);
        if ((++sp & 255u) == 0u) { if (xb_ld(&bar[XB_TMO])) break; if (sp > XB_SPIN_CAP) { atomicAdd(&bar[XB_TMO], 1u); break; } }
    }
    nloc = mine > 0u ? mine : 1u; nx = cnt > 0u ? cnt : 1u;
}
__device__ __forceinline__ void xcd_barrier(const XcdBarrier& b) {
    asm volatile("s_waitcnt vmcnt(0)" ::: "memory");
    __syncthreads();
    if (threadIdx.x == 0) {
        unsigned* bar = b.bar;
        __builtin_amdgcn_s_waitcnt(0);
        unsigned nloc = b.st[0], nx = b.st[1];
        if (nloc == 0u) { xcd_barrier_complete(bar, b.x, nloc, nx); b.st[0] = nloc; b.st[1] = nx; }
        const unsigned old = xb_add(&bar[XB_XSUB(b.x)], 1u);
        const unsigned gen = old / nloc;
        if (old + 1u == (gen + 1u) * nloc) {
            __builtin_amdgcn_fence(__ATOMIC_RELEASE, "agent");
            asm volatile("s_waitcnt vmcnt(0)" ::: "memory");
            const unsigned og = xb_add(&bar[XB_TOP], 1u);
            const unsigned tg = og / nx;
            if (og + 1u == (tg + 1u) * nx) xb_add(&bar[XB_TOPGEN], 1u);
            else XB_SPIN(xb_ld(&bar[XB_TOPGEN]) == tg, bar);
            __builtin_amdgcn_fence(__ATOMIC_ACQUIRE, "agent");
            xb_add(&bar[XB_XGEN(b.x)], 1u);
            asm volatile("s_waitcnt vmcnt(0)" ::: "memory");
        } else {
            XB_SPIN(xb_ld(&bar[XB_XGEN(b.x)]) == gen, bar);
            __builtin_amdgcn_fence(__ATOMIC_ACQUIRE, "agent");
            asm volatile("s_waitcnt vmcnt(0)" ::: "memory");
        }
    }
    __syncthreads();
}

typedef const __attribute__((address_space(4))) Args* CArgsPtr;
__device__ __forceinline__ Args load_args() {
#if defined(__HIP_DEVICE_COMPILE__)
    CArgsPtr p = (CArgsPtr)__builtin_amdgcn_kernarg_segment_ptr(); asm volatile("" : "+s"(p)); return *p;
#else
    return Args{};
#endif
}

__global__ void __launch_bounds__(512, 2) fwd_kernel(Args a_in) {
    extern __shared__ __attribute__((aligned(16))) unsigned char lds_raw[];
    LAS unsigned char* lds = (LAS unsigned char*)lds_raw;
    cg::grid_group grid = cg::this_grid();
    const int G = gridDim.x;
    unsigned* xbar_words; unsigned xbar_x;
    {
        const Args a = load_args();
        xbar_words = (unsigned*)(a.ws + WS_CTL) + CW_BAR;
        if (threadIdx.x < 2) ((LAS unsigned*)(lds + LDS_MISC + 32))[threadIdx.x] = 0u;
        __syncthreads();
        const XcdBarrier b0 = xcd_barrier_post(xbar_words, (volatile LAS unsigned*)(lds + LDS_MISC + 32));
        xbar_x = b0.x;
    }
#define TIDS() int tid = threadIdx.x; asm volatile("" : "+v"(tid)); const int lane = tid & 63, wave = __builtin_amdgcn_readfirstlane(tid >> 6), gw = blockIdx.x * 8 + wave, NGW = G * 8; (void)lane; (void)gw; (void)NGW
    for (int rep = 0; rep < REP_P0; ++rep) {
        const Args a = load_args(); TIDS();
        phase0(a, lds, gw, NGW, wave, lane);
    }
    grid.sync();
    for (int _r = 1; _r < REP_SYNC; ++_r) grid.sync();

    for (int l = 0; l < DEPTH; ++l) {
        {
            const Args a = load_args();
            const unsigned char* wl = a.ws + WS_W + (size_t)l * WL_STRIDE;
            pg8::Gemm g{(const bf16_t*)(a.ws + WS_XN), (const bf16_t*)(wl + WO_IN), MROWS, NIN, DM}; pg8::InOrder S; S.init(MROWS, NIN, G, (int)blockIdx.x, 0, G == 256 ? 6 : (1 << 30));
            pg8::EpiIn E{(bf16_t*)(a.ws + WS_PROJ), (float*)(a.ws + WS_FLOG), (const float*)(a.ws + WS_ROT), a.fa_b_f + l * 4};
            pg8::gemm_phase<pg8::EpiIn, pg8::InOrder>(lds, g, S, E);
        }
        GSYNC();
        for (int rep = 0; rep < REP_MIX; ++rep) {
            const Args a = load_args();
            mixer_phase(a, l + 2 * rep, l, lds, threadIdx.x);
        }
        GSYNC();
        for (int rep = 0; rep < REP_MERGE; ++rep) {
            const Args a = load_args();
            const unsigned char* wl = a.ws + WS_W + (size_t)l * WL_STRIDE;
            pg8::Gemm g{(const bf16_t*)(a.ws + WS_BR), (const bf16_t*)(wl + WO_BR), MROWS, DM, DM}; pg8::StaticOrder S; S.init(MROWS, DM, G, (int)blockIdx.x);
            pg8::EpiMergeFold E{(const bf16_t*)(a.ws + WS_PROJ) + P_GATE, (bf16_t*)(a.ws + WS_MB)};
            pg8::gemm_phase<pg8::EpiMergeFold, pg8::StaticOrder>(lds, g, S, E);
        }
        GSYNC();
        for (int rep = 0; rep < REP_OUT; ++rep) {
            const Args a = load_args();
            const unsigned char* wl = a.ws + WS_W + (size_t)l * WL_STRIDE;
            pg8::Gemm g{(const bf16_t*)(a.ws + WS_MB), (const bf16_t*)(wl + WO_OUT), MROWS, DM, DM}; pg8::StaticOrder S; S.init(MROWS, DM, G, (int)blockIdx.x);
            pg8::EpiBf<0> E{(bf16_t*)(a.ws + WS_Y), DM};
            pg8::gemm_phase<pg8::EpiBf<0>, pg8::StaticOrder>(lds, g, S, E);
        }
        GSYNC();
        {
            const Args a = load_args(); TIDS();
            if (l == 0) row_phase<false, true>((const bf16_t*)(a.ws + WS_Y), a.x, a.ws + WS_HB, a.n_mix_post + (size_t)l * DM, a.n_ffn_pre + (size_t)l * DM, (bf16_t*)(a.ws + WS_XN), gw, NGW, lane);
            else row_phase<true, true>((const bf16_t*)(a.ws + WS_Y), a.ws + WS_HB, a.ws + WS_HB, a.n_mix_post + (size_t)l * DM, a.n_ffn_pre + (size_t)l * DM, (bf16_t*)(a.ws + WS_XN), gw, NGW, lane);
        }
        GSYNC();
        {
            const Args a = load_args();
            const unsigned char* wl = a.ws + WS_W + (size_t)l * WL_STRIDE;
            pg8::Gemm g{(const bf16_t*)(a.ws + WS_XN), (const bf16_t*)(wl + WO_UP), MROWS, FFN, DM}; pg8::StaticOrder S; S.init(MROWS, FFN, G, (int)blockIdx.x, REP_UP);
            pg8::EpiBf<1> E{(bf16_t*)(a.ws + WS_PROJ), FFN};
            pg8::gemm_phase<pg8::EpiBf<1>, pg8::StaticOrder>(lds, g, S, E);
        }
        GSYNC();
        for (int rep = 0; rep < REP_DN; ++rep) {
            const Args a = load_args();
            const unsigned char* wl = a.ws + WS_W + (size_t)l * WL_STRIDE;
            pg8::Gemm g{(const bf16_t*)(a.ws + WS_PROJ), (const bf16_t*)(wl + WO_DN), MROWS, DM, FFN}; pg8::StaticOrder S; S.init(MROWS, DM, G, (int)blockIdx.x);
            pg8::EpiBf<0> E{(bf16_t*)(a.ws + WS_Y), DM};
            pg8::gemm_phase<pg8::EpiBf<0>, pg8::StaticOrder>(lds, g, S, E);
        }
        GSYNC();
        {
            const Args a = load_args(); TIDS();
            if (l + 1 < DEPTH) row_phase<true, true>((const bf16_t*)(a.ws + WS_Y), a.ws + WS_HB, a.ws + WS_HB, a.n_ffn_post + (size_t)l * DM, a.n_mix_pre + (size_t)(l + 1) * DM, (bf16_t*)(a.ws + WS_XN), gw, NGW, lane);
            else row_phase<true, false>((const bf16_t*)(a.ws + WS_Y), a.ws + WS_HB, a.out, a.n_ffn_post + (size_t)l * DM, nullptr, (bf16_t*)(a.ws + WS_XN), gw, NGW, lane);
        }
        if (l + 1 < DEPTH) GSYNC();
    }
#undef TIDS
}

extern "C" void kernel_launch(void* const* d_in, const int* in_sizes, int n_in, void* d_out, int out_size, void* d_ws, size_t ws_size, hipStream_t stream) {
    static int grid = 0;
    if (grid == 0) {
        if (n_in != 20 || out_size != MROWS * DM || ws_size < WS_END) { fprintf(stderr, "kernel_launch: unexpected shapes (n_in %d out %d ws %zu)\n", n_in, out_size, ws_size); grid = -1; return; }
        int dev = 0, cus = 0, per_cu = 0;
        (void)hipGetDevice(&dev);
        (void)hipDeviceGetAttribute(&cus, hipDeviceAttributeMultiprocessorCount, dev);
        if (hipFuncSetAttribute((const void*)fwd_kernel, hipFuncAttributeMaxDynamicSharedMemorySize, LDS_BYTES) != hipSuccess) { fprintf(stderr, "kernel_launch: hipFuncSetAttribute failed\n"); grid = -1; return; }
        (void)hipOccupancyMaxActiveBlocksPerMultiprocessor(&per_cu, (const void*)fwd_kernel, 512, LDS_BYTES);
        if (per_cu < 1) { fprintf(stderr, "kernel_launch: occupancy query says %d\n", per_cu); per_cu = 1; }
        (void)hipGetLastError();
        grid = cus;
        if (grid > 256) grid = 256;
    }
    if (grid < 0) return;
    (void)hipMemsetAsync((char*)d_ws + WS_CTL, 0, CTL_BYTES, stream);
    Args a{};
    a.x = (const float*)d_in[0]; a.pos = (const int*)d_in[1];
    a.n_mix_pre = (const float*)d_in[2]; a.n_mix_post = (const float*)d_in[3]; a.n_ffn_pre = (const float*)d_in[4]; a.n_ffn_post = (const float*)d_in[5];
    a.w_in = (const float*)d_in[6]; a.gm_ln_g = (const float*)d_in[7]; a.gm_ln_b = (const float*)d_in[8]; a.gm_w_s = (const float*)d_in[9]; a.gm_b_s = (const float*)d_in[10];
    a.da_lambda = (const float*)d_in[11]; a.da_subln_g = (const float*)d_in[12]; a.fa_b_f = (const float*)d_in[13]; a.pool_w = (const float*)d_in[14]; a.pool_scale = (const float*)d_in[15];
    a.w_branch = (const float*)d_in[16]; a.w_out = (const float*)d_in[17]; a.w_ffn_up = (const float*)d_in[18]; a.w_ffn_down = (const float*)d_in[19];
    a.out = (float*)d_out; a.ws = (unsigned char*)d_ws;
    void* args[] = {&a};
    hipError_t e = hipLaunchCooperativeKernel((const void*)fwd_kernel, dim3(grid), dim3(512), args, LDS_BYTES, stream);
    if (e != hipSuccess) fprintf(stderr, "cooperative launch failed: %s (grid %d)\n", hipGetErrorString(e), grid);
}
```

```cpp
#include <hip/hip_runtime.h>
#include <hip/hip_cooperative_groups.h>
#include <cstdio>
#include <cstdint>
namespace cg = cooperative_groups;
#ifndef REP_P0
#define REP_P0 1
#endif
#ifndef REP_IN
#define REP_IN 1
#endif
#ifndef REP_MIX
#define REP_MIX 1
#endif
#ifndef REP_MERGE
#define REP_MERGE 1
#endif
#ifndef REP_OUT
#define REP_OUT 1
#endif
#ifndef REP_UP
#define REP_UP 1
#endif
#ifndef REP_DN
#define REP_DN 1
#endif
#ifndef REP_ROW
#define REP_ROW 1
#endif
#ifndef REP_SYNC
#define REP_SYNC 1
#endif
#ifndef USE_CG_SYNC
#define USE_CG_SYNC 0
#endif
#define GSYNC() do { for (int _r = 0; _r < REP_SYNC; ++_r) { if (USE_CG_SYNC) grid.sync(); else { XcdBarrier _b; _b.bar = xbar_words; _b.x = xbar_x; _b.st = (volatile LAS unsigned*)(lds + LDS_MISC + 32); xcd_barrier(_b); } } } while (0)

#define LAS __attribute__((address_space(3)))
typedef unsigned short bf16_t;
typedef short bf16x8 __attribute__((ext_vector_type(8)));
typedef float f32x4 __attribute__((ext_vector_type(4)));
typedef unsigned u32x4 __attribute__((ext_vector_type(4)));
typedef unsigned u32x2 __attribute__((ext_vector_type(2)));

constexpr int DM = 2048, NBATCH = 4, SEQ = 2048, MROWS = NBATCH * SEQ, DEPTH = 2;
constexpr int INC = 12804;
constexpr int NP = 12800;
constexpr int NIN = 13056;
constexpr int FFN = 8192;
constexpr int P_AU = 0, P_AV = 512, P_BQ = 1024, P_BK = 1536, P_BV = 2048, P_CQ = 2560, P_CK = 3072, P_CV = 3584, P_DH = 4096, P_GATE = 4608;
constexpr float NORM_EPS = 1e-6f;
constexpr float LOG2E = 1.4426950408889634f;

constexpr size_t MiB = 1u << 20;
constexpr size_t WS_CTL = 0, CTL_BYTES = 65536;
constexpr int CW_BAR = 4096;
constexpr size_t WS_W = 1 * MiB, WL_STRIDE = 132 * MiB;
constexpr size_t WO_IN = 0, WO_BR = 51 * MiB, WO_OUT = 59 * MiB, WO_UP = 67 * MiB, WO_DN = 99 * MiB, WO_POOL = 131 * MiB;
constexpr size_t WS_PROJ = 266 * MiB;
constexpr size_t WS_XN = 466 * MiB;
constexpr size_t WS_BR = 498 * MiB;
constexpr size_t WS_MB = 530 * MiB;
constexpr size_t WS_Y = 562 * MiB;
constexpr size_t WS_FLOG = 626 * MiB;
constexpr size_t WS_ROT = 627 * MiB;
constexpr size_t WS_HB = 628 * MiB;
constexpr size_t WS_END = 660 * MiB;

constexpr int LDS_BYTES = 139264;
constexpr int LDS_MISC = 135168;

__device__ __forceinline__ unsigned f2bf(float f) { unsigned u = __builtin_bit_cast(unsigned, f); return (u + 0x7fffu + ((u >> 16) & 1u)) >> 16; }
__device__ __forceinline__ unsigned pk2(float lo, float hi) { return f2bf(lo) | (f2bf(hi) << 16); }
__device__ __forceinline__ float bflo(unsigned w) { return __builtin_bit_cast(float, w << 16); }
__device__ __forceinline__ float bfhi(unsigned w) { return __builtin_bit_cast(float, w & 0xffff0000u); }
__device__ __forceinline__ float wave_sum(float v) {
#pragma unroll
    for (int o = 1; o < 64; o <<= 1) v += __shfl_xor(v, o);
    return v;
}
#define LDS_WAIT() asm volatile("s_waitcnt lgkmcnt(0)" ::: "memory")

namespace pg8 {
constexpr int BM = 256, BK = 64, HALF = 128, HTB = HALF * BK * 2, STAGE_BYTES = 8 * HTB, NXCD = 8, WGM = 8;
__host__ __device__ __forceinline__ int lds_byte(int r, int c) { const int st = (r >> 4) * 2 + (c >> 5), rr = r & 15, cc = c & 31, ob = rr * 64 + cc * 2; return st * 1024 + (ob ^ (((ob >> 9) & 1) << 5)); }
__host__ __device__ __forceinline__ void stage_rc(int b, int& R, int& C) { const int st = b / 1024, sb = b % 1024, swz = sb ^ (((sb >> 9) & 1) << 5); R = (st >> 1) * 16 + swz / 64; C = (st & 1) * 32 + (swz % 64) / 2; }
__host__ __device__ __forceinline__ int perm32(int rho) { const int n = rho >> 4, i = rho & 15; return 8 * (i >> 2) + 4 * n + (i & 3); }

struct Unit { int pm, pn; };
struct Gemm { const bf16_t* A; const bf16_t* Bt; int M, N, K; };

struct StaticOrder {
    int nM, nN, nwg, G, c, nrep;
    __device__ void init(int M, int N, int G_, int c_, int nrep_ = 1) { nM = M / BM; nN = N / BM; nwg = nM * nN; G = G_; c = c_; nrep = nrep_; asm volatile("" : "+s"(c), "+s"(G)); }
    __device__ bool next(int i, Unit& u) const {
        long L = (long)i * G + c; if (L >= (long)nwg * nrep) return false;
        if (nrep > 1) L %= nwg;
        int wgid = (int)L; { const int q = nwg / NXCD, r = nwg % NXCD, xcd = wgid % NXCD, off = wgid / NXCD; wgid = (xcd < r ? xcd * (q + 1) : r * (q + 1) + (xcd - r) * q) + off; }
        const int nig = WGM * nN, gid = wgid / nig, fm = gid * WGM, gsz = (nM - fm) < WGM ? (nM - fm) : WGM;
        u.pm = fm + ((wgid % nig) % gsz); u.pn = (wgid % nig) / gsz; return true;
    }
};

struct InOrder : StaticOrder {
    int i0, i1;
    __device__ void init(int M, int N, int G_, int c_, int i0_, int i1_) { StaticOrder::init(M, N, G_, c_, 1); i0 = i0_; i1 = i1_; }
    __device__ bool next(int i, Unit& u) const {
        if (i + i0 >= i1) return false;
        const bool ok = StaticOrder::next(i + i0, u);
        if (ok) u.pn = (u.pn == 0) ? 50 : u.pn - 1;
        return ok;
    }
};
__device__ __forceinline__ unsigned cvt_pk_bf16(float lo, float hi) { unsigned r; asm volatile("v_cvt_pk_bf16_f32 %0, %1, %2" : "=v"(r) : "v"(lo), "v"(hi)); return r; }


struct EpiIn {
    static constexpr bool PERM = true, FOLD = false;
    bf16_t* O; float* flog; const float* rot; const float* bfv;
    __device__ __forceinline__ void operator()(const f32x4 (&acc)[2][2][4][2], const Unit& u, int wr, int wc, int fr, int fq) const {
        const int row0 = u.pm * BM + wr * 64 + fr;
        if (u.pn == 50) {
            if (wc == 0 && fq == 0) {
                const f32x4 b = *(const f32x4*)bfv;
#pragma unroll
                for (int ai = 0; ai < 2; ++ai)
#pragma unroll
                    for (int m = 0; m < 4; ++m) *(f32x4*)(flog + (size_t)(row0 + ai * HALF + m * 16) * 4) = acc[ai][0][m][0] + b;
            }
            return;
        }
        const int col0 = u.pn * BM + wc * 32 + 8 * fq;
        const bool sig = u.pn >= 18;
        const bool rotary = (u.pn >= 4) && (u.pn < 8) && ((wc & 1) == 0);
        const float sg = (fq == 0) ? -1.f : 1.f;
#pragma unroll
        for (int ai = 0; ai < 2; ++ai)
#pragma unroll
            for (int m = 0; m < 4; ++m) {
                const int row = row0 + ai * HALF + m * 16;
                bf16_t* rowp = O + (size_t)row * NP + col0;
                f32x4 v[2][2];
#pragma unroll
                for (int bj = 0; bj < 2; ++bj) { v[bj][0] = acc[ai][bj][m][0]; v[bj][1] = acc[ai][bj][m][1]; }
                if (rotary) {
                    const f32x4* rp = (const f32x4*)(rot + (size_t)row * 16);
#pragma unroll
                    for (int n = 0; n < 2; ++n) {
                        const f32x4 ca = rp[2 * n], cb = rp[2 * n + 1];
                        const float cc[4] = {ca[0], ca[2], cb[0], cb[2]};
                        const float ss[4] = {ca[1] * sg, ca[3] * sg, cb[1] * sg, cb[3] * sg};
#pragma unroll
                        for (int bj = 0; bj < 2; ++bj)
#pragma unroll
                            for (int j = 0; j < 4; ++j) {
                                const float own = v[bj][n][j];
                                const float par = __shfl_xor(own, 16);
                                const float nv = own * cc[j] + par * ss[j];
                                v[bj][n][j] = (fq < 2) ? nv : own;
                            }
                    }
                    asm volatile("" ::: "memory");
                }
#pragma unroll
                for (int bj = 0; bj < 2; ++bj) {
                    f32x4 v0 = v[bj][0], v1 = v[bj][1];
                    if (sig) {
#pragma unroll
                        for (int j = 0; j < 4; ++j) {
                            v0[j] = __builtin_amdgcn_rcpf(1.0f + __builtin_amdgcn_exp2f(v0[j]));
                            v1[j] = __builtin_amdgcn_rcpf(1.0f + __builtin_amdgcn_exp2f(v1[j]));
                        }
                    }
                    u32x4 w; w.x = cvt_pk_bf16(v0[0], v0[1]); w.y = cvt_pk_bf16(v0[2], v0[3]); w.z = cvt_pk_bf16(v1[0], v1[1]); w.w = cvt_pk_bf16(v1[2], v1[3]);
                    *(u32x4*)(rowp + bj * HALF) = w;
                }
            }
    }
};
template <int ACT> struct EpiBf {
    static constexpr bool PERM = true, FOLD = false;
    bf16_t* O; int ldc;
    __device__ __forceinline__ void operator()(const f32x4 (&acc)[2][2][4][2], const Unit& u, int wr, int wc, int fr, int fq) const {
        const int row0 = u.pm * BM + wr * 64 + fr, col0 = u.pn * BM + wc * 32 + 8 * fq;
#pragma unroll
        for (int ai = 0; ai < 2; ++ai)
#pragma unroll
            for (int m = 0; m < 4; ++m) {
                bf16_t* rowp = O + (size_t)(row0 + ai * HALF + m * 16) * ldc + col0;
#pragma unroll
                for (int bj = 0; bj < 2; ++bj) {
                    f32x4 v0 = acc[ai][bj][m][0], v1 = acc[ai][bj][m][1];
#pragma unroll
                    for (int j = 0; j < 4; ++j) { if (ACT == 1) { const float a = fmaxf(v0[j], 0.f), b = fmaxf(v1[j], 0.f); v0[j] = a * a; v1[j] = b * b; } }
                    u32x4 w; w.x = cvt_pk_bf16(v0[0], v0[1]); w.y = cvt_pk_bf16(v0[2], v0[3]); w.z = cvt_pk_bf16(v1[0], v1[1]); w.w = cvt_pk_bf16(v1[2], v1[3]);
                    *(u32x4*)(rowp + bj * HALF) = w;
                }
            }
    }
};
struct EpiF32 {
    static constexpr bool PERM = false, FOLD = false;
    float* C; int ldc;
    __device__ __forceinline__ void operator()(const f32x4 (&acc)[2][2][4][2], const Unit& u, int wr, int wc, int fr, int fq) const {
        const int row0 = u.pm * BM + wr * 64 + fr, col0 = u.pn * BM + wc * 32 + 4 * fq;
#pragma unroll
        for (int ai = 0; ai < 2; ++ai)
#pragma unroll
            for (int m = 0; m < 4; ++m) {
                float* rowp = C + (size_t)(row0 + ai * HALF + m * 16) * ldc + col0;
#pragma unroll
                for (int bj = 0; bj < 2; ++bj)
#pragma unroll
                    for (int n = 0; n < 2; ++n) *(f32x4*)(rowp + bj * HALF + n * 16) = acc[ai][bj][m][n];
            }
    }
};
struct EpiMergeFold {
    static constexpr bool PERM = true, FOLD = true;
    const bf16_t* gate;
    bf16_t* MBo;
    static __device__ __forceinline__ void unpack8(const u32x4 w, float (&f)[8]) {
        f[0] = bflo(w.x); f[1] = bfhi(w.x); f[2] = bflo(w.y); f[3] = bfhi(w.y); f[4] = bflo(w.z); f[5] = bfhi(w.z); f[6] = bflo(w.w); f[7] = bfhi(w.w);
#pragma unroll
        for (int j = 0; j < 8; ++j) f[j] = fmaxf(f[j], 1e-30f);
    }
    static __device__ __forceinline__ float ratio(float n, float d) { return fmaxf(n, 1e-30f) * __builtin_amdgcn_rcpf(fmaxf(d, 1e-30f)); }
    __device__ __forceinline__ void fold(f32x4 (&acc)[2][2][4][2], const Unit& u, int nb, int wr, int wc, int fr, int fq) const {
        const bf16_t* gbase = gate + (size_t)(u.pm * BM + wr * 64 + fr) * NP + (size_t)nb * DM + (u.pn * BM + wc * 32 + 8 * fq);
#pragma unroll
        for (int ai = 0; ai < 2; ++ai) {
            u32x4 wn[4][2], wd[4][2];
#pragma unroll
            for (int m = 0; m < 4; ++m)
#pragma unroll
                for (int bj = 0; bj < 2; ++bj) {
                    const bf16_t* gp = gbase + (size_t)(ai * HALF + m * 16) * NP + bj * HALF;
                    wn[m][bj] = *(const u32x4*)(gp - DM);
                    wd[m][bj] = *(const u32x4*)gp;
                }
#pragma unroll
            for (int m = 0; m < 4; ++m)
#pragma unroll
                for (int bj = 0; bj < 2; ++bj) {
                    const u32x4 a = wn[m][bj], d = wd[m][bj];
                    f32x4 r0, r1;
                    r0[0] = ratio(bflo(a.x), bflo(d.x)); r0[1] = ratio(bfhi(a.x), bfhi(d.x)); r0[2] = ratio(bflo(a.y), bflo(d.y)); r0[3] = ratio(bfhi(a.y), bfhi(d.y));
                    r1[0] = ratio(bflo(a.z), bflo(d.z)); r1[1] = ratio(bfhi(a.z), bfhi(d.z)); r1[2] = ratio(bflo(a.w), bflo(d.w)); r1[3] = ratio(bfhi(a.w), bfhi(d.w));
                    acc[ai][bj][m][0] *= r0; acc[ai][bj][m][1] *= r1;
                }
            asm volatile("" ::: "memory");
        }
    }
    __device__ __forceinline__ void operator()(const f32x4 (&acc)[2][2][4][2], const Unit& u, int wr, int wc, int fr, int fq) const {
        const int row0 = u.pm * BM + wr * 64 + fr, col0 = u.pn * BM + wc * 32 + 8 * fq;
        u32x4 gw[2][4][2];
#pragma unroll
        for (int ai = 0; ai < 2; ++ai)
#pragma unroll
            for (int m = 0; m < 4; ++m)
#pragma unroll
                for (int bj = 0; bj < 2; ++bj) gw[ai][m][bj] = *(const u32x4*)(gate + (size_t)(row0 + ai * HALF + m * 16) * NP + (size_t)3 * DM + col0 + bj * HALF);
#pragma unroll
        for (int ai = 0; ai < 2; ++ai)
#pragma unroll
            for (int m = 0; m < 4; ++m) {
                bf16_t* rowp = MBo + (size_t)(row0 + ai * HALF + m * 16) * DM + col0;
#pragma unroll
                for (int bj = 0; bj < 2; ++bj) {
                    float g[8]; unpack8(gw[ai][m][bj], g);
                    const f32x4 v0 = acc[ai][bj][m][0], v1 = acc[ai][bj][m][1];
                    u32x4 w; w.x = cvt_pk_bf16(v0[0] * g[0], v0[1] * g[1]); w.y = cvt_pk_bf16(v0[2] * g[2], v0[3] * g[3]); w.z = cvt_pk_bf16(v1[0] * g[4], v1[1] * g[5]); w.w = cvt_pk_bf16(v1[2] * g[6], v1[3] * g[7]);
                    *(u32x4*)(rowp + bj * HALF) = w;
                }
            }
    }
};

template <class Epi, class Sched, bool ALIGN_EPI = true, bool SP2 = true>
__device__ __forceinline__ void gemm_phase(LAS unsigned char* lds, const Gemm g, const Sched& S, const Epi& E) {
    int tid = threadIdx.x; asm volatile("" : "+v"(tid));
    const int wid = __builtin_amdgcn_readfirstlane(tid >> 6), lane = tid & 63, wr = wid >> 2, wc = wid & 3, fr = lane & 15, fq = lane >> 4;
    const int K = g.K, nt = K / BK;
    unsigned voffA[2], voffB[2];
#pragma unroll
    for (int i = 0; i < 2; ++i) { int R, C; stage_rc(tid * 16 + i * 8192, R, C); const int Rb = Epi::PERM ? ((R & ~31) + perm32(R & 31)) : R;
        voffA[i] = (unsigned)(R * K + C) * 2u; voffB[i] = (unsigned)(Rb * K + C) * 2u; }
    const size_t kstep = (size_t)(BK * 2);
    const size_t hstep = (size_t)HALF * K * 2;
    const size_t tstep = 2 * hstep;
    const unsigned ldsw = (unsigned)wid * 1024u;
    const int aoff = lds_byte(wr * 64 + fr, fq * 8), boff = lds_byte(wc * 32 + fr, fq * 8);
#define PG8_SA(b, h) (((b) * 2 + (h)) * HTB)
#define PG8_SB(b, h) ((4 + (b) * 2 + (h)) * HTB)
#define PG8_STAGE(bufoff, gbase, voff) do { _Pragma("unroll") for (int _i = 0; _i < 2; ++_i) \
        __builtin_amdgcn_global_load_lds((const unsigned*)((const char*)(gbase) + (voff)[_i]), (LAS unsigned*)(lds + (bufoff) + ldsw + _i * 8192), 16, 0, 0); } while (0)
#define PG8_LDA(dst, b, h) do { _Pragma("unroll") for (int m = 0; m < 4; ++m) _Pragma("unroll") for (int k = 0; k < 2; ++k) dst[m][k] = *(const LAS bf16x8*)(lds + PG8_SA(b, h) + aoff + m * 2048 + k * 1024); } while (0)
#define PG8_LDB(dst, b, h) do { _Pragma("unroll") for (int n = 0; n < 2; ++n) _Pragma("unroll") for (int k = 0; k < 2; ++k) dst[n][k] = *(const LAS bf16x8*)(lds + PG8_SB(b, h) + boff + n * 2048 + k * 1024); } while (0)
#define PG8_MMA(ai, bj, At, Bt) do { __builtin_amdgcn_s_setprio(1); _Pragma("unroll") for (int m = 0; m < 4; ++m) _Pragma("unroll") for (int n = 0; n < 2; ++n) _Pragma("unroll") for (int k = 0; k < 2; ++k) \
        acc[ai][bj][m][n] = __builtin_amdgcn_mfma_f32_16x16x32_bf16(Bt[n][k], At[m][k], acc[ai][bj][m][n], 0, 0, 0); __builtin_amdgcn_s_setprio(0); } while (0)
#define PG8_WAIT_V(n) asm volatile("s_waitcnt vmcnt(" #n ")" ::: "memory")
#define PG8_WAIT_L(n) asm volatile("s_waitcnt lgkmcnt(" #n ")" ::: "memory")
#define PG8_BAR __builtin_amdgcn_s_barrier()
#define PG8_SCHED __builtin_amdgcn_sched_barrier(0)
    Unit cur, nxt; int ui = 0;
    if (!S.next(0, cur)) return;
    f32x4 acc[2][2][4][2];
#pragma unroll
    for (int a = 0; a < 2; ++a)
#pragma unroll
        for (int b = 0; b < 2; ++b)
#pragma unroll
            for (int m = 0; m < 4; ++m)
#pragma unroll
                for (int n = 0; n < 2; ++n) acc[a][b][m][n] = (f32x4){0.f, 0.f, 0.f, 0.f};
    bf16x8 At[4][2], B0[2][2], B1[2][2];
    const char* cA = (const char*)g.A + (size_t)cur.pm * tstep; const char* cB = (const char*)g.Bt + (size_t)cur.pn * tstep;
    if constexpr (SP2) {
        PG8_STAGE(PG8_SB(0, 0), cB, voffB); PG8_STAGE(PG8_SB(0, 1), cB + hstep, voffB); PG8_STAGE(PG8_SA(0, 0), cA, voffA); PG8_STAGE(PG8_SA(0, 1), cA + hstep, voffA);
        if (wr == 1) PG8_BAR;
        PG8_WAIT_V(2); PG8_BAR;
        PG8_STAGE(PG8_SB(1, 0), cB + kstep, voffB); PG8_STAGE(PG8_SA(1, 0), cA + kstep, voffA); PG8_STAGE(PG8_SB(1, 1), cB + hstep + kstep, voffB);
        PG8_WAIT_V(6); PG8_BAR;
    } else {
        PG8_STAGE(PG8_SB(0, 0), cB, voffB); PG8_STAGE(PG8_SA(0, 0), cA, voffA); PG8_STAGE(PG8_SB(0, 1), cB + hstep, voffB); PG8_STAGE(PG8_SA(0, 1), cA + hstep, voffA);
        if (wr == 1) PG8_BAR;
        PG8_WAIT_V(4); PG8_BAR;
        PG8_STAGE(PG8_SB(1, 0), cB + kstep, voffB); PG8_STAGE(PG8_SA(1, 0), cA + kstep, voffA); PG8_STAGE(PG8_SB(1, 1), cB + hstep + kstep, voffB);
        PG8_WAIT_V(6); PG8_BAR;
    }
    for (;;) {
        const bool has_next = S.next(ui + 1, nxt);
        const char* nA = has_next ? (const char*)g.A + (size_t)nxt.pm * tstep : cA; const char* nB = has_next ? (const char*)g.Bt + (size_t)nxt.pn * tstep : cB;
        for (int t = 0; t < nt; t += 2) {
            const bool last = (t == nt - 2);
            const char* a1 = cA + (size_t)(t + 1) * kstep;
            const char* a2 = last ? nA : cA + (size_t)(t + 2) * kstep; const char* b2 = last ? nB : cB + (size_t)(t + 2) * kstep;
            const char* a3 = a2 + kstep; const char* b3 = b2 + kstep;
            if constexpr (Epi::FOLD) { if (t > 0 && (t & 7) == 0) E.fold(acc, cur, t >> 3, wr, wc, fr, fq); }
            if constexpr (SP2) {
            PG8_LDB(B0, 0, 0); PG8_LDB(B1, 0, 1); PG8_SCHED; PG8_LDA(At, 0, 0); PG8_STAGE(PG8_SA(1, 1), a1 + hstep, voffA);
            PG8_WAIT_V(8); PG8_WAIT_L(0); PG8_BAR; PG8_MMA(0, 0, At, B0); PG8_MMA(0, 1, At, B1); PG8_BAR; PG8_SCHED;
            PG8_LDA(At, 0, 1); PG8_STAGE(PG8_SB(0, 0), b2, voffB); PG8_STAGE(PG8_SB(0, 1), b2 + hstep, voffB); PG8_STAGE(PG8_SA(0, 0), a2, voffA);
            PG8_WAIT_V(8); PG8_WAIT_L(0); PG8_BAR; PG8_MMA(1, 0, At, B0); PG8_MMA(1, 1, At, B1); PG8_BAR; PG8_SCHED;
            PG8_LDB(B0, 1, 0); PG8_LDB(B1, 1, 1); PG8_SCHED; PG8_LDA(At, 1, 0); PG8_STAGE(PG8_SA(0, 1), a2 + hstep, voffA);
            PG8_WAIT_V(8); PG8_WAIT_L(0); PG8_BAR; PG8_MMA(0, 0, At, B0); PG8_MMA(0, 1, At, B1); PG8_BAR; PG8_SCHED;
            PG8_LDA(At, 1, 1); PG8_STAGE(PG8_SB(1, 0), b3, voffB); PG8_STAGE(PG8_SB(1, 1), b3 + hstep, voffB); PG8_STAGE(PG8_SA(1, 0), a3, voffA);
            PG8_WAIT_V(8); PG8_WAIT_L(0); PG8_BAR; PG8_MMA(1, 0, At, B0); PG8_MMA(1, 1, At, B1); PG8_BAR; PG8_SCHED;
            } else {
            PG8_LDB(B0, 0, 0); PG8_SCHED; PG8_LDA(At, 0, 0); PG8_STAGE(PG8_SA(1, 1), a1 + hstep, voffA);
            PG8_WAIT_L(8); PG8_BAR; PG8_WAIT_L(0); PG8_MMA(0, 0, At, B0); PG8_BAR; PG8_SCHED;
            PG8_LDB(B1, 0, 1); PG8_STAGE(PG8_SB(0, 0), b2, voffB);
            PG8_BAR; PG8_WAIT_L(0); PG8_MMA(0, 1, At, B1); PG8_BAR;
            PG8_LDA(At, 0, 1); PG8_STAGE(PG8_SA(0, 0), a2, voffA);
            PG8_BAR; PG8_WAIT_L(0); PG8_MMA(1, 0, At, B0); PG8_BAR; PG8_SCHED;
            PG8_STAGE(PG8_SB(0, 1), b2 + hstep, voffB);
            PG8_WAIT_V(6); PG8_BAR; PG8_MMA(1, 1, At, B1); PG8_BAR;
            PG8_LDB(B0, 1, 0); PG8_SCHED; PG8_LDA(At, 1, 0); PG8_STAGE(PG8_SA(0, 1), a2 + hstep, voffA);
            PG8_WAIT_L(8); PG8_BAR; PG8_WAIT_L(0); PG8_MMA(0, 0, At, B0); PG8_BAR; PG8_SCHED;
            PG8_LDB(B1, 1, 1); PG8_STAGE(PG8_SB(1, 0), b3, voffB);
            PG8_BAR; PG8_WAIT_L(0); PG8_MMA(0, 1, At, B1); PG8_BAR;
            PG8_LDA(At, 1, 1); PG8_STAGE(PG8_SA(1, 0), a3, voffA);
            PG8_BAR; PG8_WAIT_L(0); PG8_MMA(1, 0, At, B0); PG8_BAR; PG8_SCHED;
            PG8_STAGE(PG8_SB(1, 1), b3 + hstep, voffB);
            PG8_WAIT_V(6); PG8_BAR; PG8_MMA(1, 1, At, B1); PG8_BAR;
            }
        }
        if constexpr (ALIGN_EPI) { if (wr == 0) PG8_BAR; }
        E(acc, cur, wr, wc, fr, fq);
        if (!has_next) break;
#pragma unroll
        for (int a = 0; a < 2; ++a)
#pragma unroll
            for (int b = 0; b < 2; ++b)
#pragma unroll
                for (int m = 0; m < 4; ++m)
#pragma unroll
                    for (int n = 0; n < 2; ++n) acc[a][b][m][n] = (f32x4){0.f, 0.f, 0.f, 0.f};
        cur = nxt; cA = nA; cB = nB; ++ui;
        if constexpr (ALIGN_EPI) { if (wr == 1) PG8_BAR; }
    }
    PG8_WAIT_V(0);
    if constexpr (!ALIGN_EPI) { if (wr == 0) PG8_BAR; }
    PG8_BAR;
#undef PG8_SA
#undef PG8_SB
#undef PG8_STAGE
#undef PG8_LDA
#undef PG8_LDB
#undef PG8_MMA
#undef PG8_WAIT_V
#undef PG8_WAIT_L
#undef PG8_BAR
#undef PG8_SCHED
}
}

struct Args {
    const float* x; const int* pos;
    const float *n_mix_pre, *n_mix_post, *n_ffn_pre, *n_ffn_post, *w_in, *gm_ln_g, *gm_ln_b, *gm_w_s, *gm_b_s, *da_lambda, *da_subln_g, *fa_b_f,
                *pool_w, *pool_scale, *w_branch, *w_out, *w_ffn_up, *w_ffn_down;
    float* out; unsigned char* ws;
};

struct TrDesc { const float* sp; size_t ld; bf16_t* dp; int K; float scale; bool ok; };
__device__ __forceinline__ void tr_load(const TrDesc& d, f32x4 (&v)[16]) {
#pragma unroll
    for (int i = 0; i < 16; ++i) v[i] = d.ok ? __builtin_nontemporal_load((const f32x4*)(d.sp + (size_t)(4 * i) * d.ld)) : (f32x4){0.f, 0.f, 0.f, 0.f};
}
__device__ __forceinline__ void tr_finish(const TrDesc& d, const f32x4 (&v)[16], LAS float* scr, int lane) {
    const int c4 = (lane & 15) * 4, kr = lane >> 4;
#pragma unroll
    for (int i = 0; i < 16; ++i) {
        LAS float* p = scr + (4 * i + kr) * 65 + c4;
        p[0] = v[i][0] * d.scale; p[1] = v[i][1] * d.scale; p[2] = v[i][2] * d.scale; p[3] = v[i][3] * d.scale;
    }
    LDS_WAIT();
    const int c = lane & 7;
#pragma unroll
    for (int j = 0; j < 8; ++j) {
        const int n = (lane >> 3) + 8 * j;
        const LAS float* s = scr + (8 * c) * 65 + n;
        u32x4 o; o.x = pg8::cvt_pk_bf16(s[0], s[65]); o.y = pg8::cvt_pk_bf16(s[2 * 65], s[3 * 65]); o.z = pg8::cvt_pk_bf16(s[4 * 65], s[5 * 65]); o.w = pg8::cvt_pk_bf16(s[6 * 65], s[7 * 65]);
        *(u32x4*)(d.dp + (size_t)n * d.K + 8 * c) = o;
    }
    LDS_WAIT();
}

__device__ __forceinline__ void rms_row_bf16(const float* xrow, const f32x4 (&gv)[8], bf16_t* orow, int lane) {
    f32x4 v[8]; float s = 0.f;
#pragma unroll
    for (int j = 0; j < 8; ++j) { v[j] = *((const f32x4*)xrow + lane + 64 * j); s += (v[j][0] * v[j][0] + v[j][1] * v[j][1]) + (v[j][2] * v[j][2] + v[j][3] * v[j][3]); }
    const float rstd = 1.0f / sqrtf(wave_sum(s) * (1.0f / DM) + NORM_EPS);
#pragma unroll
    for (int j = 0; j < 8; ++j) {
        u32x2 w; w.x = pk2(v[j][0] * rstd * gv[j][0], v[j][1] * rstd * gv[j][1]); w.y = pk2(v[j][2] * rstd * gv[j][2], v[j][3] * rstd * gv[j][3]);
        *((u32x2*)orow + lane + 64 * j) = w;
    }
}

__device__ __forceinline__ void phase0(const Args& a, LAS unsigned char* lds, int gw, int NGW, int wave, int lane) {
    LAS float* scr = (LAS float*)(lds + wave * 16640);
    constexpr int I_IN = 32 * 204, I_BR = 4 * 8 * 32, I_OUT = 32 * 32, I_UP = 32 * 128, I_DN = 128 * 32, I_POOL = 16;
    constexpr int I_LAYER = I_IN + I_BR + I_OUT + I_UP + I_DN + I_POOL, I_ALL = DEPTH * I_LAYER;
    const int c4 = (lane & 15) * 4, kr = lane >> 4;
    auto decode = [&](int it) -> TrDesc {
        const int l = it / I_LAYER; int r = it - l * I_LAYER;
        unsigned char* wl = a.ws + WS_W + (size_t)l * WL_STRIDE;
        const float* src; size_t ld; int sc, nv = 64, k0, n0, K; bf16_t* dst; float scale = 1.0f;
        if (r < I_IN) {
            const int kb = r / 204, nb = r % 204; n0 = nb * 64; k0 = kb * 64;
            if (nb < 64) { sc = n0; } else if (nb < 200) { sc = n0 + 4; } else if (nb == 200) { sc = 4096; nv = 4; } else { sc = 0; nv = 0; }
            src = a.w_in + (size_t)l * DM * INC; ld = INC; dst = (bf16_t*)(wl + WO_IN); K = DM;
            scale = (nb >= 72 && nb < 200) ? -LOG2E : 1.0f;
        } else if ((r -= I_IN) < I_BR) {
            const int n = r / 256, rr = r % 256, kb = rr / 32, nb = rr % 32; n0 = nb * 64; k0 = kb * 64; sc = n0;
            src = a.w_branch + ((size_t)l * 4 + n) * 512 * DM; ld = DM; dst = (bf16_t*)(wl + WO_BR) + n * 512; K = DM;
        } else if ((r -= I_BR) < I_OUT) {
            const int kb = r / 32, nb = r % 32; n0 = nb * 64; k0 = kb * 64; sc = n0;
            src = a.w_out + (size_t)l * DM * DM; ld = DM; dst = (bf16_t*)(wl + WO_OUT); K = DM;
        } else if ((r -= I_OUT) < I_UP) {
            const int kb = r / 128, nb = r % 128; n0 = nb * 64; k0 = kb * 64; sc = n0;
            src = a.w_ffn_up + (size_t)l * DM * FFN; ld = FFN; dst = (bf16_t*)(wl + WO_UP); K = DM;
        } else if ((r -= I_UP) < I_DN) {
            const int kb = r / 32, nb = r % 32; n0 = nb * 64; k0 = kb * 64; sc = n0;
            src = a.w_ffn_down + (size_t)l * FFN * DM; ld = DM; dst = (bf16_t*)(wl + WO_DN); K = FFN;
        } else {
            r -= I_DN;
            const int g = r / 4, rr = r % 4, kb = rr / 2, nb = rr % 2; n0 = nb * 64; k0 = kb * 64; sc = n0;
            src = a.pool_w + ((size_t)l * 4 + g) * 128 * 128; ld = 128; dst = (bf16_t*)(wl + WO_POOL) + (size_t)g * 128 * 128; K = 128;
        }
        TrDesc d; d.sp = src + (size_t)(k0 + kr) * ld + sc + c4; d.ld = ld; d.dp = dst + (size_t)n0 * K + k0; d.K = K; d.scale = scale; d.ok = c4 < nv;
        return d;
    };
    {
        int it = gw; TrDesc dA, dB; f32x4 vA[16], vB[16];
        if (it < I_ALL) { dA = decode(it); tr_load(dA, vA); }
        while (it < I_ALL) {
            const int itB = it + NGW;
            if (itB < I_ALL) { dB = decode(itB); tr_load(dB, vB); }
            tr_finish(dA, vA, scr, lane);
            const int itA = itB + NGW;
            if (itA < I_ALL) { dA = decode(itA); tr_load(dA, vA); }
            if (itB < I_ALL) tr_finish(dB, vB, scr, lane);
            it = itA;
        }
    }
    {
        float* rot = (float*)(a.ws + WS_ROT);
        const float inv[8] = {1.0f, 0.193922758102417f, 0.03760603070259094f, 0.00729266507551074f, 0.001414213445968926f, 0.00027424818836152554f, 5.318296462064609e-05f, 1.0313385246263351e-05f};
        for (int e = gw * 64 + lane; e < MROWS * 8; e += NGW * 64) {
            const int row = e >> 3, i = e & 7;
            float iv = inv[0];
#pragma unroll
            for (int q = 1; q < 8; ++q) iv = (i == q) ? inv[q] : iv;
            const float ang = (float)a.pos[row] * iv;
            const double ad = (double)ang;
            const double kk = __builtin_rint(ad * 0.15915494309189535);
            const float rr = (float)(ad - kk * 6.283185307179586);
            rot[2 * e] = cosf(rr); rot[2 * e + 1] = sinf(rr);
        }
    }
    {
        f32x4 g0[8];
#pragma unroll
        for (int j = 0; j < 8; ++j) g0[j] = *((const f32x4*)a.n_mix_pre + lane + 64 * j);
        for (int m = gw; m < MROWS; m += NGW) rms_row_bf16(a.x + (size_t)m * DM, g0, (bf16_t*)(a.ws + WS_XN) + (size_t)m * DM, lane);
    }
}

template <bool HIN_BF, bool HOUT_BF>
__device__ __forceinline__ void row_phase(const bf16_t* Y, const void* hin, void* hout, const float* gpost, const float* gpre, bf16_t* XN, int gw, int NGW, int lane) {
    f32x4 gpo[8], gpr[8];
#pragma unroll
    for (int j = 0; j < 8; ++j) { gpo[j] = *((const f32x4*)gpost + lane + 64 * j); gpr[j] = gpre ? *((const f32x4*)gpre + lane + 64 * j) : (f32x4){0.f, 0.f, 0.f, 0.f}; }
    for (int m = gw; m < MROWS; m += NGW) {
        const u32x2* yr = (const u32x2*)(Y + (size_t)m * DM);
        u32x2 yw[8]; u32x2 hw[8]; f32x4 hf[8];
#pragma unroll
        for (int j = 0; j < 8; ++j) yw[j] = yr[lane + 64 * j];
#pragma unroll
        for (int j = 0; j < 8; ++j) {
            if (HIN_BF) hw[j] = *((const u32x2*)((const bf16_t*)hin + (size_t)m * DM) + lane + 64 * j);
            else hf[j] = *((const f32x4*)((const float*)hin + (size_t)m * DM) + lane + 64 * j);
        }
        f32x4 v[8]; float s = 0.f;
#pragma unroll
        for (int j = 0; j < 8; ++j) { v[j] = (f32x4){bflo(yw[j].x), bfhi(yw[j].x), bflo(yw[j].y), bfhi(yw[j].y)}; s += (v[j][0] * v[j][0] + v[j][1] * v[j][1]) + (v[j][2] * v[j][2] + v[j][3] * v[j][3]); }
        const float rstd = 1.0f / sqrtf(wave_sum(s) * (1.0f / DM) + NORM_EPS);
        float s2 = 0.f;
#pragma unroll
        for (int j = 0; j < 8; ++j) {
            f32x4 h;
            if (HIN_BF) h = (f32x4){bflo(hw[j].x), bfhi(hw[j].x), bflo(hw[j].y), bfhi(hw[j].y)}; else h = hf[j];
            v[j] = h + v[j] * rstd * gpo[j];
            if (HOUT_BF) { u32x2 w; w.x = pk2(v[j][0], v[j][1]); w.y = pk2(v[j][2], v[j][3]); *((u32x2*)((bf16_t*)hout + (size_t)m * DM) + lane + 64 * j) = w; }
            else *((f32x4*)((float*)hout + (size_t)m * DM) + lane + 64 * j) = v[j];
            s2 += (v[j][0] * v[j][0] + v[j][1] * v[j][1]) + (v[j][2] * v[j][2] + v[j][3] * v[j][3]);
        }
        if (gpre) {
            const float rstd2 = 1.0f / sqrtf(wave_sum(s2) * (1.0f / DM) + NORM_EPS);
#pragma unroll
            for (int j = 0; j < 8; ++j) {
                const f32x4 gv = gpr[j];
                u32x2 w; w.x = pk2(v[j][0] * rstd2 * gv[0], v[j][1] * rstd2 * gv[1]); w.y = pk2(v[j][2] * rstd2 * gv[2], v[j][3] * rstd2 * gv[3]);
                *((u32x2*)(XN + (size_t)m * DM) + lane + 64 * j) = w;
            }
        }
    }
}

constexpr int KSTR = 272;
constexpr int VSTR = 144;
constexpr int KBUF = 64 * KSTR;
constexpr int VBUF = 128 * VSTR;
constexpr int L_K0 = 0, L_V0 = 2 * KBUF, L_CUM = L_V0 + 2 * VBUF  , L_STAT = L_CUM + 8192  , L_WT = L_STAT + 1024  ;

struct KRegs { u32x4 a, b; };
struct VRegs { u32x4 a, b; };

__device__ __forceinline__ KRegs k_load(const bf16_t* base  , int tid) {
    const bf16_t* p = base + (size_t)(tid >> 3) * NP + (tid & 7) * 16;
    KRegs r; r.a = *(const u32x4*)p; r.b = *(const u32x4*)(p + 8); return r;
}
__device__ __forceinline__ void k_store(LAS unsigned char* buf, const KRegs& r, int tid) {
    LAS unsigned char* d = buf + (tid >> 3) * KSTR + (tid & 7) * 32;
    *(LAS u32x4*)d = r.a; *(LAS u32x4*)(d + 16) = r.b;
}
__device__ __forceinline__ void v_map(int tid, int& chunk, int& pair) { const int w = tid >> 6, l = tid & 63; chunk = 4 * (w & 3) + (l & 3); pair = 16 * (w >> 2) + (l >> 2); }
__device__ __forceinline__ VRegs v_load(const bf16_t* base, int tid) {
    int chunk, pair; v_map(tid, chunk, pair);
    const bf16_t* p = base + (size_t)(2 * pair) * NP + chunk * 8;
    VRegs r; r.a = *(const u32x4*)p; r.b = *(const u32x4*)(p + NP); return r;
}
__device__ __forceinline__ void v_store_words(LAS unsigned char* buf, const unsigned (&wa)[4], const unsigned (&wb)[4], int tid) {
    int chunk, pair; v_map(tid, chunk, pair);
    LAS unsigned char* d = buf + (8 * chunk) * VSTR + ((pair * 4) ^ ((chunk & 1) << 6));
#pragma unroll
    for (int i = 0; i < 4; ++i) {
        *(LAS unsigned*)(d + (2 * i) * VSTR) = (wa[i] & 0xffffu) | (wb[i] << 16);
        *(LAS unsigned*)(d + (2 * i + 1) * VSTR) = (wa[i] >> 16) | (wb[i] & 0xffff0000u);
    }
}
__device__ __forceinline__ void v_store(LAS unsigned char* buf, const VRegs& r, int tid) {
    const unsigned wa[4] = {r.a.x, r.a.y, r.a.z, r.a.w}, wb[4] = {r.b.x, r.b.y, r.b.z, r.b.w};
    v_store_words(buf, wa, wb, tid);
}

__device__ __forceinline__ void pv_mma(f32x4 (&o)[8], const LAS unsigned char* vbuf, const bf16x8 (&pf)[2], int lane) {
    const LAS unsigned char* vp = vbuf + (lane & 15) * VSTR + (lane >> 4) * 16;
#pragma unroll
    for (int mb = 0; mb < 8; ++mb)
#pragma unroll
        for (int pr = 0; pr < 2; ++pr) {
            const bf16x8 vf = *(const LAS bf16x8*)(vp + mb * 16 * VSTR + ((pr ^ (((lane & 15) >> 3) & 1)) << 6));
            o[mb] = __builtin_amdgcn_mfma_f32_16x16x32_bf16(vf, pf[pr], o[mb], 0, 0, 0);
        }
}

__device__ __forceinline__ void softmax_tile(f32x4 (&s)[4], const f32x4 (&add)[4], float cs, float& lsum, bf16x8 (&pf)[2]) {
    float ps = 0.f;
#pragma unroll
    for (int rb = 0; rb < 4; ++rb)
#pragma unroll
        for (int j = 0; j < 4; ++j) { s[rb][j] = __builtin_amdgcn_exp2f(fminf(fmaf(s[rb][j], cs, add[rb][j]), 126.f)); ps += s[rb][j]; }
    lsum += ps;
#pragma unroll
    for (int pr = 0; pr < 2; ++pr) {
        u32x4 w; w.x = pg8::cvt_pk_bf16(s[2 * pr][0], s[2 * pr][1]); w.y = pg8::cvt_pk_bf16(s[2 * pr][2], s[2 * pr][3]); w.z = pg8::cvt_pk_bf16(s[2 * pr + 1][0], s[2 * pr + 1][1]); w.w = pg8::cvt_pk_bf16(s[2 * pr + 1][2], s[2 * pr + 1][3]);
        pf[pr] = __builtin_bit_cast(bf16x8, w);
    }
}

template <bool DIFF>
__device__ __forceinline__ void attn_unit(const Args& a, int layer, int bh, int qb, LAS unsigned char* lds, int tid) {
    const int wave = tid >> 6, lane = tid & 63, l15 = lane & 15, quad = lane >> 4;
    const int b = bh >> 2, h = bh & 3;
    const bf16_t* proj = (const bf16_t*)(a.ws + WS_PROJ) + (size_t)b * SEQ * NP;
    const bf16_t* Qg = proj + (DIFF ? P_BQ : P_CQ) + h * 128;
    const bf16_t* Kg = proj + (DIFF ? P_BK : P_CK) + h * 128;
    const bf16_t* Vg = proj + (DIFF ? P_BV : P_CV) + h * 128;
    const int q0 = qb * 128, ntiles = 2 * qb + 2;
    __syncthreads();
    { KRegs r0 = k_load(Qg + (size_t)q0 * NP, tid), r1 = k_load(Qg + (size_t)(q0 + 64) * NP, tid);
      k_store(lds + L_K0, r0, tid); k_store(lds + L_K0 + KBUF, r1, tid); }
    if (!DIFF) {
        const float* fl = (const float*)(a.ws + WS_FLOG) + (size_t)b * SEQ * 4 + h;
        const int nk = q0 + 128;
        float v[4];
#pragma unroll
        for (int i = 0; i < 4; ++i) {
            const int k = 4 * tid + i;
            float z = (k < nk) ? fl[(size_t)k * 4] : 0.f;
            float ls = fminf(z, 0.f) - log1pf(expf(-fabsf(z)));
            v[i] = (k < nk) ? ls : 0.f;
        }
        const float s0 = v[0], s1 = s0 + v[1], s2 = s1 + v[2], s3 = s2 + v[3];
        float x = s3;
#pragma unroll
        for (int d = 1; d < 64; d <<= 1) { const float y = __shfl_up(x, d); if (lane >= d) x += y; }
        LAS float* wt = (LAS float*)(lds + L_WT);
        if (lane == 63) wt[wave] = x;
        __syncthreads();
        float off = 0.f;
#pragma unroll
        for (int w = 0; w < 8; ++w) off += (w < wave) ? wt[w] : 0.f;
        const float ex = off + x - s3;
        LAS f32x4* cum = (LAS f32x4*)(lds + L_CUM);
        cum[tid] = (f32x4){(ex + s0) * LOG2E, (ex + s1) * LOG2E, (ex + s2) * LOG2E, (ex + s3) * LOG2E};
    }
    __syncthreads();
    bf16x8 qf[4];
    {
        const LAS unsigned char* qp = lds + L_K0 + (wave * 16 + l15) * KSTR + quad * 16;
#pragma unroll
        for (int ks = 0; ks < 4; ++ks) qf[ks] = *(const LAS bf16x8*)(qp + ks * 64);
    }
    KRegs kr = k_load(Kg, tid); VRegs vr = v_load(Vg, tid);
    __syncthreads();

    constexpr int NMAP = DIFF ? 2 : 1;
    const float cs = (DIFF ? 0.125f : 0.08838834764831845f) * LOG2E;
    f32x4 o[NMAP][8]; float lsum[NMAP];
#pragma unroll
    for (int mp = 0; mp < NMAP; ++mp) { lsum[mp] = 0.f;
#pragma unroll
        for (int mb = 0; mb < 8; ++mb) o[mp][mb] = (f32x4){0.f, 0.f, 0.f, 0.f}; }
    const int qi = q0 + wave * 16 + l15;
    float cumq = 0.f; if (!DIFF) cumq = *(const LAS float*)(lds + L_CUM + qi * 4);

    for (int jt = 0; jt < ntiles; ++jt) {
        LAS unsigned char* kb = lds + L_K0 + (jt & 1) * KBUF;
        LAS unsigned char* vb = lds + L_V0 + (jt & 1) * VBUF;
        k_store(kb, kr, tid); v_store(vb, vr, tid);
        __syncthreads();
        if (jt + 1 < ntiles) { kr = k_load(Kg + (size_t)(jt + 1) * 64 * NP, tid); vr = v_load(Vg + (size_t)(jt + 1) * 64 * NP, tid); }
        f32x4 s[NMAP][4];
        {
            bf16x8 kf[4][4];
#pragma unroll
            for (int rb = 0; rb < 4; ++rb) {
                const int trow = 32 * (rb >> 1) + 8 * (l15 >> 2) + 4 * (rb & 1) + (l15 & 3);
                const LAS unsigned char* kp = kb + trow * KSTR + quad * 16;
#pragma unroll
                for (int ks = 0; ks < 4; ++ks) kf[rb][ks] = *(const LAS bf16x8*)(kp + ks * 64);
            }
            __builtin_amdgcn_sched_barrier(0);
            __builtin_amdgcn_s_setprio(1);
#pragma unroll
            for (int rb = 0; rb < 4; ++rb) {
                if (DIFF) {
                    f32x4 c0 = (f32x4){0.f, 0.f, 0.f, 0.f}, c1 = c0;
                    c0 = __builtin_amdgcn_mfma_f32_16x16x32_bf16(kf[rb][0], qf[0], c0, 0, 0, 0);
                    c0 = __builtin_amdgcn_mfma_f32_16x16x32_bf16(kf[rb][1], qf[1], c0, 0, 0, 0);
                    c1 = __builtin_amdgcn_mfma_f32_16x16x32_bf16(kf[rb][2], qf[2], c1, 0, 0, 0);
                    c1 = __builtin_amdgcn_mfma_f32_16x16x32_bf16(kf[rb][3], qf[3], c1, 0, 0, 0);
                    s[0][rb] = c0; s[NMAP - 1][rb] = c1;
                } else {
                    f32x4 c0 = (f32x4){0.f, 0.f, 0.f, 0.f};
#pragma unroll
                    for (int ks = 0; ks < 4; ++ks) c0 = __builtin_amdgcn_mfma_f32_16x16x32_bf16(kf[rb][ks], qf[ks], c0, 0, 0, 0);
                    s[0][rb] = c0;
                }
            }
            __builtin_amdgcn_s_setprio(0);
        }
        bf16x8 vf[8][2];
        {
            const LAS unsigned char* vp = vb + l15 * VSTR + quad * 16;
#pragma unroll
            for (int mb = 0; mb < 8; ++mb)
#pragma unroll
                for (int pr = 0; pr < 2; ++pr) vf[mb][pr] = *(const LAS bf16x8*)(vp + mb * 16 * VSTR + ((pr ^ ((l15 >> 3) & 1)) << 6));
        }
        __builtin_amdgcn_sched_barrier(0);
        f32x4 addv[4];
#pragma unroll
        for (int rb = 0; rb < 4; ++rb) {
            const int key0 = jt * 64 + 32 * (rb >> 1) + 8 * quad + 4 * (rb & 1);
            if (!DIFF) addv[rb] = cumq - *(const LAS f32x4*)(lds + L_CUM + key0 * 4);
            else addv[rb] = (f32x4){0.f, 0.f, 0.f, 0.f};
        }
        if (jt >= 2 * qb) {
#pragma unroll
            for (int rb = 0; rb < 4; ++rb) {
                const int key0 = jt * 64 + 32 * (rb >> 1) + 8 * quad + 4 * (rb & 1);
#pragma unroll
                for (int mp = 0; mp < NMAP; ++mp)
#pragma unroll
                    for (int j = 0; j < 4; ++j) s[mp][rb][j] = (key0 + j > qi) ? -INFINITY : s[mp][rb][j];
            }
        }
        bf16x8 pf[NMAP][2];
#pragma unroll
        for (int mp = 0; mp < NMAP; ++mp) softmax_tile(s[mp], addv, cs, lsum[mp], pf[mp]);
        __builtin_amdgcn_s_setprio(1);
#pragma unroll
        for (int mb = 0; mb < 8; ++mb)
#pragma unroll
            for (int pr = 0; pr < 2; ++pr)
#pragma unroll
                for (int mp = 0; mp < NMAP; ++mp) o[mp][mb] = __builtin_amdgcn_mfma_f32_16x16x32_bf16(vf[mb][pr], pf[mp][pr], o[mp][mb], 0, 0, 0);
        __builtin_amdgcn_s_setprio(0);
    }
    float inv[NMAP];
#pragma unroll
    for (int mp = 0; mp < NMAP; ++mp) { float l = lsum[mp]; l += __shfl_xor(l, 16); l += __shfl_xor(l, 32); inv[mp] = 1.0f / l; }
    const size_t orow = (size_t)b * SEQ + qi;
    if (DIFF) {
        const float li = 0.8f - 0.6f * expf(-0.3f * (float)layer);
        const float* lp = a.da_lambda + (size_t)layer * 256;
        float d1 = lp[lane] * lp[64 + lane], d2 = lp[128 + lane] * lp[192 + lane];
        d1 = wave_sum(d1); d2 = wave_sum(d2);
        const float lam = expf(d1) - expf(d2) + li;
        const float c1 = inv[0], c2 = lam * inv[NMAP - 1];
        float ss = 0.f;
#pragma unroll
        for (int mb = 0; mb < 8; ++mb) { o[0][mb] = o[0][mb] * c1 - o[NMAP - 1][mb] * c2; ss += (o[0][mb][0] * o[0][mb][0] + o[0][mb][1] * o[0][mb][1]) + (o[0][mb][2] * o[0][mb][2] + o[0][mb][3] * o[0][mb][3]); }
        ss += __shfl_xor(ss, 16); ss += __shfl_xor(ss, 32);
        const float rstd = (1.0f / sqrtf(ss * (1.0f / 128.0f) + NORM_EPS)) * (1.0f - li);
        const float* sg = a.da_subln_g + (size_t)layer * 128;
        bf16_t* op = (bf16_t*)(a.ws + WS_BR) + orow * DM + 1 * 512 + h * 128 + quad * 4;
        f32x4 sgv[8];
#pragma unroll
        for (int mb = 0; mb < 8; ++mb) sgv[mb] = *(const f32x4*)(sg + mb * 16 + quad * 4);
#pragma unroll
        for (int mb = 0; mb < 8; ++mb) {
            const f32x4 gv = sgv[mb];
            u32x2 w; w.x = pk2(o[0][mb][0] * rstd * gv[0], o[0][mb][1] * rstd * gv[1]); w.y = pk2(o[0][mb][2] * rstd * gv[2], o[0][mb][3] * rstd * gv[3]);
            *(u32x2*)(op + mb * 16) = w;
        }
    } else {
        bf16_t* op = (bf16_t*)(a.ws + WS_BR) + orow * DM + 2 * 512 + h * 128 + quad * 4;
#pragma unroll
        for (int mb = 0; mb < 8; ++mb) {
            const f32x4 v = o[0][mb] * inv[0];
            u32x2 w; w.x = pk2(v[0], v[1]); w.y = pk2(v[2], v[3]);
            *(u32x2*)(op + mb * 16) = w;
        }
    }
}

__device__ __forceinline__ void gmlp_unit(const Args& a, int layer, int unit, LAS unsigned char* lds, int tid) {
    const int wave = tid >> 6, lane = tid & 63, l15 = lane & 15, quad = lane >> 4;
    const int g = unit & 3, bn = unit >> 2;
    const size_t r0 = (size_t)bn * 128;
    const bf16_t* proj = (const bf16_t*)(a.ws + WS_PROJ) + r0 * NP;
    __syncthreads();
    LAS float* stat = (LAS float*)(lds + L_STAT);
    {
        const int t = wave * 16 + (lane >> 2), part = lane & 3;
        const bf16_t* vp = proj + (size_t)t * NP + P_AV + part * 128;
        u32x4 w[16];
#pragma unroll
        for (int j = 0; j < 16; ++j) w[j] = *(const u32x4*)(vp + j * 8);
        float s1 = 0.f, s2 = 0.f;
#pragma unroll
        for (int j = 0; j < 16; ++j) {
            const float f[8] = {bflo(w[j].x), bfhi(w[j].x), bflo(w[j].y), bfhi(w[j].y), bflo(w[j].z), bfhi(w[j].z), bflo(w[j].w), bfhi(w[j].w)};
#pragma unroll
            for (int e = 0; e < 8; ++e) { s1 += f[e]; s2 += f[e] * f[e]; }
        }
        s1 += __shfl_xor(s1, 1); s1 += __shfl_xor(s1, 2); s2 += __shfl_xor(s2, 1); s2 += __shfl_xor(s2, 2);
        const float mu = s1 * (1.0f / 512.0f), var = fmaxf(s2 * (1.0f / 512.0f) - mu * mu, 0.f);
        if (part == 0) { stat[2 * t] = mu; stat[2 * t + 1] = 1.0f / sqrtf(var + NORM_EPS); }
    }
    __syncthreads();
    {
        int chunk, pair; v_map(tid, chunk, pair);
        const float* lg = a.gm_ln_g + (size_t)layer * 512 + g * 128 + chunk * 8;
        const float* lb = a.gm_ln_b + (size_t)layer * 512 + g * 128 + chunk * 8;
        const f32x4 g0 = *(const f32x4*)lg, g1 = *(const f32x4*)(lg + 4), b0 = *(const f32x4*)lb, b1 = *(const f32x4*)(lb + 4);
        const float gg[8] = {g0[0], g0[1], g0[2], g0[3], g1[0], g1[1], g1[2], g1[3]};
        const float bb[8] = {b0[0], b0[1], b0[2], b0[3], b1[0], b1[1], b1[2], b1[3]};
#pragma unroll
        for (int half = 0; half < 2; ++half) {
            const VRegs r = v_load(proj + (size_t)(half * 64) * NP + P_AV + g * 128, tid);
            const int sA = half * 64 + 2 * pair, sB = sA + 1;
            const float muA = stat[2 * sA], rsA = stat[2 * sA + 1], muB = stat[2 * sB], rsB = stat[2 * sB + 1];
            const unsigned ra[4] = {r.a.x, r.a.y, r.a.z, r.a.w}, rb[4] = {r.b.x, r.b.y, r.b.z, r.b.w};
            unsigned wa[4], wb[4];
#pragma unroll
            for (int i = 0; i < 4; ++i) {
                wa[i] = pk2((bflo(ra[i]) - muA) * rsA * gg[2 * i] + bb[2 * i], (bfhi(ra[i]) - muA) * rsA * gg[2 * i + 1] + bb[2 * i + 1]);
                wb[i] = pk2((bflo(rb[i]) - muB) * rsB * gg[2 * i] + bb[2 * i], (bfhi(rb[i]) - muB) * rsB * gg[2 * i + 1] + bb[2 * i + 1]);
            }
            v_store_words(lds + L_V0 + half * VBUF, wa, wb, tid);
        }
    }
    __syncthreads();
    const int t = wave * 16 + l15;
    const float* W = a.gm_w_s + ((size_t)layer * 4 + g) * 128 * 128 + (size_t)t * 128;
    f32x4 o[8];
#pragma unroll
    for (int mb = 0; mb < 8; ++mb) o[mb] = (f32x4){0.f, 0.f, 0.f, 0.f};
#pragma unroll
    for (int st = 0; st < 2; ++st) {
        if (st * 64 <= wave * 16 + 15) {
            bf16x8 pf[2];
#pragma unroll
            for (int pr = 0; pr < 2; ++pr) {
                const int sbase = st * 64 + pr * 32 + quad * 8;
                const f32x4 w0 = *(const f32x4*)(W + sbase), w1 = *(const f32x4*)(W + sbase + 4);
                float f[8] = {w0[0], w0[1], w0[2], w0[3], w1[0], w1[1], w1[2], w1[3]};
#pragma unroll
                for (int j = 0; j < 8; ++j) f[j] = (sbase + j <= t) ? f[j] : 0.f;
                u32x4 w; w.x = pk2(f[0], f[1]); w.y = pk2(f[2], f[3]); w.z = pk2(f[4], f[5]); w.w = pk2(f[6], f[7]);
                pf[pr] = __builtin_bit_cast(bf16x8, w);
            }
            pv_mma(o, lds + L_V0 + st * VBUF, pf, lane);
        }
    }
    const float bs = a.gm_b_s[((size_t)layer * 4 + g) * 128 + t];
    const bf16_t* up = proj + (size_t)t * NP + P_AU + g * 128 + quad * 4;
    bf16_t* op = (bf16_t*)(a.ws + WS_BR) + (r0 + t) * DM + g * 128 + quad * 4;
    u32x2 uwv[8];
#pragma unroll
    for (int mb = 0; mb < 8; ++mb) uwv[mb] = *(const u32x2*)(up + mb * 16);
#pragma unroll
    for (int mb = 0; mb < 8; ++mb) {
        const u32x2 uw = uwv[mb];
        u32x2 w; w.x = pk2(bflo(uw.x) * (o[mb][0] + bs), bfhi(uw.x) * (o[mb][1] + bs)); w.y = pk2(bflo(uw.y) * (o[mb][2] + bs), bfhi(uw.y) * (o[mb][3] + bs));
        *(u32x2*)(op + mb * 16) = w;
    }
}

template <int G_>
__device__ __forceinline__ void pool_unit_t(const Args& a, int layer, int unit, int tid) {
    const int wave = tid >> 6, lane = tid & 63, l15 = lane & 15, quad = lane >> 4;
    constexpr int g = G_; const int tile = unit >> 2;
    const int t = wave * 16 + l15;
    const size_t row = (size_t)tile * 128 + t;
    const int tseq = (int)(row & (SEQ - 1));
    constexpr int win = 2 << g;
    const int cnt = (tseq + 1 < win) ? (tseq + 1) : win;
    const float rc = 1.0f / (float)cnt;
    const bf16_t* hp = (const bf16_t*)(a.ws + WS_PROJ) + row * NP + P_DH + g * 128 + quad * 8;
    const bf16_t* wp = (const bf16_t*)(a.ws + WS_W + (size_t)layer * WL_STRIDE + WO_POOL) + (size_t)g * 128 * 128 + (size_t)l15 * 128 + quad * 8;
    f32x4 o[8];
#pragma unroll
    for (int mb = 0; mb < 8; ++mb) o[mb] = (f32x4){0.f, 0.f, 0.f, 0.f};
#pragma unroll
    for (int ks = 0; ks < 4; ++ks) {
        float acc[8] = {0.f, 0.f, 0.f, 0.f, 0.f, 0.f, 0.f, 0.f};
        float self[8];
        u32x4 wv[win];
#pragma unroll
        for (int i = 0; i < win; ++i) wv[i] = (i < cnt) ? *(const u32x4*)(hp - (size_t)i * NP + ks * 32) : (u32x4){0u, 0u, 0u, 0u};
#pragma unroll
        for (int i = 0; i < win; ++i) {
            const u32x4 w = wv[i];
            const float f[8] = {bflo(w.x), bfhi(w.x), bflo(w.y), bfhi(w.y), bflo(w.z), bfhi(w.z), bflo(w.w), bfhi(w.w)};
#pragma unroll
            for (int j = 0; j < 8; ++j) { acc[j] += f[j]; if (i == 0) self[j] = f[j]; }
        }
        asm volatile("" ::: "memory");
        u32x4 pw; pw.x = pk2(acc[0] * rc - self[0], acc[1] * rc - self[1]); pw.y = pk2(acc[2] * rc - self[2], acc[3] * rc - self[3]);
        pw.z = pk2(acc[4] * rc - self[4], acc[5] * rc - self[5]); pw.w = pk2(acc[6] * rc - self[6], acc[7] * rc - self[7]);
        const bf16x8 pf = __builtin_bit_cast(bf16x8, pw);
#pragma unroll
        for (int mb = 0; mb < 8; ++mb) {
            const bf16x8 wf = *(const bf16x8*)(wp + (size_t)mb * 16 * 128 + ks * 32);
            o[mb] = __builtin_amdgcn_mfma_f32_16x16x32_bf16(wf, pf, o[mb], 0, 0, 0);
        }
    }
    const float* sc = a.pool_scale + (size_t)layer * 512 + g * 128 + quad * 4;
    bf16_t* op = (bf16_t*)(a.ws + WS_BR) + row * DM + 3 * 512 + g * 128 + quad * 4;
    f32x4 svv[8];
#pragma unroll
    for (int mb = 0; mb < 8; ++mb) svv[mb] = *(const f32x4*)(sc + mb * 16);
#pragma unroll
    for (int mb = 0; mb < 8; ++mb) {
        const f32x4 sv = svv[mb];
        u32x2 w; w.x = pk2(o[mb][0] * sv[0], o[mb][1] * sv[1]); w.y = pk2(o[mb][2] * sv[2], o[mb][3] * sv[3]);
        *(u32x2*)(op + mb * 16) = w;
    }
}

__device__ __forceinline__ void mixer_phase(const Args& a, int cidx, int layer, LAS unsigned char* lds, int tid_) {
    int tid = tid_; asm volatile("" : "+v"(tid));
    unsigned* ctr = (unsigned*)(a.ws + WS_CTL) + 64 * cidx;
    LAS unsigned* slot = (LAS unsigned*)(lds + LDS_MISC);
    {
        const unsigned char* wl = a.ws + WS_W + (size_t)layer * WL_STRIDE;
        pg8::Gemm g{(const bf16_t*)(a.ws + WS_XN), (const bf16_t*)(wl + WO_IN), MROWS, NIN, DM};
        pg8::InOrder S; S.init(MROWS, NIN, (int)gridDim.x, (int)blockIdx.x, gridDim.x == 256 ? 6 : (1 << 30), 1 << 30);
        pg8::EpiIn E{(bf16_t*)(a.ws + WS_PROJ), (float*)(a.ws + WS_FLOG), (const float*)(a.ws + WS_ROT), a.fa_b_f + layer * 4};
        pg8::gemm_phase<pg8::EpiIn, pg8::InOrder>(lds, g, S, E);
    }
    for (;;) {
        __syncthreads();
        if (tid == 0) slot[0] = atomicAdd(ctr, 1u);
        __syncthreads();
        const int idx = (int)slot[0];
        if (idx >= 1024) break;
        int tu = tid; asm volatile("" : "+v"(tu));
        if (idx < 512) {
            const int qb = 15 - (idx >> 5), r = idx & 31, bh = r & 15;
            if (r < 16) attn_unit<true>(a, layer, bh, qb, lds, tu); else attn_unit<false>(a, layer, bh, qb, lds, tu);
        } else if (idx < 768) gmlp_unit(a, layer, idx - 512, lds, tu);
        else { const int pu = idx - 768; switch (pu & 3) { case 0: pool_unit_t<0>(a, layer, pu, tu); break; case 1: pool_unit_t<1>(a, layer, pu, tu); break; case 2: pool_unit_t<2>(a, layer, pu, tu); break; default: pool_unit_t<3>(a, layer, pu, tu); break; } }
    }
}

#define XB_TMO      128
#define XB_XCNT(j)  (256  + 64 * (j))
#define XB_XSUB(j)  (1280 + 64 * (j))
#define XB_XGEN(j)  (2304 + 64 * (j))
#define XB_TOP      3328
#define XB_TOPGEN   3392
#define XCD_BAR_WORDS 3456
#define XB_SPIN_CAP (1u << 22)
__device__ __forceinline__ unsigned xb_ld(unsigned* p)              { return __hip_atomic_load(p, __ATOMIC_RELAXED, __HIP_MEMORY_SCOPE_AGENT); }
__device__ __forceinline__ unsigned xb_add(unsigned* p, unsigned v) { return __hip_atomic_fetch_add(p, v, __ATOMIC_RELAXED, __HIP_MEMORY_SCOPE_AGENT); }
__device__ __forceinline__ unsigned xb_xcc_id() { return (unsigned)__builtin_amdgcn_s_getreg((3 << 11) | 20) & 0xFu; }
#define XB_SPIN(cond, bar) do { unsigned _sp = 0; while (cond) { __builtin_amdgcn_s_sleep(1); \
    if ((++_sp & 255u) == 0u) { if (xb_ld(&(bar)[XB_TMO])) break; if (_sp > XB_SPIN_CAP) { atomicAdd(&(bar)[XB_TMO], 1u); break; } } } } while (0)
struct XcdBarrier { unsigned* bar; unsigned x; volatile LAS unsigned* st; };
__device__ __forceinline__ XcdBarrier xcd_barrier_post(unsigned* bar, volatile LAS unsigned* st) {
    XcdBarrier b; b.bar = bar; b.x = xb_xcc_id(); b.st = st;
    if (threadIdx.x == 0) (void)xb_add(&bar[XB_XCNT(b.x)], 1u);
    return b;
}
__device__ __forceinline__ void xcd_barrier_complete(unsigned* bar, unsigned x, unsigned& nloc, unsigned& nx) {
    const unsigned G = gridDim.x * gridDim.y * gridDim.z;
    unsigned sum, cnt, mine, sp = 0u;
    for (;;) {
        sum = 0u; cnt = 0u; mine = 0u;
#pragma unroll
        for (unsigned j = 0; j < 16; ++j) { const unsigned c = xb_ld(&bar[XB_XCNT(j)]); sum += c; cnt += (c > 0u) ? 1u : 0u; mine = (j == x) ? c : mine; }
        if (sum == G) break;
        __builtin_amdgcn_s_sleep(1);
        if ((++sp & 255u) == 0u) { if (xb_ld(&bar[XB_TMO])) break; if (sp > XB_SPIN_CAP) { atomicAdd(&bar[XB_TMO], 1u); break; } }
    }
    nloc = mine > 0u ? mine : 1u; nx = cnt > 0u ? cnt : 1u;
}
__device__ __forceinline__ void xcd_barrier(const XcdBarrier& b) {
    asm volatile("s_waitcnt vmcnt(0)" ::: "memory");
    __syncthreads();
    if (threadIdx.x == 0) {
        unsigned* bar = b.bar;
        __builtin_amdgcn_s_waitcnt(0);
        unsigned nloc = b.st[0], nx = b.st[1];
        if (nloc == 0u) { xcd_barrier_complete(bar, b.x, nloc, nx); b.st[0] = nloc; b.st[1] = nx; }
        const unsigned old = xb_add(&bar[XB_XSUB(b.x)], 1u);
        const unsigned gen = old / nloc;
        if (old + 1u == (gen + 1u) * nloc) {
            __builtin_amdgcn_fence(__ATOMIC_RELEASE, "agent");
            asm volatile("s_waitcnt vmcnt(0)" ::: "memory");
            const unsigned og = xb_add(&bar[XB_TOP], 1u);
            const unsigned tg = og / nx;
            if (og + 1u == (tg + 1u) * nx) xb_add(&bar[XB_TOPGEN], 1u);
            else XB_SPIN(xb_ld(&bar[XB_TOPGEN]) == tg, bar);
            __builtin_amdgcn_fence(__ATOMIC_ACQUIRE, "agent");
            xb_add(&bar[XB_XGEN(b.x)], 1u);
            asm volatile("s_waitcnt vmcnt(0)" ::: "memory");
        } else {
            XB_SPIN(xb_ld(&bar[XB_XGEN(b.x)]) == gen, bar);
            __builtin_amdgcn_fence(__ATOMIC_ACQUIRE, "agent");
            asm volatile("s_waitcnt vmcnt(0)" ::: "memory");
        }
    }
    __syncthreads();
}

typedef const __attribute__((address_space(4))) Args* CArgsPtr;
__device__ __forceinline__ Args load_args() {
#if defined(__HIP_DEVICE_COMPILE__)
    CArgsPtr p = (CArgsPtr)__builtin_amdgcn_kernarg_segment_ptr(); asm volatile("" : "+s"(p)); return *p;
#else
    return Args{};
#endif
}

__global__ void __launch_bounds__(512, 2) fwd_kernel(Args a_in) {
    extern __shared__ __attribute__((aligned(16))) unsigned char lds_raw[];
    LAS unsigned char* lds = (LAS unsigned char*)lds_raw;
    cg::grid_group grid = cg::this_grid();
    const int G = gridDim.x;
    unsigned* xbar_words; unsigned xbar_x;
    {
        const Args a = load_args();
        xbar_words = (unsigned*)(a.ws + WS_CTL) + CW_BAR;
        if (threadIdx.x < 2) ((LAS unsigned*)(lds + LDS_MISC + 32))[threadIdx.x] = 0u;
        __syncthreads();
        const XcdBarrier b0 = xcd_barrier_post(xbar_words, (volatile LAS unsigned*)(lds + LDS_MISC + 32));
        xbar_x = b0.x;
    }
#define TIDS() int tid = threadIdx.x; asm volatile("" : "+v"(tid)); const int lane = tid & 63, wave = __builtin_amdgcn_readfirstlane(tid >> 6), gw = blockIdx.x * 8 + wave, NGW = G * 8; (void)lane; (void)gw; (void)NGW
    for (int rep = 0; rep < REP_P0; ++rep) {
        const Args a = load_args(); TIDS();
        phase0(a, lds, gw, NGW, wave, lane);
    }
    grid.sync();
    for (int _r = 1; _r < REP_SYNC; ++_r) grid.sync();

    for (int l = 0; l < DEPTH; ++l) {
        {
            const Args a = load_args();
            const unsigned char* wl = a.ws + WS_W + (size_t)l * WL_STRIDE;
            pg8::Gemm g{(const bf16_t*)(a.ws + WS_XN), (const bf16_t*)(wl + WO_IN), MROWS, NIN, DM}; pg8::InOrder S; S.init(MROWS, NIN, G, (int)blockIdx.x, 0, G == 256 ? 6 : (1 << 30));
            pg8::EpiIn E{(bf16_t*)(a.ws + WS_PROJ), (float*)(a.ws + WS_FLOG), (const float*)(a.ws + WS_ROT), a.fa_b_f + l * 4};
            pg8::gemm_phase<pg8::EpiIn, pg8::InOrder>(lds, g, S, E);
        }
        GSYNC();
        for (int rep = 0; rep < REP_MIX; ++rep) {
            const Args a = load_args();
            mixer_phase(a, l + 2 * rep, l, lds, threadIdx.x);
        }
        GSYNC();
        for (int rep = 0; rep < REP_MERGE; ++rep) {
            const Args a = load_args();
            const unsigned char* wl = a.ws + WS_W + (size_t)l * WL_STRIDE;
            pg8::Gemm g{(const bf16_t*)(a.ws + WS_BR), (const bf16_t*)(wl + WO_BR), MROWS, DM, DM}; pg8::StaticOrder S; S.init(MROWS, DM, G, (int)blockIdx.x);
            pg8::EpiMergeFold E{(const bf16_t*)(a.ws + WS_PROJ) + P_GATE, (bf16_t*)(a.ws + WS_MB)};
            pg8::gemm_phase<pg8::EpiMergeFold, pg8::StaticOrder>(lds, g, S, E);
        }
        GSYNC();
        for (int rep = 0; rep < REP_OUT; ++rep) {
            const Args a = load_args();
            const unsigned char* wl = a.ws + WS_W + (size_t)l * WL_STRIDE;
            pg8::Gemm g{(const bf16_t*)(a.ws + WS_MB), (const bf16_t*)(wl + WO_OUT), MROWS, DM, DM}; pg8::StaticOrder S; S.init(MROWS, DM, G, (int)blockIdx.x);
            pg8::EpiBf<0> E{(bf16_t*)(a.ws + WS_Y), DM};
            pg8::gemm_phase<pg8::EpiBf<0>, pg8::StaticOrder>(lds, g, S, E);
        }
        GSYNC();
        {
            const Args a = load_args(); TIDS();
            if (l == 0) row_phase<false, true>((const bf16_t*)(a.ws + WS_Y), a.x, a.ws + WS_HB, a.n_mix_post + (size_t)l * DM, a.n_ffn_pre + (size_t)l * DM, (bf16_t*)(a.ws + WS_XN), gw, NGW, lane);
            else row_phase<true, true>((const bf16_t*)(a.ws + WS_Y), a.ws + WS_HB, a.ws + WS_HB, a.n_mix_post + (size_t)l * DM, a.n_ffn_pre + (size_t)l * DM, (bf16_t*)(a.ws + WS_XN), gw, NGW, lane);
        }
        GSYNC();
        {
            const Args a = load_args();
            const unsigned char* wl = a.ws + WS_W + (size_t)l * WL_STRIDE;
            pg8::Gemm g{(const bf16_t*)(a.ws + WS_XN), (const bf16_t*)(wl + WO_UP), MROWS, FFN, DM}; pg8::StaticOrder S; S.init(MROWS, FFN, G, (int)blockIdx.x, REP_UP);
            pg8::EpiBf<1> E{(bf16_t*)(a.ws + WS_PROJ), FFN};
            pg8::gemm_phase<pg8::EpiBf<1>, pg8::StaticOrder>(lds, g, S, E);
        }
        GSYNC();
        for (int rep = 0; rep < REP_DN; ++rep) {
            const Args a = load_args();
            const unsigned char* wl = a.ws + WS_W + (size_t)l * WL_STRIDE;
            pg8::Gemm g{(const bf16_t*)(a.ws + WS_PROJ), (const bf16_t*)(wl + WO_DN), MROWS, DM, FFN}; pg8::StaticOrder S; S.init(MROWS, DM, G, (int)blockIdx.x);
            pg8::EpiBf<0> E{(bf16_t*)(a.ws + WS_Y), DM};
            pg8::gemm_phase<pg8::EpiBf<0>, pg8::StaticOrder>(lds, g, S, E);
        }
        GSYNC();
        {
            const Args a = load_args(); TIDS();
            if (l + 1 < DEPTH) row_phase<true, true>((const bf16_t*)(a.ws + WS_Y), a.ws + WS_HB, a.ws + WS_HB, a.n_ffn_post + (size_t)l * DM, a.n_mix_pre + (size_t)(l + 1) * DM, (bf16_t*)(a.ws + WS_XN), gw, NGW, lane);
            else row_phase<true, false>((const bf16_t*)(a.ws + WS_Y), a.ws + WS_HB, a.out, a.n_ffn_post + (size_t)l * DM, nullptr, (bf16_t*)(a.ws + WS_XN), gw, NGW, lane);
        }
        if (l + 1 < DEPTH) GSYNC();
    }
#undef TIDS
}

extern "C" void kernel_launch(void* const* d_in, const int* in_sizes, int n_in, void* d_out, int out_size, void* d_ws, size_t ws_size, hipStream_t stream) {
    static int grid = 0;
    if (grid == 0) {
        if (n_in != 20 || out_size != MROWS * DM || ws_size < WS_END) { fprintf(stderr, "kernel_launch: unexpected shapes (n_in %d out %d ws %zu)\n", n_in, out_size, ws_size); grid = -1; return; }
        int dev = 0, cus = 0, per_cu = 0;
        (void)hipGetDevice(&dev);
        (void)hipDeviceGetAttribute(&cus, hipDeviceAttributeMultiprocessorCount, dev);
        if (hipFuncSetAttribute((const void*)fwd_kernel, hipFuncAttributeMaxDynamicSharedMemorySize, LDS_BYTES) != hipSuccess) { fprintf(stderr, "kernel_launch: hipFuncSetAttribute failed\n"); grid = -1; return; }
        (void)hipOccupancyMaxActiveBlocksPerMultiprocessor(&per_cu, (const void*)fwd_kernel, 512, LDS_BYTES);
        if (per_cu < 1) { fprintf(stderr, "kernel_launch: occupancy query says %d\n", per_cu); per_cu = 1; }
        (void)hipGetLastError();
        grid = cus;
        if (grid > 256) grid = 256;
    }
    if (grid < 0) return;
    (void)hipMemsetAsync((char*)d_ws + WS_CTL, 0, CTL_BYTES, stream);
    Args a{};
    a.x = (const float*)d_in[0]; a.pos = (const int*)d_in[1];
    a.n_mix_pre = (const float*)d_in[2]; a.n_mix_post = (const float*)d_in[3]; a.n_ffn_pre = (const float*)d_in[4]; a.n_ffn_post = (const float*)d_in[5];
    a.w_in = (const float*)d_in[6]; a.gm_ln_g = (const float*)d_in[7]; a.gm_ln_b = (const float*)d_in[8]; a.gm_w_s = (const float*)d_in[9]; a.gm_b_s = (const float*)d_in[10];
    a.da_lambda = (const float*)d_in[11]; a.da_subln_g = (const float*)d_in[12]; a.fa_b_f = (const float*)d_in[13]; a.pool_w = (const float*)d_in[14]; a.pool_scale = (const float*)d_in[15];
    a.w_branch = (const float*)d_in[16]; a.w_out = (const float*)d_in[17]; a.w_ffn_up = (const float*)d_in[18]; a.w_ffn_down = (const float*)d_in[19];
    a.out = (float*)d_out; a.ws = (unsigned char*)d_ws;
    void* args[] = {&a};
    hipError_t e = hipLaunchCooperativeKernel((const void*)fwd_kernel, dim3(grid), dim3(512), args, LDS_BYTES, stream);
    if (e != hipSuccess) fprintf(stderr, "cooperative launch failed: %s (grid %d)\n", hipGetErrorString(e), grid);
}
```
